# Optimizing an MI355X kernel written in HIP

```python
import math
import jax, jax.numpy as jnp
from jax import lax
import numpy as np

D_MODEL = 1024
BATCH = 4
SEQ = 4096
DEPTH = 2
DEC_BATCH = 128
DEC_SEQ = 4
PAST_LEN = 2048
PAGE_SIZE = 128

ATT_HEADS = 8
ATT_HEAD_DIM = 64
ATT_WIDTH = ATT_HEADS * ATT_HEAD_DIM
MOBA_BLOCK = 256
MOBA_TOPK = 3
MOBA_Q_CHUNK = 32
CONV_CH = 512
CONV_GROUPS = 8
CONV_LEN = 31
HGRN_HEADS = 8
HGRN_DK = 128
HGRN_DV = 128
HGRN_KEY_WIDTH = HGRN_HEADS * HGRN_DK
HGRN_VAL_WIDTH = HGRN_HEADS * HGRN_DV
HGRN_CHUNK = 64
EPS = 1e-6

AB_SPLITS = [ATT_WIDTH] * 4 + [CONV_CH] * 3
C_SPLITS = [HGRN_KEY_WIDTH, HGRN_KEY_WIDTH, HGRN_VAL_WIDTH, HGRN_VAL_WIDTH]

kernel_name = 'moba_conformer_hgrn2_hybrid_step'


def _split(z, sizes):
    return jnp.split(z, [int(c) for c in np.cumsum(sizes)[:-1]], axis=-1)


def _rms(x, g):
    xf = x.astype(jnp.float32)
    y = xf * lax.rsqrt(jnp.mean(xf * xf, axis=-1, keepdims=True) + EPS)
    return (y * g.astype(jnp.float32)).astype(x.dtype)


def _layernorm(x, g, b):
    xf = x.astype(jnp.float32)
    mu = jnp.mean(xf, axis=-1, keepdims=True)
    var = jnp.mean(jnp.square(xf - mu), axis=-1, keepdims=True)
    y = (xf - mu) * lax.rsqrt(var + EPS) * g.astype(jnp.float32) + b.astype(jnp.float32)
    return y.astype(x.dtype)


def _moba_combine(s_own, v_own, s_sel=None, v_sel=None):
    if s_sel is None:
        p = jax.nn.softmax(s_own, axis=-1)
        return jnp.einsum('bhqk,bhkd->bhqd', p.astype(v_own.dtype), v_own)
    shp = s_sel.shape
    n_sel = shp[-2] * shp[-1]
    s = jnp.concatenate([s_sel.reshape(shp[:-2] + (n_sel,)), s_own], axis=-1)
    p = jax.nn.softmax(s, axis=-1)
    p_sel = p[..., :n_sel].reshape(shp).astype(v_sel.dtype)
    p_own = p[..., n_sel:].astype(v_own.dtype)
    return (jnp.einsum('bhqnk,bhqnkd->bhqd', p_sel, v_sel)
            + jnp.einsum('bhqk,bhkd->bhqd', p_own, v_own))


def _moba_prompt(q, k, v):
    B, S, H, Dh = q.shape
    nb = -(-S // MOBA_BLOCK)
    pad = nb * MOBA_BLOCK - S
    scale = Dh ** -0.5

    def blocks(a):
        a = jnp.pad(a, ((0, 0), (0, pad), (0, 0), (0, 0)))
        return a.reshape(B, nb, MOBA_BLOCK, H, Dh).transpose(0, 3, 1, 2, 4)

    kb, vb = blocks(k), blocks(v)
    k_mean = jnp.mean(kb.astype(jnp.float32), axis=3)
    topk = min(MOBA_TOPK, nb)
    qh = q.transpose(0, 2, 1, 3)
    qlen = math.gcd(S, MOBA_Q_CHUNK)
    b_idx = jnp.arange(B)[:, None, None, None]
    h_idx = jnp.arange(H)[None, :, None, None]
    blk_ids = jnp.arange(nb)

    def one_chunk(c):
        t0 = c * qlen
        qc = lax.dynamic_slice_in_dim(qh, t0, qlen, axis=2)
        j = t0 // MOBA_BLOCK
        gate = jnp.einsum('bhqd,bhnd->bhqn', qc.astype(jnp.float32), k_mean)
        gate = jnp.where(blk_ids < j, gate, -jnp.inf)
        _, sel = lax.top_k(gate, topk)
        valid = sel < j
        k_sel = kb[b_idx, h_idx, sel]
        v_sel = vb[b_idx, h_idx, sel]
        s_sel = jnp.einsum('bhqd,bhqnkd->bhqnk', qc, k_sel).astype(jnp.float32) * scale
        s_sel = jnp.where(valid[..., None], s_sel, -jnp.inf)
        k_own = lax.dynamic_index_in_dim(kb, j, axis=2, keepdims=False)
        v_own = lax.dynamic_index_in_dim(vb, j, axis=2, keepdims=False)
        s_own = jnp.einsum('bhqd,bhkd->bhqk', qc, k_own).astype(jnp.float32) * scale
        q_pos = t0 + jnp.arange(qlen)
        k_pos = j * MOBA_BLOCK + jnp.arange(MOBA_BLOCK)
        s_own = jnp.where(k_pos[None, :] <= q_pos[:, None], s_own, -jnp.inf)
        return _moba_combine(s_own, v_own, s_sel, v_sel)

    out = lax.map(one_chunk, jnp.arange(S // qlen))
    return out.transpose(1, 0, 3, 2, 4).reshape(B, S, H * Dh)


def _moba_sample(q, k_new, v_new, cache_k, cache_v, page_table):
    N, T, H, Dh = q.shape
    n_pages = page_table.shape[1]
    past = n_pages * PAGE_SIZE
    ppb = MOBA_BLOCK // PAGE_SIZE
    j = past // MOBA_BLOCK
    scale = Dh ** -0.5
    qh = q.transpose(0, 2, 1, 3)
    own_pages = page_table[:, j * ppb:]
    n_own = own_pages.shape[1] * PAGE_SIZE
    k_own = jnp.concatenate([cache_k[own_pages].reshape(N, n_own, H, Dh), k_new], axis=1)
    v_own = jnp.concatenate([cache_v[own_pages].reshape(N, n_own, H, Dh), v_new], axis=1)
    k_own = k_own.transpose(0, 2, 1, 3)
    v_own = v_own.transpose(0, 2, 1, 3)
    L = k_own.shape[2]
    s_own = jnp.einsum('bhqd,bhkd->bhqk', qh, k_own).astype(jnp.float32) * scale
    q_pos = past + jnp.arange(T)
    k_pos = j * MOBA_BLOCK + jnp.arange(L)
    s_own = jnp.where(k_pos[None, :] <= q_pos[:, None], s_own, -jnp.inf)
    if j == 0:
        out = _moba_combine(s_own, v_own)
    else:
        past_pages = page_table[:, :j * ppb]
        k_mean = jnp.mean(cache_k[past_pages].astype(jnp.float32)
                          .reshape(N, j, ppb * PAGE_SIZE, H, Dh), axis=2)
        gate = jnp.einsum('bhqd,bnhd->bhqn', qh.astype(jnp.float32), k_mean)
        topk = min(MOBA_TOPK, j)
        _, sel = lax.top_k(gate, topk)
        phys = page_table[jnp.arange(N)[:, None, None, None, None],
                          sel[..., None] * ppb + jnp.arange(ppb)]
        h_idx = jnp.arange(H)[None, :, None, None, None]
        k_sel = cache_k[phys, :, h_idx].reshape(N, H, T, topk, MOBA_BLOCK, Dh)
        v_sel = cache_v[phys, :, h_idx].reshape(N, H, T, topk, MOBA_BLOCK, Dh)
        s_sel = jnp.einsum('bhqd,bhqnkd->bhqnk', qh, k_sel).astype(jnp.float32) * scale
        out = _moba_combine(s_own, v_own, s_sel, v_sel)
    return out.transpose(0, 2, 1, 3).reshape(N, T, H * Dh)


def _ab_in(x, norm_g, w_in, q_g, k_g):
    B, T, _ = x.shape
    h = _rms(x, norm_g)
    q, k, v, g_att, u_a, u_b, g_conv = _split(h @ w_in, AB_SPLITS)
    q = _rms(q.reshape(B, T, ATT_HEADS, ATT_HEAD_DIM), q_g)
    k = _rms(k.reshape(B, T, ATT_HEADS, ATT_HEAD_DIM), k_g)
    v = v.reshape(B, T, ATT_HEADS, ATT_HEAD_DIM)
    u = u_a * jax.nn.sigmoid(u_b)
    return q, k, v, g_att, u, g_conv


def _conv_branch(u, buf, conv_w, conv_b, ln_g, ln_b):
    up = jnp.concatenate([buf, u], axis=1)
    y = lax.conv_general_dilated(up, conv_w[:, None, :].astype(up.dtype), (1,), 'VALID',
                                 dimension_numbers=('NWC', 'WIO', 'NWC'),
                                 feature_group_count=CONV_CH) + conv_b.astype(up.dtype)
    y = jax.nn.silu(_layernorm(y, ln_g, ln_b))
    return y, up[:, -(CONV_LEN - 1):]


def _ab_out(x, o_att, g_att, o_conv, g_conv, w_out):
    m = jnp.concatenate([o_att * jax.nn.silu(g_att), o_conv * jax.nn.silu(g_conv)], axis=-1)
    return x + m @ w_out


def _hgrn2_scan(q, k, logf, v, S0):
    B, T, H, DK = q.shape
    DV = v.shape[-1]
    C = math.gcd(T, HGRN_CHUNK)
    n = T // C

    def to_chunks(a):
        return a.reshape(B, n, C, H, a.shape[-1]).transpose(1, 0, 3, 2, 4)

    causal = jnp.tril(jnp.ones((C, C), dtype=bool))[:, :, None]

    def step(S, inp):
        qc, kc, lc, vc = inp
        b = jnp.cumsum(lc, axis=2)
        o_inter = jnp.einsum('bhtk,bhkv->bhtv', qc * jnp.exp(b), S)
        diff = b[:, :, :, None, :] - b[:, :, None, :, :]
        decay = jnp.exp(jnp.where(causal, diff, -jnp.inf))
        a = jnp.einsum('bhtk,bhsk,bhtsk->bhts', qc, kc, decay)
        o = o_inter + jnp.einsum('bhts,bhsv->bhtv', a, vc)
        b_last = b[:, :, -1, :]
        S = (jnp.exp(b_last)[..., None] * S
             + jnp.einsum('bhsk,bhsv->bhkv', kc * jnp.exp(b_last[:, :, None, :] - b), vc))
        return S, o

    S, o = lax.scan(step, S0, (to_chunks(q), to_chunks(k), to_chunks(logf), to_chunks(v)))
    return o.transpose(1, 0, 3, 2, 4).reshape(B, T, H, DV), S


def _c_layer(x, S0, layer, norm_g, w_in, lb_logits, o_g, w_out):
    B, T, _ = x.shape
    h = _rms(x, norm_g)
    q, fz, i, g = _split(h @ w_in, C_SPLITS)
    p = jax.nn.softmax(lb_logits.astype(jnp.float32), axis=0)
    lb = (jnp.cumsum(p, axis=0) - p[0:1])[layer]
    f = lb + (1.0 - lb) * jax.nn.sigmoid(fz.astype(jnp.float32))
    logf = jnp.log(f).reshape(B, T, HGRN_HEADS, HGRN_DK)
    kk = (1.0 - f).reshape(B, T, HGRN_HEADS, HGRN_DK)
    qq = jax.nn.silu(q.astype(jnp.float32)).reshape(B, T, HGRN_HEADS, HGRN_DK)
    vv = i.astype(jnp.float32).reshape(B, T, HGRN_HEADS, HGRN_DV)
    o, S = _hgrn2_scan(qq, kk, logf, vv, S0.astype(jnp.float32))
    o = _rms(o, o_g).reshape(B, T, HGRN_VAL_WIDTH).astype(x.dtype)
    return x + (o * jax.nn.silu(g)) @ w_out, S.astype(x.dtype)


def setup_inputs(seed: int = 0) -> dict:
    key = jax.random.key(seed)
    ks = jax.random.split(key, 24)
    n_pages = PAST_LEN // PAGE_SIZE
    n_used = DEC_BATCH * n_pages
    n_pool = n_used + n_used // 4

    def nrm(k, shape, s):
        return s * jax.random.normal(k, shape, jnp.float32)

    page_table = jax.random.permutation(ks[6], n_pool)[:n_used].reshape(DEC_BATCH, n_pages).astype(jnp.int32)
    return {
        'x_prompt': nrm(ks[0], (BATCH, SEQ, D_MODEL), 1.0),
        'x_sample': nrm(ks[1], (DEC_BATCH, DEC_SEQ, D_MODEL), 1.0),
        'cache_k': nrm(ks[2], (n_pool, PAGE_SIZE, ATT_HEADS, ATT_HEAD_DIM), 1.0),
        'cache_v': nrm(ks[3], (n_pool, PAGE_SIZE, ATT_HEADS, ATT_HEAD_DIM), 1.0),
        'state_conv': nrm(ks[4], (DEC_BATCH, CONV_LEN - 1, CONV_CH), 0.5),
        'state_hgrn': nrm(ks[5], (DEC_BATCH, HGRN_HEADS, HGRN_DK, HGRN_DV), 0.3),
        'page_table': page_table,
        'norm_0': 1.0 + nrm(ks[7], (D_MODEL,), 0.02),
        'w_in_0': nrm(ks[8], (D_MODEL, sum(AB_SPLITS)), D_MODEL ** -0.5),
        'q_norm_0': 1.0 + nrm(ks[9], (ATT_HEAD_DIM,), 0.02),
        'k_norm_0': 1.0 + nrm(ks[10], (ATT_HEAD_DIM,), 0.02),
        'conv_w_0': nrm(ks[11], (CONV_LEN, CONV_CH), CONV_LEN ** -0.5),
        'conv_b_0': nrm(ks[12], (CONV_CH,), 0.01),
        'conv_ln_g_0': 1.0 + nrm(ks[13], (CONV_CH,), 0.02),
        'conv_ln_b_0': nrm(ks[14], (CONV_CH,), 0.01),
        'w_out_0': nrm(ks[15], (ATT_WIDTH + CONV_CH, D_MODEL), (ATT_WIDTH + CONV_CH) ** -0.5),
        'norm_1': 1.0 + nrm(ks[16], (D_MODEL,), 0.02),
        'w_in_1': nrm(ks[17], (D_MODEL, sum(C_SPLITS)), D_MODEL ** -0.5),
        'lb_logits': nrm(ks[18], (DEPTH, HGRN_KEY_WIDTH), 0.5),
        'o_norm_1': 1.0 + nrm(ks[19], (HGRN_DV,), 0.02),
        'w_out_1': nrm(ks[20], (HGRN_VAL_WIDTH, D_MODEL), HGRN_VAL_WIDTH ** -0.5),
    }


def reference(x_prompt, x_sample, cache_k, cache_v, state_conv, state_hgrn, page_table,
              norm_0, w_in_0, q_norm_0, k_norm_0, conv_w_0, conv_b_0, conv_ln_g_0, conv_ln_b_0, w_out_0,
              norm_1, w_in_1, lb_logits, o_norm_1, w_out_1):
    xp, xs = x_prompt, x_sample
    for layer in range(DEPTH):
        if layer % 2 == 0:
            q, k_prompt, v_prompt, ga, u, gc = _ab_in(xp, norm_0, w_in_0, q_norm_0, k_norm_0)
            oa = _moba_prompt(q, k_prompt, v_prompt)
            buf0 = jnp.zeros((xp.shape[0], CONV_LEN - 1, CONV_CH), u.dtype)
            oc, conv_prompt = _conv_branch(u, buf0, conv_w_0, conv_b_0, conv_ln_g_0, conv_ln_b_0)
            xp = _ab_out(xp, oa, ga, oc, gc, w_out_0)
            q, k_sample, v_sample, ga, u, gc = _ab_in(xs, norm_0, w_in_0, q_norm_0, k_norm_0)
            oa = _moba_sample(q, k_sample, v_sample, cache_k, cache_v, page_table)
            oc, conv_sample = _conv_branch(u, state_conv.astype(u.dtype), conv_w_0, conv_b_0,
                                           conv_ln_g_0, conv_ln_b_0)
            xs = _ab_out(xs, oa, ga, oc, gc, w_out_0)
        else:
            s0 = jnp.zeros((xp.shape[0], HGRN_HEADS, HGRN_DK, HGRN_DV), jnp.float32)
            xp, hgrn_prompt = _c_layer(xp, s0, layer, norm_1, w_in_1, lb_logits, o_norm_1, w_out_1)
            xs, hgrn_sample = _c_layer(xs, state_hgrn, layer, norm_1, w_in_1, lb_logits, o_norm_1, w_out_1)
    return (xp, xs, k_prompt, v_prompt, k_sample, v_sample, conv_prompt, conv_sample, hgrn_prompt, hgrn_sample)
```

```cpp
#include <hip/hip_runtime.h>
#include <cstdio>
#include <cstdint>
namespace pg8 {
#define PG8_LAS __attribute__((address_space(3)))
typedef unsigned short bf16_t;
typedef short bf16x8 __attribute__((ext_vector_type(8)));
typedef float f32x4 __attribute__((ext_vector_type(4)));
typedef unsigned u32x4 __attribute__((ext_vector_type(4)));
constexpr int BM = 256, BK = 64, HALF = 128, HTB = HALF * BK * 2  , STAGE_BYTES = 8 * HTB, NXCD = 8, WGM = 8;

__host__ __device__ __forceinline__ int lds_byte(int r, int c) { const int st = (r >> 4) * 2 + (c >> 5), rr = r & 15, cc = c & 31, ob = rr * 64 + cc * 2; return st * 1024 + (ob ^ (((ob >> 9) & 1) << 5)); }
__host__ __device__ __forceinline__ void stage_rc(int b, int& R, int& C) { const int st = b / 1024, sb = b % 1024, swz = sb ^ (((sb >> 9) & 1) << 5); R = (st >> 1) * 16 + swz / 64; C = (st & 1) * 32 + (swz % 64) / 2; }
__host__ __device__ __forceinline__ int perm32(int rho) { const int n = rho >> 4, i = rho & 15; return 8 * (i >> 2) + 4 * n + (i & 3); }

struct Unit { int pm, pn; };
struct Gemm { const bf16_t* A; const bf16_t* Bt; int M, N, K; };

struct StaticOrder {
    int nM, nN, nwg, G, c;
    __host__ __device__ void init(int M, int N, int G_, int c_) { nM = M / BM; nN = N / BM; nwg = nM * nN; G = G_; c = c_; }
    __host__ __device__ bool next(int i, Unit& u) const {
        const long L = (long)i * G + c; if (L >= nwg) return false;
        int wgid = (int)L; { const int q = nwg / NXCD, r = nwg % NXCD, xcd = wgid % NXCD, off = wgid / NXCD; wgid = (xcd < r ? xcd * (q + 1) : r * (q + 1) + (xcd - r) * q) + off; }
        const int nig = WGM * nN, gid = wgid / nig, fm = gid * WGM, gsz = (nM - fm) < WGM ? (nM - fm) : WGM;
        u.pm = fm + ((wgid % nig) % gsz); u.pn = (wgid % nig) / gsz; return true;
    }
    __device__ __forceinline__ void a_ready(const Unit&) const {}
    __device__ __forceinline__ void done(const Unit&) const {}
};
__device__ __forceinline__ unsigned cvt_pk_bf16(float lo, float hi) { unsigned r; asm volatile("v_cvt_pk_bf16_f32 %0, %1, %2" : "=v"(r) : "v"(lo), "v"(hi)); return r; }
typedef float f32x2 __attribute__((ext_vector_type(2)));
typedef unsigned u32x2 __attribute__((ext_vector_type(2)));
__device__ __forceinline__ float fsigmoid(float x) { return __builtin_amdgcn_rcpf(1.0f + __builtin_amdgcn_exp2f(-1.4426950408889634f * x)); }
__device__ __forceinline__ float fsilu(float x) { return x * fsigmoid(x); }
__device__ __forceinline__ f32x4 silu4(f32x4 v) { return (f32x4){fsilu(v[0]), fsilu(v[1]), fsilu(v[2]), fsilu(v[3])}; }
__device__ __forceinline__ f32x4 sigm4(f32x4 v) { return (f32x4){fsigmoid(v[0]), fsigmoid(v[1]), fsigmoid(v[2]), fsigmoid(v[3])}; }
__device__ __forceinline__ u32x4 pack8(f32x4 a, f32x4 b) { u32x4 w; w.x = cvt_pk_bf16(a[0], a[1]); w.y = cvt_pk_bf16(a[2], a[3]); w.z = cvt_pk_bf16(b[0], b[1]); w.w = cvt_pk_bf16(b[2], b[3]); return w; }
__device__ __forceinline__ float dot4(f32x4 a) { return (a[0] * a[0] + a[1] * a[1]) + (a[2] * a[2] + a[3] * a[3]); }

constexpr int MP = 16384;
constexpr float RMS_EPS = 1e-6f;

struct EpiIn0 {
    static constexpr bool PERM = true, AFTER_DRAIN = false;
    const float* rstd; const float* qg; const float* kg;
    bf16_t *Q, *Kb, *Vb, *GA, *U, *GC;
    float *k_prompt, *v_prompt, *k_sample, *v_sample, *conv_prompt, *conv_sample;
    float* kmp;
    __device__ __forceinline__ void operator()(const f32x4 (&acc)[2][2][4][2], const Unit& u, int wr, int wc, int fr, int fq) const {
        const int pn = u.pn;
        const int rowb = u.pm * BM + wr * 64 + fr;
        const bool sample = u.pm >= 64;
        if (pn < 4) {
            const bool isk = pn >= 2;
            const float* g = isk ? kg : qg;
            f32x4 gv[2][2];
#pragma unroll
            for (int bj = 0; bj < 2; ++bj)
#pragma unroll
                for (int n = 0; n < 2; ++n) gv[bj][n] = *(const f32x4*)(g + 32 * bj + 8 * fq + 4 * n);
            const int colb = 256 * (pn & 1) + 64 * wc + 8 * fq;
            bf16_t* ob = isk ? Kb : Q;
            float* of = sample ? (k_sample - (size_t)MP * 512) : k_prompt;
#pragma unroll
            for (int ai = 0; ai < 2; ++ai) {
                f32x4 ks[2][2];
#pragma unroll
                for (int bj = 0; bj < 2; ++bj)
#pragma unroll
                    for (int n = 0; n < 2; ++n) ks[bj][n] = (f32x4){0.f, 0.f, 0.f, 0.f};
#pragma unroll
                for (int m = 0; m < 4; ++m) {
                    const int r = rowb + ai * HALF + m * 16;
                    const float rs = rstd[r];
                    f32x4 v[2][2]; float ss = 0.f;
#pragma unroll
                    for (int bj = 0; bj < 2; ++bj)
#pragma unroll
                        for (int n = 0; n < 2; ++n) { v[bj][n] = acc[ai][bj][m][n] * rs; ss += dot4(v[bj][n]); }
                    ss += __shfl_xor(ss, 16); ss += __shfl_xor(ss, 32);
                    const float inv = __builtin_amdgcn_rsqf(ss * (1.0f / 64.0f) + RMS_EPS);
#pragma unroll
                    for (int bj = 0; bj < 2; ++bj) {
                        const f32x4 o0 = v[bj][0] * inv * gv[bj][0], o1 = v[bj][1] * inv * gv[bj][1];
                        const size_t off = (size_t)r * 512 + colb + 32 * bj;
                        *(u32x4*)(ob + off) = pack8(o0, o1);
                        if (isk) { *(f32x4*)(of + off) = o0; *(f32x4*)(of + off + 4) = o1; ks[bj][0] += o0; ks[bj][1] += o1; }
                    }
                }
                if (isk && !sample) {
#pragma unroll
                    for (int bj = 0; bj < 2; ++bj)
#pragma unroll
                        for (int n = 0; n < 2; ++n) {
                            f32x4 s = ks[bj][n];
#pragma unroll
                            for (int o = 1; o < 16; o <<= 1) { s[0] += __shfl_xor(s[0], o); s[1] += __shfl_xor(s[1], o); s[2] += __shfl_xor(s[2], o); s[3] += __shfl_xor(s[3], o); }
                            if (fr == 0) *(f32x4*)(kmp + ((size_t)(u.pm * 4 + ai * 2 + wr)) * 512 + colb + 32 * bj + 4 * n) = s;
                        }
                }
            }
        } else if (pn < 6) {
            const int colb = 256 * (pn & 1) + 64 * wc + 8 * fq;
            float* of = sample ? (v_sample - (size_t)MP * 512) : v_prompt;
#pragma unroll
            for (int ai = 0; ai < 2; ++ai)
#pragma unroll
                for (int m = 0; m < 4; ++m) {
                    const int r = rowb + ai * HALF + m * 16;
                    const float rs = rstd[r];
#pragma unroll
                    for (int bj = 0; bj < 2; ++bj) {
                        const f32x4 o0 = acc[ai][bj][m][0] * rs, o1 = acc[ai][bj][m][1] * rs;
                        const size_t off = (size_t)r * 512 + colb + 32 * bj;
                        *(u32x4*)(Vb + off) = pack8(o0, o1);
                        *(f32x4*)(of + off) = o0; *(f32x4*)(of + off + 4) = o1;
                    }
                }
        } else if (pn < 8 || pn >= 12) {
            const int colb = 256 * (pn & 1) + 64 * wc + 8 * fq;
            bf16_t* ob = pn < 8 ? GA : GC;
#pragma unroll
            for (int ai = 0; ai < 2; ++ai)
#pragma unroll
                for (int m = 0; m < 4; ++m) {
                    const int r = rowb + ai * HALF + m * 16;
                    const float rs = rstd[r];
#pragma unroll
                    for (int bj = 0; bj < 2; ++bj) {
                        const f32x4 o0 = silu4(acc[ai][bj][m][0] * rs), o1 = silu4(acc[ai][bj][m][1] * rs);
                        *(u32x4*)(ob + (size_t)r * 512 + colb + 32 * bj) = pack8(o0, o1);
                    }
                }
        } else {
            const int ch0 = 128 * (pn - 8) + 32 * wc + 8 * fq;
            const bool tailp = !sample && ((u.pm & 15) == 15);
#pragma unroll
            for (int ai = 0; ai < 2; ++ai)
#pragma unroll
                for (int m = 0; m < 4; ++m) {
                    const int r = rowb + ai * HALF + m * 16;
                    const float rs = rstd[r];
                    const f32x4 o0 = (acc[ai][0][m][0] * rs) * sigm4(acc[ai][1][m][0] * rs), o1 = (acc[ai][0][m][1] * rs) * sigm4(acc[ai][1][m][1] * rs);
                    *(u32x4*)(U + (size_t)r * 512 + ch0) = pack8(o0, o1);
                    if (tailp) { const int tok = r & 4095; if (tok >= 4066) { float* d = conv_prompt + ((size_t)((r >> 12) * 30 + (tok - 4066))) * 512 + ch0; *(f32x4*)d = o0; *(f32x4*)(d + 4) = o1; } }
                    if (sample) { const int rr = r - MP; float* d = conv_sample + ((size_t)((rr >> 2) * 30 + 26 + (rr & 3))) * 512 + ch0; *(f32x4*)d = o0; *(f32x4*)(d + 4) = o1; }
                }
        }
    }
};
template <class Epi, class Sched, bool ALIGN_EPI = false, bool SP2 = false>
__device__ __forceinline__ void gemm_phase(PG8_LAS unsigned char* lds, const Gemm g, const Sched& S, const Epi& E) {
    const int tid = threadIdx.x, wid = __builtin_amdgcn_readfirstlane(tid >> 6), lane = tid & 63, wr = wid >> 2, wc = wid & 3, fr = lane & 15, fq = lane >> 4;
    const int K = g.K, nt = K / BK;
    unsigned voffA[2], voffB[2];
#pragma unroll
    for (int i = 0; i < 2; ++i) { int R, C; stage_rc(tid * 16 + i * 8192, R, C); const int Rb = Epi::PERM ? ((R & ~31) + perm32(R & 31)) : R;
        voffA[i] = (unsigned)(R * K + C) * 2u; voffB[i] = (unsigned)(Rb * K + C) * 2u; }
    const size_t kstep = (size_t)(BK * 2);
    const size_t hstep = (size_t)HALF * K * 2;
    const size_t tstep = 2 * hstep;
    const unsigned ldsw = (unsigned)wid * 1024u;
    const int aoff = lds_byte(wr * 64 + fr, fq * 8), boff = lds_byte(wc * 32 + fr, fq * 8);
#define PG8_SA(b, h) (((b) * 2 + (h)) * HTB)
#define PG8_SB(b, h) ((4 + (b) * 2 + (h)) * HTB)
#define PG8_STAGE(bufoff, gbase, voff) do { _Pragma("unroll") for (int _i = 0; _i < 2; ++_i) \
        __builtin_amdgcn_global_load_lds((const unsigned*)((const char*)(gbase) + (voff)[_i]), (PG8_LAS unsigned*)(lds + (bufoff) + ldsw + _i * 8192), 16, 0, 0); } while (0)
#define PG8_LDA(dst, b, h) do { _Pragma("unroll") for (int m = 0; m < 4; ++m) _Pragma("unroll") for (int k = 0; k < 2; ++k) dst[m][k] = *(const PG8_LAS bf16x8*)(lds + PG8_SA(b, h) + aoff + m * 2048 + k * 1024); } while (0)
#define PG8_LDB(dst, b, h) do { _Pragma("unroll") for (int n = 0; n < 2; ++n) _Pragma("unroll") for (int k = 0; k < 2; ++k) dst[n][k] = *(const PG8_LAS bf16x8*)(lds + PG8_SB(b, h) + boff + n * 2048 + k * 1024); } while (0)
#define PG8_MMA(ai, bj, At, Bt) do { __builtin_amdgcn_s_setprio(1); _Pragma("unroll") for (int m = 0; m < 4; ++m) _Pragma("unroll") for (int n = 0; n < 2; ++n) _Pragma("unroll") for (int k = 0; k < 2; ++k) \
        acc[ai][bj][m][n] = __builtin_amdgcn_mfma_f32_16x16x32_bf16(Bt[n][k], At[m][k], acc[ai][bj][m][n], 0, 0, 0); __builtin_amdgcn_s_setprio(0); } while (0)
#define PG8_WAIT_V(n) asm volatile("s_waitcnt vmcnt(" #n ")" ::: "memory")
#define PG8_WAIT_L(n) asm volatile("s_waitcnt lgkmcnt(" #n ")" ::: "memory")
#define PG8_BAR __builtin_amdgcn_s_barrier()
#define PG8_SCHED __builtin_amdgcn_sched_barrier(0)
    Unit cur, nxt; int ui = 0;
    if (!S.next(0, cur)) return;
    f32x4 acc[2][2][4][2];
#pragma unroll
    for (int a = 0; a < 2; ++a)
#pragma unroll
        for (int b = 0; b < 2; ++b)
#pragma unroll
            for (int m = 0; m < 4; ++m)
#pragma unroll
                for (int n = 0; n < 2; ++n) acc[a][b][m][n] = (f32x4){0.f, 0.f, 0.f, 0.f};
    bf16x8 At[4][2], B0[2][2], B1[2][2];
    const char* cA = (const char*)g.A + (size_t)cur.pm * tstep; const char* cB = (const char*)g.Bt + (size_t)cur.pn * tstep;
    S.a_ready(cur);
    if constexpr (SP2) {
        PG8_STAGE(PG8_SB(0, 0), cB, voffB); PG8_STAGE(PG8_SB(0, 1), cB + hstep, voffB); PG8_STAGE(PG8_SA(0, 0), cA, voffA); PG8_STAGE(PG8_SA(0, 1), cA + hstep, voffA);
        if (wr == 1) PG8_BAR;
        PG8_WAIT_V(2); PG8_BAR;
        PG8_STAGE(PG8_SB(1, 0), cB + kstep, voffB); PG8_STAGE(PG8_SA(1, 0), cA + kstep, voffA); PG8_STAGE(PG8_SB(1, 1), cB + hstep + kstep, voffB);
        PG8_WAIT_V(6); PG8_BAR;
    } else {
        PG8_STAGE(PG8_SB(0, 0), cB, voffB); PG8_STAGE(PG8_SA(0, 0), cA, voffA); PG8_STAGE(PG8_SB(0, 1), cB + hstep, voffB); PG8_STAGE(PG8_SA(0, 1), cA + hstep, voffA);
        if (wr == 1) PG8_BAR;
        PG8_WAIT_V(4); PG8_BAR;
        PG8_STAGE(PG8_SB(1, 0), cB + kstep, voffB); PG8_STAGE(PG8_SA(1, 0), cA + kstep, voffA); PG8_STAGE(PG8_SB(1, 1), cB + hstep + kstep, voffB);
        PG8_WAIT_V(6); PG8_BAR;
    }
    for (;;) {
        const bool has_next = S.next(ui + 1, nxt);
        const char* nA = has_next ? (const char*)g.A + (size_t)nxt.pm * tstep : cA; const char* nB = has_next ? (const char*)g.Bt + (size_t)nxt.pn * tstep : cB;
        for (int t = 0; t < nt; t += 2) {
            const bool last = (t == nt - 2);
            const char* a1 = cA + (size_t)(t + 1) * kstep;
            const char* a2 = last ? nA : cA + (size_t)(t + 2) * kstep; const char* b2 = last ? nB : cB + (size_t)(t + 2) * kstep;
            const char* a3 = a2 + kstep; const char* b3 = b2 + kstep;
            if (last && has_next) S.a_ready(nxt);
            if constexpr (SP2) {
            PG8_LDB(B0, 0, 0); PG8_LDB(B1, 0, 1); PG8_SCHED; PG8_LDA(At, 0, 0); PG8_STAGE(PG8_SA(1, 1), a1 + hstep, voffA);
            PG8_WAIT_V(8); PG8_WAIT_L(0); PG8_BAR; PG8_MMA(0, 0, At, B0); PG8_MMA(0, 1, At, B1); PG8_BAR; PG8_SCHED;
            PG8_LDA(At, 0, 1); PG8_STAGE(PG8_SB(0, 0), b2, voffB); PG8_STAGE(PG8_SB(0, 1), b2 + hstep, voffB); PG8_STAGE(PG8_SA(0, 0), a2, voffA);
            PG8_WAIT_V(8); PG8_WAIT_L(0); PG8_BAR; PG8_MMA(1, 0, At, B0); PG8_MMA(1, 1, At, B1); PG8_BAR; PG8_SCHED;
            PG8_LDB(B0, 1, 0); PG8_LDB(B1, 1, 1); PG8_SCHED; PG8_LDA(At, 1, 0); PG8_STAGE(PG8_SA(0, 1), a2 + hstep, voffA);
            PG8_WAIT_V(8); PG8_WAIT_L(0); PG8_BAR; PG8_MMA(0, 0, At, B0); PG8_MMA(0, 1, At, B1); PG8_BAR; PG8_SCHED;
            PG8_LDA(At, 1, 1); PG8_STAGE(PG8_SB(1, 0), b3, voffB); PG8_STAGE(PG8_SB(1, 1), b3 + hstep, voffB); PG8_STAGE(PG8_SA(1, 0), a3, voffA);
            PG8_WAIT_V(8); PG8_WAIT_L(0); PG8_BAR; PG8_MMA(1, 0, At, B0); PG8_MMA(1, 1, At, B1); PG8_BAR; PG8_SCHED;
            } else {
            PG8_LDB(B0, 0, 0); PG8_SCHED; PG8_LDA(At, 0, 0); PG8_STAGE(PG8_SA(1, 1), a1 + hstep, voffA);
            PG8_WAIT_L(8); PG8_BAR; PG8_WAIT_L(0); PG8_MMA(0, 0, At, B0); PG8_BAR; PG8_SCHED;
            PG8_LDB(B1, 0, 1); PG8_STAGE(PG8_SB(0, 0), b2, voffB);
            PG8_BAR; PG8_WAIT_L(0); PG8_MMA(0, 1, At, B1); PG8_BAR;
            PG8_LDA(At, 0, 1); PG8_STAGE(PG8_SA(0, 0), a2, voffA);
            PG8_BAR; PG8_WAIT_L(0); PG8_MMA(1, 0, At, B0); PG8_BAR; PG8_SCHED;
            PG8_STAGE(PG8_SB(0, 1), b2 + hstep, voffB);
            PG8_WAIT_V(6); PG8_BAR; PG8_MMA(1, 1, At, B1); PG8_BAR;
            PG8_LDB(B0, 1, 0); PG8_SCHED; PG8_LDA(At, 1, 0); PG8_STAGE(PG8_SA(0, 1), a2 + hstep, voffA);
            PG8_WAIT_L(8); PG8_BAR; PG8_WAIT_L(0); PG8_MMA(0, 0, At, B0); PG8_BAR; PG8_SCHED;
            PG8_LDB(B1, 1, 1); PG8_STAGE(PG8_SB(1, 0), b3, voffB);
            PG8_BAR; PG8_WAIT_L(0); PG8_MMA(0, 1, At, B1); PG8_BAR;
            PG8_LDA(At, 1, 1); PG8_STAGE(PG8_SA(1, 0), a3, voffA);
            PG8_BAR; PG8_WAIT_L(0); PG8_MMA(1, 0, At, B0); PG8_BAR; PG8_SCHED;
            PG8_STAGE(PG8_SB(1, 1), b3 + hstep, voffB);
            PG8_WAIT_V(6); PG8_BAR; PG8_MMA(1, 1, At, B1); PG8_BAR;
            }
        }
        if constexpr (ALIGN_EPI) { if (wr == 0) PG8_BAR; }
        if constexpr (!Epi::AFTER_DRAIN) { E(acc, cur, wr, wc, fr, fq); S.done(cur); }
        if (!has_next) break;
#pragma unroll
        for (int a = 0; a < 2; ++a)
#pragma unroll
            for (int b = 0; b < 2; ++b)
#pragma unroll
                for (int m = 0; m < 4; ++m)
#pragma unroll
                    for (int n = 0; n < 2; ++n) acc[a][b][m][n] = (f32x4){0.f, 0.f, 0.f, 0.f};
        cur = nxt; cA = nA; cB = nB; ++ui;
        if constexpr (ALIGN_EPI) { if (wr == 1) PG8_BAR; }
    }
    PG8_WAIT_V(0);
    if constexpr (!ALIGN_EPI) { if (wr == 0) PG8_BAR; }
    PG8_BAR;
    if constexpr (Epi::AFTER_DRAIN) { E.fused(acc, cur, wr, wc, fr, fq, lds, wid, lane); S.done(cur); }
#undef PG8_SA
#undef PG8_SB
#undef PG8_STAGE
#undef PG8_LDA
#undef PG8_LDB
#undef PG8_MMA
#undef PG8_WAIT_V
#undef PG8_WAIT_L
#undef PG8_BAR
#undef PG8_SCHED
}
}

constexpr int NWAVES = 8;
constexpr int D = 1024, MPROMPT = 16384, MSAMPLE = 512, MTOT = MPROMPT + MSAMPLE;
constexpr int SEQ = 4096, NB = 4, NDEC = 128, TDEC = 4;
constexpr int N0 = 3584, N1 = 4096;
constexpr size_t MiB = 1u << 20;
constexpr size_t WS_CTL = 0, CTL_ZERO_BYTES = 1 * MiB;
constexpr size_t WS_W0T = 2 * MiB, WS_WO0T = 10 * MiB, WS_W1T = 12 * MiB, WS_WO1T = 20 * MiB;
constexpr size_t WS_RSTD0 = 22 * MiB, WS_LB = 23 * MiB, WS_KMP = 24 * MiB, WS_SSQ = 26 * MiB;
constexpr size_t WS_XB = 64 * MiB, WS_Q = 128 * MiB, WS_K = 160 * MiB, WS_V = 192 * MiB, WS_GA = 224 * MiB, WS_U = 256 * MiB, WS_GC = 288 * MiB;
constexpr size_t WS_M0 = 320 * MiB, WS_X1 = 384 * MiB, WS_XB1 = 464 * MiB, WS_QQ = 512 * MiB, WS_LOGF = 576 * MiB, WS_VV = 656 * MiB, WS_GS = 704 * MiB;
constexpr size_t WS_M1 = 752 * MiB, WS_OLOC = 800 * MiB, WS_QBS = 880 * MiB, WS_USEG = 928 * MiB, WS_DSEG = 952 * MiB, WS_SC = 960 * MiB, WS_KMS = 1000 * MiB, WS_END = 1024 * MiB;
constexpr int CW_BAR = 4096;
constexpr int RING_BYTES = 131072, LDSCTL_OFF = RING_BYTES, MISC_OFF = LDSCTL_OFF + 320, LDS_BYTES = 147456;

#define GAS __attribute__((address_space(1)))
#define LAS __attribute__((address_space(3)))
typedef unsigned short bf16;
typedef unsigned v4u __attribute__((ext_vector_type(4)));
typedef float f32x4 __attribute__((ext_vector_type(4)));
typedef short bf16x8 __attribute__((ext_vector_type(8)));
#define LDS_WAIT() asm volatile("s_waitcnt lgkmcnt(0)" ::: "memory")
#define VM_WAIT() asm volatile("s_waitcnt vmcnt(0)" ::: "memory")
__device__ __forceinline__ unsigned f2bf(float f) { unsigned u = __builtin_bit_cast(unsigned, f); return (u + 0x7fffu + ((u >> 16) & 1u)) >> 16; }
__device__ __forceinline__ unsigned pk2(float lo, float hi) { return f2bf(lo) | (f2bf(hi) << 16); }
__device__ __forceinline__ float bf2f(unsigned short b) { return __builtin_bit_cast(float, ((unsigned)b) << 16); }
__device__ __forceinline__ float wave_sum(float v) {
#pragma unroll
    for (int o = 1; o < 64; o <<= 1) v += __shfl_xor(v, o);
    return v;
}
#define XB_TMO      128
#define XB_XCNT(j)  (256  + 64 * (j))
#define XB_XSUB(j)  (1280 + 64 * (j))
#define XB_XGEN(j)  (2304 + 64 * (j))
#define XB_TOP      3328
#define XB_TOPGEN   3392
#define XCD_BAR_WORDS 3456
#define XB_SPIN_CAP (1u << 18)
#define LAS __attribute__((address_space(3)))

__device__ __forceinline__ unsigned xb_ld(unsigned* p)              { return __hip_atomic_load(p, __ATOMIC_RELAXED, __HIP_MEMORY_SCOPE_AGENT); }
__device__ __forceinline__ unsigned xb_add(unsigned* p, unsigned v) { return __hip_atomic_fetch_add(p, v, __ATOMIC_RELAXED, __HIP_MEMORY_SCOPE_AGENT); }
__device__ __forceinline__ unsigned xb_xcc_id() { return (unsigned)__builtin_amdgcn_s_getreg((3 << 11) | 20) & 0xFu; }
#define XB_SPIN(cond, bar) do { unsigned _sp = 0; while (cond) { __builtin_amdgcn_s_sleep(1); \
    if ((++_sp & 255u) == 0u) { if (xb_ld(&(bar)[XB_TMO])) break; if (_sp > XB_SPIN_CAP) { atomicAdd(&(bar)[XB_TMO], 1u); break; } } } } while (0)

struct XcdBarrier {
    unsigned* bar; unsigned x;
    volatile LAS unsigned* st;
};

__device__ __forceinline__ XcdBarrier xcd_barrier_post(unsigned* bar, volatile LAS unsigned* st) {
    XcdBarrier b; b.bar = bar; b.x = xb_xcc_id(); b.st = st;
    if (threadIdx.x == 0) (void)xb_add(&bar[XB_XCNT(b.x)], 1u);
    return b;
}
__device__ __forceinline__ void xcd_barrier_complete(unsigned* bar, unsigned x, unsigned& nloc, unsigned& nx) {
    const unsigned G = gridDim.x * gridDim.y * gridDim.z;
    unsigned sum, cnt, mine, sp = 0u;
    for (;;) {
        sum = 0u; cnt = 0u; mine = 0u;
#pragma unroll
        for (unsigned j = 0; j < 16; ++j) { const unsigned c = xb_ld(&bar[XB_XCNT(j)]); sum += c; cnt += (c > 0u) ? 1u : 0u; mine = (j == x) ? c : mine; }
        if (sum == G) break;
        __builtin_amdgcn_s_sleep(1);
        if ((++sp & 255u) == 0u) { if (xb_ld(&bar[XB_TMO])) break; if (sp > XB_SPIN_CAP) { atomicAdd(&bar[XB_TMO], 1u); break; } }
    }
    nloc = mine > 0u ? mine : 1u; nx = cnt > 0u ? cnt : 1u;
}

__device__ __forceinline__ void xcd_barrier(const XcdBarrier& b) {
    asm volatile("s_waitcnt vmcnt(0)" ::: "memory");
    __syncthreads();
    if (threadIdx.x == 0) {
        unsigned* bar = b.bar;
        __builtin_amdgcn_s_waitcnt(0);
        unsigned nloc = b.st[0], nx = b.st[1];
        if (nloc == 0u) { xcd_barrier_complete(bar, b.x, nloc, nx); b.st[0] = nloc; b.st[1] = nx; }
        const unsigned old = xb_add(&bar[XB_XSUB(b.x)], 1u);
        const unsigned gen = old / nloc;
        if (old + 1u == (gen + 1u) * nloc) {
            __builtin_amdgcn_fence(__ATOMIC_RELEASE, "agent");
            asm volatile("s_waitcnt vmcnt(0)" ::: "memory");
            const unsigned og = xb_add(&bar[XB_TOP], 1u);
            const unsigned tg = og / nx;
            if (og + 1u == (tg + 1u) * nx) xb_add(&bar[XB_TOPGEN], 1u);
            else XB_SPIN(xb_ld(&bar[XB_TOPGEN]) == tg, bar);
            __builtin_amdgcn_fence(__ATOMIC_ACQUIRE, "agent");
            xb_add(&bar[XB_XGEN(b.x)], 1u);
            asm volatile("s_waitcnt vmcnt(0)" ::: "memory");
        } else {
            XB_SPIN(xb_ld(&bar[XB_XGEN(b.x)]) == gen, bar);
            __builtin_amdgcn_fence(__ATOMIC_ACQUIRE, "agent");
            asm volatile("s_waitcnt vmcnt(0)" ::: "memory");
        }
    }
    __syncthreads();
}

constexpr size_t O_Y = 0, O_KP = 17301504, O_VP = O_KP + 8388608, O_KS = O_VP + 8388608, O_VS = O_KS + 262144, O_CP = O_VS + 262144, O_CS = O_CP + 61440, O_HP = O_CS + 1966080, O_HS = O_HP + 524288, O_END = O_HS + 16777216;
enum { I_XP = 0, I_XS, I_CK, I_CV, I_SCONV, I_SHGRN, I_PT, I_NORM0, I_WIN0, I_QN, I_KN, I_CW, I_CB, I_LNG, I_LNB, I_WOUT0, I_NORM1, I_WIN1, I_LBL, I_ONORM, I_WOUT1, N_IN };
struct Args { const void* in[N_IN]; float* out; unsigned char* ws; };

__device__ __forceinline__ void p0_transpose_item(const float* W, int K, int N, bf16* WT, int k0, int n0, int drow0, const float* gain, LAS float* scr, int lane) {
#pragma unroll 8
    for (int i = 0; i < 32; ++i) { const int kk = 2 * i + (lane >> 5); const float gsc = gain ? gain[k0 + kk] : 1.0f; scr[kk * 33 + (lane & 31)] = W[(size_t)(k0 + kk) * N + n0 + (lane & 31)] * gsc; }
    LDS_WAIT(); asm volatile("" ::: "memory");
    const int c = lane & 7;
#pragma unroll
    for (int j = 0; j < 4; ++j) { const int n = (lane >> 3) + 8 * j; const LAS float* s = scr + (8 * c) * 33 + n;
        v4u o; o.x = pk2(s[0 * 33], s[1 * 33]); o.y = pk2(s[2 * 33], s[3 * 33]); o.z = pk2(s[4 * 33], s[5 * 33]); o.w = pk2(s[6 * 33], s[7 * 33]);
        *(GAS v4u*)(WT + (size_t)(drow0 + n) * K + k0 + 8 * c) = o; }
    LDS_WAIT(); asm volatile("" ::: "memory");
}
__device__ __forceinline__ int l0_src_group(int dg) {
    const int pnD = dg >> 3, gi = dg & 7, bj = gi >> 2, wc = gi & 3;
    if (pnD >= 8 && pnD < 12) return (bj ? 80 : 64) + 4 * (pnD - 8) + wc;
    return 8 * pnD + 2 * wc + bj;
}

__global__ void __launch_bounds__(NWAVES * 64, 2) fwd(Args args) {
    extern __shared__ __attribute__((aligned(16))) unsigned char lds_raw[];
    LAS unsigned char* lds = (LAS unsigned char*)lds_raw;
    volatile LAS unsigned* MISC = (volatile LAS unsigned*)(lds + MISC_OFF);
    const int tid = threadIdx.x, lane = tid & 63, wave = __builtin_amdgcn_readfirstlane(tid >> 6);
    const int G = gridDim.x; const int bx = blockIdx.x; const int vcu = (G % 8 == 0) ? (bx % 8) * (G / 8) + bx / 8 : bx;
    unsigned char* ws = args.ws;
    for (int u = tid; u < (LDS_BYTES - LDSCTL_OFF) / 4; u += NWAVES * 64) ((LAS unsigned*)(lds + LDSCTL_OFF))[u] = 0u;
    __syncthreads();
    XcdBarrier bar = xcd_barrier_post((unsigned*)(ws + WS_CTL) + CW_BAR, MISC + 8);

    const float* x_prompt = (const float*)args.in[I_XP]; const float* x_sample = (const float*)args.in[I_XS];
    float* out = args.out;
    bf16* W0T = (bf16*)(ws + WS_W0T); bf16* WO0T = (bf16*)(ws + WS_WO0T); bf16* W1T = (bf16*)(ws + WS_W1T); bf16* WO1T = (bf16*)(ws + WS_WO1T);
    float* RSTD0 = (float*)(ws + WS_RSTD0); float* LB = (float*)(ws + WS_LB); float* KMP = (float*)(ws + WS_KMP); float* SSQ = (float*)(ws + WS_SSQ);
    bf16* XB = (bf16*)(ws + WS_XB); bf16* Qb = (bf16*)(ws + WS_Q); bf16* Kb = (bf16*)(ws + WS_K); bf16* Vb = (bf16*)(ws + WS_V);
    bf16* GA = (bf16*)(ws + WS_GA); bf16* Ub = (bf16*)(ws + WS_U); bf16* GC = (bf16*)(ws + WS_GC);

    {
        LAS float* scr = (LAS float*)(lds + wave * 16384);
        const int gw = vcu * NWAVES + wave, NGW = G * NWAVES;
        constexpr int I0 = 16 * (N0 / 32), IO = 16 * 32, I1 = 16 * (N1 / 32);
        constexpr int NITEMS = I0 + IO + I1 + IO;
        for (int it = gw; it < NITEMS; it += NGW) {
            int r = it;
            if (r < I0) { const int kb = r / (N0 / 32), dg = r % (N0 / 32); p0_transpose_item((const float*)args.in[I_WIN0], D, N0, W0T, 64 * kb, 32 * l0_src_group(dg), 32 * dg, (const float*)args.in[I_NORM0], scr, lane); continue; } r -= I0;
            if (r < IO) { const int kb = r / 32, dg = r % 32; p0_transpose_item((const float*)args.in[I_WOUT0], D, D, WO0T, 64 * kb, 32 * dg, 32 * dg, nullptr, scr, lane); continue; } r -= IO;
            if (r < I1) { const int kb = r / (N1 / 32), dg = r % (N1 / 32); p0_transpose_item((const float*)args.in[I_WIN1], D, N1, W1T, 64 * kb, 32 * dg, 32 * dg, (const float*)args.in[I_NORM1], scr, lane); continue; } r -= I1;
            { const int kb = r / 32, dg = r % 32; p0_transpose_item((const float*)args.in[I_WOUT1], D, D, WO1T, 64 * kb, 32 * dg, 32 * dg, nullptr, scr, lane); }
        }
        for (int m = gw; m < MTOT; m += NGW) {
            const float* xrow = m < MPROMPT ? x_prompt + (size_t)m * D : x_sample + (size_t)(m - MPROMPT) * D;
            const GAS f32x4* xr = (const GAS f32x4*)xrow + lane;
            f32x4 v[4]; float s = 0.f;
#pragma unroll
            for (int j = 0; j < 4; ++j) { v[j] = xr[64 * j]; s += (v[j].x * v[j].x + v[j].y * v[j].y) + (v[j].z * v[j].z + v[j].w * v[j].w); }
            s = wave_sum(s);
            if (lane == 0) RSTD0[m] = __builtin_amdgcn_rsqf(s * (1.0f / D) + 1e-6f);
            GAS unsigned long long* o8 = (GAS unsigned long long*)(XB + (size_t)m * D) + lane;
#pragma unroll
            for (int j = 0; j < 4; ++j) o8[64 * j] = (unsigned long long)pk2(v[j].x, v[j].y) | ((unsigned long long)pk2(v[j].z, v[j].w) << 32);
        }
        { const int gt = vcu * (NWAVES * 64) + tid; if (gt < 1024) { const float* l = (const float*)args.in[I_LBL]; LB[gt] = 1.0f / (1.0f + __expf(l[gt] - l[1024 + gt])); } }
        { const f32x4* sc = (const f32x4*)args.in[I_SCONV]; f32x4* cs = (f32x4*)(out + O_CS);
          for (int i = vcu * (NWAVES * 64) + tid; i < NDEC * 26 * 128; i += G * NWAVES * 64) { const int n = i / (26 * 128), rem = i % (26 * 128); cs[(size_t)n * 30 * 128 + rem] = sc[(size_t)n * 30 * 128 + 4 * 128 + rem]; } }
    }
    xcd_barrier(bar);

    {
        pg8::Gemm g{XB, W0T, MTOT, N0, D}; pg8::StaticOrder S; S.init(MTOT, N0, G, bx);
        pg8::EpiIn0 E{RSTD0, (const float*)args.in[I_QN], (const float*)args.in[I_KN], Qb, Kb, Vb, GA, Ub, GC,
                      out + O_KP, out + O_VP, out + O_KS, out + O_VS, out + O_CP, out + O_CS, KMP};
        pg8::gemm_phase<pg8::EpiIn0, pg8::StaticOrder, true, true>(lds, g, S, E);
    }
    xcd_barrier(bar);
}


namespace gold {
constexpr int MT = 16896, MPR = 16384;
constexpr size_t GB = (size_t)1024 << 20;
constexpr size_t G_H = GB, G_Z = G_H + ((size_t)72 << 20), G_KM = G_Z + ((size_t)280 << 20), G_OA = G_KM + ((size_t)1 << 20), G_OC = G_OA + ((size_t)36 << 20),
                 G_M = G_OC + ((size_t)36 << 20), G_X1 = G_M + ((size_t)72 << 20), G_O = G_X1 + ((size_t)72 << 20), G_END = G_O + ((size_t)72 << 20);
__device__ __forceinline__ float wsum(float v) {
#pragma unroll
    for (int o = 1; o < 64; o <<= 1) v += __shfl_xor(v, o);
    return v;
}
__device__ __forceinline__ float wmax(float v) {
#pragma unroll
    for (int o = 1; o < 64; o <<= 1) v = fmaxf(v, __shfl_xor(v, o));
    return v;
}
__device__ __forceinline__ float sigm(float x) { return 1.0f / (1.0f + expf(-x)); }
__device__ __forceinline__ float silu(float x) { return x * sigm(x); }

__global__ void __launch_bounds__(256) rms_rows(const float* s0, const float* s1, int split, const float* g, float* H) {
    __shared__ float red[4];
    const int m = blockIdx.x, t = threadIdx.x;
    const float* src = m < split ? s0 + (size_t)m * 1024 : s1 + (size_t)(m - split) * 1024;
    float v[4]; float ss = 0.f;
    for (int j = 0; j < 4; ++j) { v[j] = src[t + 256 * j]; ss += v[j] * v[j]; }
    ss = wsum(ss); if ((t & 63) == 0) red[t >> 6] = ss; __syncthreads();
    const float tot = red[0] + red[1] + red[2] + red[3];
    const float rs = 1.0f / sqrtf(tot * (1.0f / 1024.0f) + 1e-6f);
    for (int j = 0; j < 4; ++j) H[(size_t)m * 1024 + t + 256 * j] = v[j] * rs * g[t + 256 * j];
}
__global__ void __launch_bounds__(256) sgemm(const float* A, const float* B, float* C, const float* r0, const float* r1, int rsplit, int M, int N, int K) {
    __shared__ float As[16][68]; __shared__ float Bs[16][64];
    const int t = threadIdx.x, tx = t & 15, ty = t >> 4;
    const int bm = blockIdx.y * 64, bn = blockIdx.x * 64;
    float acc[4][4];
#pragma unroll
    for (int i = 0; i < 4; ++i)
#pragma unroll
        for (int j = 0; j < 4; ++j) acc[i][j] = 0.f;
    for (int k0 = 0; k0 < K; k0 += 16) {
        { const int r = t >> 2, c4 = (t & 3) * 4; const float4 a = *(const float4*)(A + (size_t)(bm + r) * K + k0 + c4); As[c4 + 0][r] = a.x; As[c4 + 1][r] = a.y; As[c4 + 2][r] = a.z; As[c4 + 3][r] = a.w; }
        { const int r = t >> 4, c4 = (t & 15) * 4; *(float4*)&Bs[r][c4] = *(const float4*)(B + (size_t)(k0 + r) * N + bn + c4); }
        __syncthreads();
#pragma unroll
        for (int kk = 0; kk < 16; ++kk) {
            float a[4], b[4];
#pragma unroll
            for (int i = 0; i < 4; ++i) { a[i] = As[kk][ty * 4 + i]; b[i] = Bs[kk][tx * 4 + i]; }
#pragma unroll
            for (int i = 0; i < 4; ++i)
#pragma unroll
                for (int j = 0; j < 4; ++j) acc[i][j] += a[i] * b[j];
        }
        __syncthreads();
    }
#pragma unroll
    for (int i = 0; i < 4; ++i) {
        const int m = bm + ty * 4 + i;
        const float* rr = r0 ? (m < rsplit ? r0 + (size_t)m * N : r1 + (size_t)(m - rsplit) * N) : nullptr;
#pragma unroll
        for (int j = 0; j < 4; ++j) { const int n = bn + tx * 4 + j; C[(size_t)m * N + n] = acc[i][j] + (rr ? rr[n] : 0.f); }
    }
}
__global__ void __launch_bounds__(256) post0(float* Z, const float* qg, const float* kg, const float* state_conv, float* out) {
    const int m = blockIdx.x, t = threadIdx.x, w = t >> 6, l = t & 63;
    float* z = Z + (size_t)m * 3584;
    const bool sample = m >= MPR; const int ms = m - MPR;
    float* kout = sample ? out + O_KS + (size_t)ms * 512 : out + O_KP + (size_t)m * 512;
    float* vout = sample ? out + O_VS + (size_t)ms * 512 : out + O_VP + (size_t)m * 512;
    for (int idx = w; idx < 16; idx += 4) {
        const float v = z[idx * 64 + l]; const float ss = wsum(v * v);
        const float o = v * (1.0f / sqrtf(ss * (1.0f / 64.0f) + 1e-6f)) * (idx < 8 ? qg[l] : kg[l]);
        z[idx * 64 + l] = o; if (idx >= 8) kout[(idx - 8) * 64 + l] = o;
    }
    for (int c = t; c < 512; c += 256) {
        vout[c] = z[1024 + c];
        const float u = z[2048 + c] * sigm(z[2560 + c]); z[2048 + c] = u;
        if (!sample) { const int tok = m & 4095, b = m >> 12; if (tok >= 4066) out[O_CP + ((size_t)b * 30 + (tok - 4066)) * 512 + c] = u; }
        else { const int n = ms >> 2, tt = ms & 3; out[O_CS + ((size_t)n * 30 + 26 + tt) * 512 + c] = u; }
    }
    if (sample && (ms & 3) == 0) { const int n = ms >> 2; for (int i = t; i < 26 * 512; i += 256) out[O_CS + (size_t)n * 30 * 512 + i] = state_conv[(size_t)n * 30 * 512 + 4 * 512 + i]; }
}
__global__ void __launch_bounds__(512) kmean_prompt(const float* Z, float* KM) {
    const int pb = blockIdx.x, c = threadIdx.x; float s = 0.f;
    for (int r = 0; r < 256; ++r) s += Z[(size_t)(pb * 256 + r) * 3584 + 512 + c];
    KM[pb * 512 + c] = s * (1.0f / 256.0f);
}
__global__ void __launch_bounds__(512) attn_prompt(const float* Z, const float* KM, float* OA) {
    __shared__ float sc[8][1280]; __shared__ float qs[8][64];
    const int m = blockIdx.x, b = m >> 12, tok = m & 4095, j = tok >> 8, h = threadIdx.x >> 6, l = threadIdx.x & 63;
    const float q = Z[(size_t)m * 3584 + h * 64 + l]; qs[h][l] = q;
    int s0 = 0, s1 = 1, s2 = 2, nsel = j;
    if (j > 3) {
        float g0 = -INFINITY, g1 = -INFINITY, g2 = -INFINITY; s0 = -1; s1 = -1; s2 = -1;
        for (int n = 0; n < j; ++n) {
            const float g = wsum(q * KM[(b * 16 + n) * 512 + h * 64 + l]);
            if (g > g0) { g2 = g1; s2 = s1; g1 = g0; s1 = s0; g0 = g; s0 = n; }
            else if (g > g1) { g2 = g1; s2 = s1; g1 = g; s1 = n; }
            else if (g > g2) { g2 = g; s2 = n; }
        }
        nsel = 3;
    }
    __syncthreads();
    const int nown = tok - j * 256 + 1, ntot = nsel * 256 + nown;
    float mx = -INFINITY;
    for (int i = l; i < ntot; i += 64) {
        const int seg = i >> 8; const int sb = seg == 0 ? s0 : (seg == 1 ? s1 : s2); const int pos = seg < nsel ? sb * 256 + (i & 255) : j * 256 + (i - nsel * 256);
        const float4* kr = (const float4*)(Z + (size_t)(b * 4096 + pos) * 3584 + 512 + h * 64); float s = 0.f;
        for (int d = 0; d < 16; ++d) { const float4 kv = kr[d]; s += qs[h][4 * d] * kv.x + qs[h][4 * d + 1] * kv.y + qs[h][4 * d + 2] * kv.z + qs[h][4 * d + 3] * kv.w; }
        s *= 0.125f; sc[h][i] = s; mx = fmaxf(mx, s);
    }
    mx = wmax(mx); float ls = 0.f;
    for (int i = l; i < ntot; i += 64) { const float p = expf(sc[h][i] - mx); sc[h][i] = p; ls += p; }
    ls = wsum(ls);
    __syncthreads();
    float o = 0.f;
    for (int i = 0; i < ntot; ++i) {
        const int seg = i >> 8; const int sb = seg == 0 ? s0 : (seg == 1 ? s1 : s2); const int pos = seg < nsel ? sb * 256 + (i & 255) : j * 256 + (i - nsel * 256);
        o += sc[h][i] * Z[(size_t)(b * 4096 + pos) * 3584 + 1024 + h * 64 + l];
    }
    OA[(size_t)m * 512 + h * 64 + l] = o / ls;
}
__global__ void __launch_bounds__(256) attn_sample(const float* Z, const float* ck, const float* cv, const int* pt, float* OA) {
    __shared__ float km[8][64]; __shared__ float part[4][64]; __shared__ float sc[4][800]; __shared__ float qs[4][64];
    const int n = blockIdx.x >> 3, h = blockIdx.x & 7, w = threadIdx.x >> 6, l = threadIdx.x & 63;
    for (int blk = 0; blk < 8; ++blk) {
        float s = 0.f;
        for (int r = w; r < 256; r += 4) { const int page = pt[n * 16 + blk * 2 + (r >> 7)]; s += ck[(((size_t)page * 128 + (r & 127)) * 8 + h) * 64 + l]; }
        part[w][l] = s; __syncthreads();
        if (w == 0) km[blk][l] = (part[0][l] + part[1][l] + part[2][l] + part[3][l]) * (1.0f / 256.0f);
        __syncthreads();
    }
    const int t = w; const int m = MPR + n * 4 + t;
    const float q = Z[(size_t)m * 3584 + h * 64 + l]; qs[t][l] = q;
    int s0 = -1, s1 = -1, s2 = -1; float g0 = -INFINITY, g1 = -INFINITY, g2 = -INFINITY;
    for (int blk = 0; blk < 8; ++blk) {
        const float g = wsum(q * km[blk][l]);
        if (g > g0) { g2 = g1; s2 = s1; g1 = g0; s1 = s0; g0 = g; s0 = blk; }
        else if (g > g1) { g2 = g1; s2 = s1; g1 = g; s1 = blk; }
        else if (g > g2) { g2 = g; s2 = blk; }
    }
    __syncthreads();
    const int ntot = 768 + t + 1; float mx = -INFINITY;
    for (int i = l; i < ntot; i += 64) {
        const float* kr;
        if (i < 768) { const int sg = i >> 8; const int blk = sg == 0 ? s0 : (sg == 1 ? s1 : s2), r = i & 255; const int page = pt[n * 16 + blk * 2 + (r >> 7)]; kr = ck + (((size_t)page * 128 + (r & 127)) * 8 + h) * 64; }
        else kr = Z + (size_t)(MPR + n * 4 + (i - 768)) * 3584 + 512 + h * 64;
        float s = 0.f; for (int d = 0; d < 64; ++d) s += qs[t][d] * kr[d];
        s *= 0.125f; sc[t][i] = s; mx = fmaxf(mx, s);
    }
    mx = wmax(mx); float ls = 0.f;
    for (int i = l; i < ntot; i += 64) { const float p = expf(sc[t][i] - mx); sc[t][i] = p; ls += p; }
    ls = wsum(ls);
    __syncthreads();
    float o = 0.f;
    for (int i = 0; i < ntot; ++i) {
        float vv;
        if (i < 768) { const int sg = i >> 8; const int blk = sg == 0 ? s0 : (sg == 1 ? s1 : s2), r = i & 255; const int page = pt[n * 16 + blk * 2 + (r >> 7)]; vv = cv[(((size_t)page * 128 + (r & 127)) * 8 + h) * 64 + l]; }
        else vv = Z[(size_t)(MPR + n * 4 + (i - 768)) * 3584 + 1024 + h * 64 + l];
        o += sc[t][i] * vv;
    }
    OA[(size_t)m * 512 + h * 64 + l] = o / ls;
}
__global__ void __launch_bounds__(512) conv_rows(const float* Z, const float* state_conv, const float* cw, const float* cb, const float* lg, const float* lb, float* OC) {
    __shared__ float red[8]; __shared__ float red2[8];
    const int m = blockIdx.x, c = threadIdx.x; float y = cb[c];
    if (m < MPR) { const int tok = m & 4095; for (int i = 0; i < 31; ++i) { const int tt = tok - 30 + i; if (tt >= 0) y += cw[i * 512 + c] * Z[(size_t)(m - 30 + i) * 3584 + 2048 + c]; } }
    else { const int ms = m - MPR, n = ms >> 2, t = ms & 3;
        for (int i = 0; i < 31; ++i) { const int tt = t - 30 + i; const float u = tt >= 0 ? Z[(size_t)(MPR + n * 4 + tt) * 3584 + 2048 + c] : state_conv[((size_t)n * 30 + (30 + tt)) * 512 + c]; y += cw[i * 512 + c] * u; } }
    float s = wsum(y); if ((c & 63) == 0) red[c >> 6] = s; __syncthreads();
    float mu = 0.f; for (int i = 0; i < 8; ++i) mu += red[i]; mu *= (1.0f / 512.0f);
    const float d = y - mu; float s2 = wsum(d * d); if ((c & 63) == 0) red2[c >> 6] = s2; __syncthreads();
    float var = 0.f; for (int i = 0; i < 8; ++i) var += red2[i]; var *= (1.0f / 512.0f);
    const float ln = d * (1.0f / sqrtf(var + 1e-6f)) * lg[c] + lb[c];
    OC[(size_t)m * 512 + c] = silu(ln);
}
__global__ void __launch_bounds__(256) mix0(const float* Z, const float* OA, const float* OC, float* M) {
    const int m = blockIdx.x;
    for (int c = threadIdx.x; c < 512; c += 256) {
        M[(size_t)m * 1024 + c] = OA[(size_t)m * 512 + c] * silu(Z[(size_t)m * 3584 + 1536 + c]);
        M[(size_t)m * 1024 + 512 + c] = OC[(size_t)m * 512 + c] * silu(Z[(size_t)m * 3584 + 3072 + c]);
    }
}
__global__ void __launch_bounds__(1024) hgrn_scan(const float* Z1, const float* LBv, const float* S0, float* Sout, float* O, int row0, int T) {
    __shared__ float qs[128], fs[128], ks[128], vs[128]; __shared__ float part[8][128];
    const int seq = blockIdx.x >> 3, h = blockIdx.x & 7, tid = threadIdx.x, kg = tid >> 7, v = tid & 127;
    float S[16];
#pragma unroll
    for (int i = 0; i < 16; ++i) S[i] = S0 ? S0[(((size_t)seq * 8 + h) * 128 + kg * 16 + i) * 128 + v] : 0.f;
    for (int t = 0; t < T; ++t) {
        const float* z = Z1 + (size_t)(row0 + seq * T + t) * 4096;
        if (tid < 128) { const float lbk = LBv[h * 128 + tid]; const float f = lbk + (1.0f - lbk) * sigm(z[1024 + h * 128 + tid]); fs[tid] = f; ks[tid] = 1.0f - f; qs[tid] = silu(z[h * 128 + tid]); vs[tid] = z[2048 + h * 128 + tid]; }
        __syncthreads();
        float po = 0.f; const float vv = vs[v];
#pragma unroll
        for (int i = 0; i < 16; ++i) { const int k = kg * 16 + i; S[i] = fs[k] * S[i] + ks[k] * vv; po += qs[k] * S[i]; }
        part[kg][v] = po; __syncthreads();
        if (tid < 128) { float o = 0.f; for (int g = 0; g < 8; ++g) o += part[g][tid]; O[(size_t)(row0 + seq * T + t) * 1024 + h * 128 + tid] = o; }
        __syncthreads();
    }
#pragma unroll
    for (int i = 0; i < 16; ++i) Sout[(((size_t)seq * 8 + h) * 128 + kg * 16 + i) * 128 + v] = S[i];
}
__global__ void __launch_bounds__(512) mix1(const float* O, const float* Z1, const float* og, float* M) {
    const int m = blockIdx.x, h = threadIdx.x >> 6, l = threadIdx.x & 63;
    const float a = O[(size_t)m * 1024 + h * 128 + l], b = O[(size_t)m * 1024 + h * 128 + 64 + l];
    const float ss = wsum(a * a + b * b); const float rs = 1.0f / sqrtf(ss * (1.0f / 128.0f) + 1e-6f);
    M[(size_t)m * 1024 + h * 128 + l] = a * rs * og[l] * silu(Z1[(size_t)m * 4096 + 3072 + h * 128 + l]);
    M[(size_t)m * 1024 + h * 128 + 64 + l] = b * rs * og[64 + l] * silu(Z1[(size_t)m * 4096 + 3072 + h * 128 + 64 + l]);
}
__global__ void lb_vec(const float* l, float* LBv) { const int i = blockIdx.x * blockDim.x + threadIdx.x; if (i < 1024) LBv[i] = 1.0f / (1.0f + expf(l[i] - l[1024 + i])); }

static void run(void* const* d_in, float* out, unsigned char* ws, hipStream_t st) {
    const float* xp = (const float*)d_in[I_XP]; const float* xs = (const float*)d_in[I_XS];
    float* H = (float*)(ws + G_H); float* Z = (float*)(ws + G_Z); float* KM = (float*)(ws + G_KM); float* OA = (float*)(ws + G_OA); float* OC = (float*)(ws + G_OC);
    float* M = (float*)(ws + G_M); float* X1 = (float*)(ws + G_X1); float* O = (float*)(ws + G_O); float* LBv = KM + 64 * 512;
    rms_rows<<<MT, 256, 0, st>>>(xp, xs, MPR, (const float*)d_in[I_NORM0], H);
    sgemm<<<dim3(3584 / 64, MT / 64), 256, 0, st>>>(H, (const float*)d_in[I_WIN0], Z, nullptr, nullptr, 0, MT, 3584, 1024);
    post0<<<MT, 256, 0, st>>>(Z, (const float*)d_in[I_QN], (const float*)d_in[I_KN], (const float*)d_in[I_SCONV], out);
    kmean_prompt<<<64, 512, 0, st>>>(Z, KM);
    attn_prompt<<<MPR, 512, 0, st>>>(Z, KM, OA);
    attn_sample<<<128 * 8, 256, 0, st>>>(Z, (const float*)d_in[I_CK], (const float*)d_in[I_CV], (const int*)d_in[I_PT], OA);
    conv_rows<<<MT, 512, 0, st>>>(Z, (const float*)d_in[I_SCONV], (const float*)d_in[I_CW], (const float*)d_in[I_CB], (const float*)d_in[I_LNG], (const float*)d_in[I_LNB], OC);
    mix0<<<MT, 256, 0, st>>>(Z, OA, OC, M);
    sgemm<<<dim3(1024 / 64, MT / 64), 256, 0, st>>>(M, (const float*)d_in[I_WOUT0], X1, xp, xs, MPR, MT, 1024, 1024);
    rms_rows<<<MT, 256, 0, st>>>(X1, X1, MT, (const float*)d_in[I_NORM1], H);
    sgemm<<<dim3(4096 / 64, MT / 64), 256, 0, st>>>(H, (const float*)d_in[I_WIN1], Z, nullptr, nullptr, 0, MT, 4096, 1024);
    lb_vec<<<4, 256, 0, st>>>((const float*)d_in[I_LBL], LBv);
    hgrn_scan<<<4 * 8, 1024, 0, st>>>(Z, LBv, nullptr, out + O_HP, O, 0, 4096);
    hgrn_scan<<<128 * 8, 1024, 0, st>>>(Z, LBv, (const float*)d_in[I_SHGRN], out + O_HS, O, MPR, 4);
    mix1<<<MT, 512, 0, st>>>(O, Z, (const float*)d_in[I_ONORM], M);
    sgemm<<<dim3(1024 / 64, MT / 64), 256, 0, st>>>(M, (const float*)d_in[I_WOUT1], out + O_Y, X1, X1, MT, MT, 1024, 1024);
}
}

extern "C" void kernel_launch(void* const* d_in, const int* in_sizes, int n_in, void* d_out, int out_size, void* d_ws, size_t ws_size, hipStream_t stream) {
    if (n_in != N_IN || (size_t)out_size != O_END || ws_size < gold::G_END) { fprintf(stderr, "kernel_launch: unexpected shapes (n_in %d out %d ws %zu)\n", n_in, out_size, ws_size); return; }
    gold::run(d_in, (float*)d_out, (unsigned char*)d_ws, stream);
}
```

```cpp
#include <hip/hip_runtime.h>
#include <cstdio>
#include <cstdint>
namespace pg8 {
#define PG8_LAS __attribute__((address_space(3)))
typedef unsigned short bf16_t;
typedef short bf16x8 __attribute__((ext_vector_type(8)));
typedef float f32x4 __attribute__((ext_vector_type(4)));
typedef unsigned u32x4 __attribute__((ext_vector_type(4)));
constexpr int BM = 256, BK = 64, HALF = 128, HTB = HALF * BK * 2  , STAGE_BYTES = 8 * HTB, NXCD = 8, WGM = 8;

__host__ __device__ __forceinline__ int lds_byte(int r, int c) { const int st = (r >> 4) * 2 + (c >> 5), rr = r & 15, cc = c & 31, ob = rr * 64 + cc * 2; return st * 1024 + (ob ^ (((ob >> 9) & 1) << 5)); }
__host__ __device__ __forceinline__ void stage_rc(int b, int& R, int& C) { const int st = b / 1024, sb = b % 1024, swz = sb ^ (((sb >> 9) & 1) << 5); R = (st >> 1) * 16 + swz / 64; C = (st & 1) * 32 + (swz % 64) / 2; }
__host__ __device__ __forceinline__ int perm32(int rho) { const int n = rho >> 4, i = rho & 15; return 8 * (i >> 2) + 4 * n + (i & 3); }

struct Unit { int pm, pn; };
struct Gemm { const bf16_t* A; const bf16_t* Bt; int M, N, K; };

struct StaticOrder {
    int nM, nN, nwg, G, c;
    __host__ __device__ void init(int M, int N, int G_, int c_) { nM = M / BM; nN = N / BM; nwg = nM * nN; G = G_; c = c_; }
    __host__ __device__ bool next(int i, Unit& u) const {
        const long L = (long)i * G + c; if (L >= nwg) return false;
        int wgid = (int)L; { const int q = nwg / NXCD, r = nwg % NXCD, xcd = wgid % NXCD, off = wgid / NXCD; wgid = (xcd < r ? xcd * (q + 1) : r * (q + 1) + (xcd - r) * q) + off; }
        const int nig = WGM * nN, gid = wgid / nig, fm = gid * WGM, gsz = (nM - fm) < WGM ? (nM - fm) : WGM;
        u.pm = fm + ((wgid % nig) % gsz); u.pn = (wgid % nig) / gsz; return true;
    }
    __device__ __forceinline__ void a_ready(const Unit&) const {}
    __device__ __forceinline__ void done(const Unit&) const {}
};
__device__ __forceinline__ unsigned cvt_pk_bf16(float lo, float hi) { unsigned r; asm volatile("v_cvt_pk_bf16_f32 %0, %1, %2" : "=v"(r) : "v"(lo), "v"(hi)); return r; }
typedef float f32x2 __attribute__((ext_vector_type(2)));
typedef unsigned u32x2 __attribute__((ext_vector_type(2)));
__device__ __forceinline__ float fsigmoid(float x) { return __builtin_amdgcn_rcpf(1.0f + __builtin_amdgcn_exp2f(-1.4426950408889634f * x)); }
__device__ __forceinline__ float fsilu(float x) { return x * fsigmoid(x); }
__device__ __forceinline__ f32x4 silu4(f32x4 v) { return (f32x4){fsilu(v[0]), fsilu(v[1]), fsilu(v[2]), fsilu(v[3])}; }
__device__ __forceinline__ f32x4 sigm4(f32x4 v) { return (f32x4){fsigmoid(v[0]), fsigmoid(v[1]), fsigmoid(v[2]), fsigmoid(v[3])}; }
__device__ __forceinline__ u32x4 pack8(f32x4 a, f32x4 b) { u32x4 w; w.x = cvt_pk_bf16(a[0], a[1]); w.y = cvt_pk_bf16(a[2], a[3]); w.z = cvt_pk_bf16(b[0], b[1]); w.w = cvt_pk_bf16(b[2], b[3]); return w; }
__device__ __forceinline__ float dot4(f32x4 a) { return (a[0] * a[0] + a[1] * a[1]) + (a[2] * a[2] + a[3] * a[3]); }

constexpr int MP = 16384;
constexpr float RMS_EPS = 1e-6f;

struct EpiIn0 {
    static constexpr bool PERM = true, AFTER_DRAIN = false;
    const float* rstd; const float* qg; const float* kg;
    bf16_t *Q, *Kb, *Vb, *GA, *U, *GC;
    float *k_prompt, *v_prompt, *k_sample, *v_sample, *conv_prompt, *conv_sample;
    float* kmp;
    __device__ __forceinline__ void operator()(const f32x4 (&acc)[2][2][4][2], const Unit& u, int wr, int wc, int fr, int fq) const {
        const int pn = u.pn;
        const int rowb = u.pm * BM + wr * 64 + fr;
        const bool sample = u.pm >= 64;
        if (pn < 4) {
            const bool isk = pn >= 2;
            const float* g = isk ? kg : qg;
            f32x4 gv[2][2];
#pragma unroll
            for (int bj = 0; bj < 2; ++bj)
#pragma unroll
                for (int n = 0; n < 2; ++n) gv[bj][n] = *(const f32x4*)(g + 32 * bj + 8 * fq + 4 * n);
            const int colb = 256 * (pn & 1) + 64 * wc + 8 * fq;
            bf16_t* ob = isk ? Kb : Q;
            float* of = sample ? (k_sample - (size_t)MP * 512) : k_prompt;
#pragma unroll
            for (int ai = 0; ai < 2; ++ai) {
                f32x4 ks[2][2];
#pragma unroll
                for (int bj = 0; bj < 2; ++bj)
#pragma unroll
                    for (int n = 0; n < 2; ++n) ks[bj][n] = (f32x4){0.f, 0.f, 0.f, 0.f};
#pragma unroll
                for (int m = 0; m < 4; ++m) {
                    const int r = rowb + ai * HALF + m * 16;
                    const float rs = rstd[r];
                    f32x4 v[2][2]; float ss = 0.f;
#pragma unroll
                    for (int bj = 0; bj < 2; ++bj)
#pragma unroll
                        for (int n = 0; n < 2; ++n) { v[bj][n] = acc[ai][bj][m][n] * rs; ss += dot4(v[bj][n]); }
                    ss += __shfl_xor(ss, 16); ss += __shfl_xor(ss, 32);
                    const float inv = __builtin_amdgcn_rsqf(ss * (1.0f / 64.0f) + RMS_EPS);
#pragma unroll
                    for (int bj = 0; bj < 2; ++bj) {
                        const f32x4 o0 = v[bj][0] * inv * gv[bj][0], o1 = v[bj][1] * inv * gv[bj][1];
                        const size_t off = (size_t)r * 512 + colb + 32 * bj;
                        *(u32x4*)(ob + off) = pack8(o0, o1);
                        if (isk) { *(f32x4*)(of + off) = o0; *(f32x4*)(of + off + 4) = o1; ks[bj][0] += o0; ks[bj][1] += o1; }
                    }
                }
                if (isk && !sample) {
#pragma unroll
                    for (int bj = 0; bj < 2; ++bj)
#pragma unroll
                        for (int n = 0; n < 2; ++n) {
                            f32x4 s = ks[bj][n];
#pragma unroll
                            for (int o = 1; o < 16; o <<= 1) { s[0] += __shfl_xor(s[0], o); s[1] += __shfl_xor(s[1], o); s[2] += __shfl_xor(s[2], o); s[3] += __shfl_xor(s[3], o); }
                            if (fr == 0) *(f32x4*)(kmp + ((size_t)(u.pm * 4 + ai * 2 + wr)) * 512 + colb + 32 * bj + 4 * n) = s;
                        }
                }
            }
        } else if (pn < 6) {
            const int colb = 256 * (pn & 1) + 64 * wc + 8 * fq;
            float* of = sample ? (v_sample - (size_t)MP * 512) : v_prompt;
#pragma unroll
            for (int ai = 0; ai < 2; ++ai)
#pragma unroll
                for (int m = 0; m < 4; ++m) {
                    const int r = rowb + ai * HALF + m * 16;
                    const float rs = rstd[r];
#pragma unroll
                    for (int bj = 0; bj < 2; ++bj) {
                        const f32x4 o0 = acc[ai][bj][m][0] * rs, o1 = acc[ai][bj][m][1] * rs;
                        const size_t off = (size_t)r * 512 + colb + 32 * bj;
                        *(u32x4*)(Vb + off) = pack8(o0, o1);
                        *(f32x4*)(of + off) = o0; *(f32x4*)(of + off + 4) = o1;
                    }
                }
        } else if (pn < 8 || pn >= 12) {
            const int colb = 256 * (pn & 1) + 64 * wc + 8 * fq;
            bf16_t* ob = pn < 8 ? GA : GC;
#pragma unroll
            for (int ai = 0; ai < 2; ++ai)
#pragma unroll
                for (int m = 0; m < 4; ++m) {
                    const int r = rowb + ai * HALF + m * 16;
                    const float rs = rstd[r];
#pragma unroll
                    for (int bj = 0; bj < 2; ++bj) {
                        const f32x4 o0 = silu4(acc[ai][bj][m][0] * rs), o1 = silu4(acc[ai][bj][m][1] * rs);
                        *(u32x4*)(ob + (size_t)r * 512 + colb + 32 * bj) = pack8(o0, o1);
                    }
                }
        } else {
            const int ch0 = 128 * (pn - 8) + 32 * wc + 8 * fq;
            const bool tailp = !sample && ((u.pm & 15) == 15);
#pragma unroll
            for (int ai = 0; ai < 2; ++ai)
#pragma unroll
                for (int m = 0; m < 4; ++m) {
                    const int r = rowb + ai * HALF + m * 16;
                    const float rs = rstd[r];
                    const f32x4 o0 = (acc[ai][0][m][0] * rs) * sigm4(acc[ai][1][m][0] * rs), o1 = (acc[ai][0][m][1] * rs) * sigm4(acc[ai][1][m][1] * rs);
                    *(u32x4*)(U + (size_t)r * 512 + ch0) = pack8(o0, o1);
                    if (tailp) { const int tok = r & 4095; if (tok >= 4066) { float* d = conv_prompt + ((size_t)((r >> 12) * 30 + (tok - 4066))) * 512 + ch0; *(f32x4*)d = o0; *(f32x4*)(d + 4) = o1; } }
                    if (sample) { const int rr = r - MP; float* d = conv_sample + ((size_t)((rr >> 2) * 30 + 26 + (rr & 3))) * 512 + ch0; *(f32x4*)d = o0; *(f32x4*)(d + 4) = o1; }
                }
        }
    }
};

struct EpiOut0 {
    static constexpr bool PERM = false, AFTER_DRAIN = false;
    const float* xp; const float* xs; float* X1; bf16_t* XB1; float* SSQ;
    __device__ __forceinline__ void operator()(const f32x4 (&acc)[2][2][4][2], const Unit& u, int wr, int wc, int fr, int fq) const {
        const int rowb = u.pm * BM + wr * 64 + fr, col0 = u.pn * BM + wc * 32 + 4 * fq;
        const float* xb = u.pm >= 64 ? xs - (size_t)MP * 1024 : xp;
#pragma unroll
        for (int ai = 0; ai < 2; ++ai)
#pragma unroll
            for (int m = 0; m < 4; ++m) {
                const int r = rowb + ai * HALF + m * 16; const size_t ro = (size_t)r * 1024 + col0; float ss = 0.f;
#pragma unroll
                for (int bj = 0; bj < 2; ++bj)
#pragma unroll
                    for (int n = 0; n < 2; ++n) {
                        const size_t o_ = ro + bj * HALF + n * 16;
                        const f32x4 o = *(const f32x4*)(xb + o_) + acc[ai][bj][m][n];
                        *(f32x4*)(X1 + o_) = o; u32x2 w; w.x = cvt_pk_bf16(o[0], o[1]); w.y = cvt_pk_bf16(o[2], o[3]); *(u32x2*)(XB1 + o_) = w; ss += dot4(o);
                    }
                ss += __shfl_xor(ss, 16); ss += __shfl_xor(ss, 32);
                if (fq == 0) SSQ[(size_t)r * 16 + u.pn * 4 + wc] = ss;
            }
    }
};
struct EpiIn1 {
    static constexpr bool PERM = true, AFTER_DRAIN = false;
    const float* SSQ; const float* LB; bf16_t *QQ, *VV, *GS; float* LOGF;
    __device__ __forceinline__ void operator()(const f32x4 (&acc)[2][2][4][2], const Unit& u, int wr, int wc, int fr, int fq) const {
        const int rowb = u.pm * BM + wr * 64 + fr, type = u.pn >> 2, cl0 = (u.pn & 3) * BM + wc * 32 + 8 * fq;
#pragma unroll
        for (int ai = 0; ai < 2; ++ai)
#pragma unroll
            for (int m = 0; m < 4; ++m) {
                const int r = rowb + ai * HALF + m * 16;
                const f32x4* sp = (const f32x4*)(SSQ + (size_t)r * 16);
                const f32x4 s0 = sp[0], s1 = sp[1], s2 = sp[2], s3 = sp[3];
                const float tot = (((s0[0] + s0[1]) + (s0[2] + s0[3])) + ((s1[0] + s1[1]) + (s1[2] + s1[3]))) + (((s2[0] + s2[1]) + (s2[2] + s2[3])) + ((s3[0] + s3[1]) + (s3[2] + s3[3])));
                const float rs = __builtin_amdgcn_rsqf(tot * (1.0f / 1024.0f) + RMS_EPS);
#pragma unroll
                for (int bj = 0; bj < 2; ++bj) {
                    const f32x4 v0 = acc[ai][bj][m][0] * rs, v1 = acc[ai][bj][m][1] * rs;
                    const int c = cl0 + bj * HALF; const size_t off = (size_t)r * 1024 + c;
                    if (type == 0) *(u32x4*)(QQ + off) = pack8(silu4(v0), silu4(v1));
                    else if (type == 1) {
                        const f32x4 l0 = *(const f32x4*)(LB + c), l1 = *(const f32x4*)(LB + c + 4);
                        const f32x4 f0 = l0 + (1.0f - l0) * sigm4(v0), f1 = l1 + (1.0f - l1) * sigm4(v1);
                        *(f32x4*)(LOGF + off) = (f32x4){__logf(f0[0]), __logf(f0[1]), __logf(f0[2]), __logf(f0[3])};
                        *(f32x4*)(LOGF + off + 4) = (f32x4){__logf(f1[0]), __logf(f1[1]), __logf(f1[2]), __logf(f1[3])};
                    }
                    else if (type == 2) *(u32x4*)(VV + off) = pack8(v0, v1);
                    else *(u32x4*)(GS + off) = pack8(silu4(v0), silu4(v1));
                }
            }
    }
};
struct EpiOut1 {
    static constexpr bool PERM = false, AFTER_DRAIN = false;
    const float* X1; float* Y;
    __device__ __forceinline__ void operator()(const f32x4 (&acc)[2][2][4][2], const Unit& u, int wr, int wc, int fr, int fq) const {
        const int rowb = u.pm * BM + wr * 64 + fr, col0 = u.pn * BM + wc * 32 + 4 * fq;
#pragma unroll
        for (int ai = 0; ai < 2; ++ai)
#pragma unroll
            for (int m = 0; m < 4; ++m) {
                const size_t ro = (size_t)(rowb + ai * HALF + m * 16) * 1024 + col0;
#pragma unroll
                for (int bj = 0; bj < 2; ++bj)
#pragma unroll
                    for (int n = 0; n < 2; ++n) { const size_t o_ = ro + bj * HALF + n * 16; *(f32x4*)(Y + o_) = *(const f32x4*)(X1 + o_) + acc[ai][bj][m][n]; }
            }
    }
};
template <class Epi, class Sched, bool ALIGN_EPI = false, bool SP2 = false>
__device__ __forceinline__ void gemm_phase(PG8_LAS unsigned char* lds, const Gemm g, const Sched& S, const Epi& E) {
    const int tid = threadIdx.x, wid = __builtin_amdgcn_readfirstlane(tid >> 6), lane = tid & 63, wr = wid >> 2, wc = wid & 3, fr = lane & 15, fq = lane >> 4;
    const int K = g.K, nt = K / BK;
    unsigned voffA[2], voffB[2];
#pragma unroll
    for (int i = 0; i < 2; ++i) { int R, C; stage_rc(tid * 16 + i * 8192, R, C); const int Rb = Epi::PERM ? ((R & ~31) + perm32(R & 31)) : R;
        voffA[i] = (unsigned)(R * K + C) * 2u; voffB[i] = (unsigned)(Rb * K + C) * 2u; }
    const size_t kstep = (size_t)(BK * 2);
    const size_t hstep = (size_t)HALF * K * 2;
    const size_t tstep = 2 * hstep;
    const unsigned ldsw = (unsigned)wid * 1024u;
    const int aoff = lds_byte(wr * 64 + fr, fq * 8), boff = lds_byte(wc * 32 + fr, fq * 8);
#define PG8_SA(b, h) (((b) * 2 + (h)) * HTB)
#define PG8_SB(b, h) ((4 + (b) * 2 + (h)) * HTB)
#define PG8_STAGE(bufoff, gbase, voff) do { _Pragma("unroll") for (int _i = 0; _i < 2; ++_i) \
        __builtin_amdgcn_global_load_lds((const unsigned*)((const char*)(gbase) + (voff)[_i]), (PG8_LAS unsigned*)(lds + (bufoff) + ldsw + _i * 8192), 16, 0, 0); } while (0)
#define PG8_LDA(dst, b, h) do { _Pragma("unroll") for (int m = 0; m < 4; ++m) _Pragma("unroll") for (int k = 0; k < 2; ++k) dst[m][k] = *(const PG8_LAS bf16x8*)(lds + PG8_SA(b, h) + aoff + m * 2048 + k * 1024); } while (0)
#define PG8_LDB(dst, b, h) do { _Pragma("unroll") for (int n = 0; n < 2; ++n) _Pragma("unroll") for (int k = 0; k < 2; ++k) dst[n][k] = *(const PG8_LAS bf16x8*)(lds + PG8_SB(b, h) + boff + n * 2048 + k * 1024); } while (0)
#define PG8_MMA(ai, bj, At, Bt) do { __builtin_amdgcn_s_setprio(1); _Pragma("unroll") for (int m = 0; m < 4; ++m) _Pragma("unroll") for (int n = 0; n < 2; ++n) _Pragma("unroll") for (int k = 0; k < 2; ++k) \
        acc[ai][bj][m][n] = __builtin_amdgcn_mfma_f32_16x16x32_bf16(Bt[n][k], At[m][k], acc[ai][bj][m][n], 0, 0, 0); __builtin_amdgcn_s_setprio(0); } while (0)
#define PG8_WAIT_V(n) asm volatile("s_waitcnt vmcnt(" #n ")" ::: "memory")
#define PG8_WAIT_L(n) asm volatile("s_waitcnt lgkmcnt(" #n ")" ::: "memory")
#define PG8_BAR __builtin_amdgcn_s_barrier()
#define PG8_SCHED __builtin_amdgcn_sched_barrier(0)
    Unit cur, nxt; int ui = 0;
    if (!S.next(0, cur)) return;
    f32x4 acc[2][2][4][2];
#pragma unroll
    for (int a = 0; a < 2; ++a)
#pragma unroll
        for (int b = 0; b < 2; ++b)
#pragma unroll
            for (int m = 0; m < 4; ++m)
#pragma unroll
                for (int n = 0; n < 2; ++n) acc[a][b][m][n] = (f32x4){0.f, 0.f, 0.f, 0.f};
    bf16x8 At[4][2], B0[2][2], B1[2][2];
    const char* cA = (const char*)g.A + (size_t)cur.pm * tstep; const char* cB = (const char*)g.Bt + (size_t)cur.pn * tstep;
    S.a_ready(cur);
    if constexpr (SP2) {
        PG8_STAGE(PG8_SB(0, 0), cB, voffB); PG8_STAGE(PG8_SB(0, 1), cB + hstep, voffB); PG8_STAGE(PG8_SA(0, 0), cA, voffA); PG8_STAGE(PG8_SA(0, 1), cA + hstep, voffA);
        if (wr == 1) PG8_BAR;
        PG8_WAIT_V(2); PG8_BAR;
        PG8_STAGE(PG8_SB(1, 0), cB + kstep, voffB); PG8_STAGE(PG8_SA(1, 0), cA + kstep, voffA); PG8_STAGE(PG8_SB(1, 1), cB + hstep + kstep, voffB);
        PG8_WAIT_V(6); PG8_BAR;
    } else {
        PG8_STAGE(PG8_SB(0, 0), cB, voffB); PG8_STAGE(PG8_SA(0, 0), cA, voffA); PG8_STAGE(PG8_SB(0, 1), cB + hstep, voffB); PG8_STAGE(PG8_SA(0, 1), cA + hstep, voffA);
        if (wr == 1) PG8_BAR;
        PG8_WAIT_V(4); PG8_BAR;
        PG8_STAGE(PG8_SB(1, 0), cB + kstep, voffB); PG8_STAGE(PG8_SA(1, 0), cA + kstep, voffA); PG8_STAGE(PG8_SB(1, 1), cB + hstep + kstep, voffB);
        PG8_WAIT_V(6); PG8_BAR;
    }
    for (;;) {
        const bool has_next = S.next(ui + 1, nxt);
        const char* nA = has_next ? (const char*)g.A + (size_t)nxt.pm * tstep : cA; const char* nB = has_next ? (const char*)g.Bt + (size_t)nxt.pn * tstep : cB;
        for (int t = 0; t < nt; t += 2) {
            const bool last = (t == nt - 2);
            const char* a1 = cA + (size_t)(t + 1) * kstep;
            const char* a2 = last ? nA : cA + (size_t)(t + 2) * kstep; const char* b2 = last ? nB : cB + (size_t)(t + 2) * kstep;
            const char* a3 = a2 + kstep; const char* b3 = b2 + kstep;
            if (last && has_next) S.a_ready(nxt);
            if constexpr (SP2) {
            PG8_LDB(B0, 0, 0); PG8_LDB(B1, 0, 1); PG8_SCHED; PG8_LDA(At, 0, 0); PG8_STAGE(PG8_SA(1, 1), a1 + hstep, voffA);
            PG8_WAIT_V(8); PG8_WAIT_L(0); PG8_BAR; PG8_MMA(0, 0, At, B0); PG8_MMA(0, 1, At, B1); PG8_BAR; PG8_SCHED;
            PG8_LDA(At, 0, 1); PG8_STAGE(PG8_SB(0, 0), b2, voffB); PG8_STAGE(PG8_SB(0, 1), b2 + hstep, voffB); PG8_STAGE(PG8_SA(0, 0), a2, voffA);
            PG8_WAIT_V(8); PG8_WAIT_L(0); PG8_BAR; PG8_MMA(1, 0, At, B0); PG8_MMA(1, 1, At, B1); PG8_BAR; PG8_SCHED;
            PG8_LDB(B0, 1, 0); PG8_LDB(B1, 1, 1); PG8_SCHED; PG8_LDA(At, 1, 0); PG8_STAGE(PG8_SA(0, 1), a2 + hstep, voffA);
            PG8_WAIT_V(8); PG8_WAIT_L(0); PG8_BAR; PG8_MMA(0, 0, At, B0); PG8_MMA(0, 1, At, B1); PG8_BAR; PG8_SCHED;
            PG8_LDA(At, 1, 1); PG8_STAGE(PG8_SB(1, 0), b3, voffB); PG8_STAGE(PG8_SB(1, 1), b3 + hstep, voffB); PG8_STAGE(PG8_SA(1, 0), a3, voffA);
            PG8_WAIT_V(8); PG8_WAIT_L(0); PG8_BAR; PG8_MMA(1, 0, At, B0); PG8_MMA(1, 1, At, B1); PG8_BAR; PG8_SCHED;
            } else {
            PG8_LDB(B0, 0, 0); PG8_SCHED; PG8_LDA(At, 0, 0); PG8_STAGE(PG8_SA(1, 1), a1 + hstep, voffA);
            PG8_WAIT_L(8); PG8_BAR; PG8_WAIT_L(0); PG8_MMA(0, 0, At, B0); PG8_BAR; PG8_SCHED;
            PG8_LDB(B1, 0, 1); PG8_STAGE(PG8_SB(0, 0), b2, voffB);
            PG8_BAR; PG8_WAIT_L(0); PG8_MMA(0, 1, At, B1); PG8_BAR;
            PG8_LDA(At, 0, 1); PG8_STAGE(PG8_SA(0, 0), a2, voffA);
            PG8_BAR; PG8_WAIT_L(0); PG8_MMA(1, 0, At, B0); PG8_BAR; PG8_SCHED;
            PG8_STAGE(PG8_SB(0, 1), b2 + hstep, voffB);
            PG8_WAIT_V(6); PG8_BAR; PG8_MMA(1, 1, At, B1); PG8_BAR;
            PG8_LDB(B0, 1, 0); PG8_SCHED; PG8_LDA(At, 1, 0); PG8_STAGE(PG8_SA(0, 1), a2 + hstep, voffA);
            PG8_WAIT_L(8); PG8_BAR; PG8_WAIT_L(0); PG8_MMA(0, 0, At, B0); PG8_BAR; PG8_SCHED;
            PG8_LDB(B1, 1, 1); PG8_STAGE(PG8_SB(1, 0), b3, voffB);
            PG8_BAR; PG8_WAIT_L(0); PG8_MMA(0, 1, At, B1); PG8_BAR;
            PG8_LDA(At, 1, 1); PG8_STAGE(PG8_SA(1, 0), a3, voffA);
            PG8_BAR; PG8_WAIT_L(0); PG8_MMA(1, 0, At, B0); PG8_BAR; PG8_SCHED;
            PG8_STAGE(PG8_SB(1, 1), b3 + hstep, voffB);
            PG8_WAIT_V(6); PG8_BAR; PG8_MMA(1, 1, At, B1); PG8_BAR;
            }
        }
        if constexpr (ALIGN_EPI) { if (wr == 0) PG8_BAR; }
        if constexpr (!Epi::AFTER_DRAIN) { E(acc, cur, wr, wc, fr, fq); S.done(cur); }
        if (!has_next) break;
#pragma unroll
        for (int a = 0; a < 2; ++a)
#pragma unroll
            for (int b = 0; b < 2; ++b)
#pragma unroll
                for (int m = 0; m < 4; ++m)
#pragma unroll
                    for (int n = 0; n < 2; ++n) acc[a][b][m][n] = (f32x4){0.f, 0.f, 0.f, 0.f};
        cur = nxt; cA = nA; cB = nB; ++ui;
        if constexpr (ALIGN_EPI) { if (wr == 1) PG8_BAR; }
    }
    PG8_WAIT_V(0);
    if constexpr (!ALIGN_EPI) { if (wr == 0) PG8_BAR; }
    PG8_BAR;
    if constexpr (Epi::AFTER_DRAIN) { E.fused(acc, cur, wr, wc, fr, fq, lds, wid, lane); S.done(cur); }
#undef PG8_SA
#undef PG8_SB
#undef PG8_STAGE
#undef PG8_LDA
#undef PG8_LDB
#undef PG8_MMA
#undef PG8_WAIT_V
#undef PG8_WAIT_L
#undef PG8_BAR
#undef PG8_SCHED
}
}

constexpr int NWAVES = 8;
constexpr int D = 1024, MPROMPT = 16384, MSAMPLE = 512, MTOT = MPROMPT + MSAMPLE;
constexpr int SEQ = 4096, NB = 4, NDEC = 128, TDEC = 4;
constexpr int N0 = 3584, N1 = 4096;
constexpr size_t MiB = 1u << 20;
constexpr size_t WS_CTL = 0, CTL_ZERO_BYTES = 1 * MiB;
constexpr size_t WS_W0T = 2 * MiB, WS_WO0T = 10 * MiB, WS_W1T = 12 * MiB, WS_WO1T = 20 * MiB;
constexpr size_t WS_RSTD0 = 22 * MiB, WS_LB = 23 * MiB, WS_KMP = 24 * MiB, WS_SSQ = 26 * MiB;
constexpr size_t WS_XB = 64 * MiB, WS_Q = 128 * MiB, WS_K = 160 * MiB, WS_V = 192 * MiB, WS_GA = 224 * MiB, WS_U = 256 * MiB, WS_GC = 288 * MiB;
constexpr size_t WS_M0 = 320 * MiB, WS_X1 = 384 * MiB, WS_XB1 = 464 * MiB, WS_QQ = 512 * MiB, WS_LOGF = 576 * MiB, WS_VV = 656 * MiB, WS_GS = 704 * MiB;
constexpr size_t WS_M1 = 752 * MiB, WS_OLOC = 800 * MiB, WS_QBS = 880 * MiB, WS_USEG = 928 * MiB, WS_DSEG = 952 * MiB, WS_SC = 960 * MiB, WS_KMS = 1000 * MiB, WS_END = 1024 * MiB;
constexpr int CW_BAR = 4096;
constexpr int RING_BYTES = 131072, LDSCTL_OFF = RING_BYTES, MISC_OFF = LDSCTL_OFF + 320, LDS_BYTES = 147456;

#define GAS __attribute__((address_space(1)))
#define LAS __attribute__((address_space(3)))
typedef unsigned short bf16;
typedef unsigned v4u __attribute__((ext_vector_type(4)));
typedef float f32x4 __attribute__((ext_vector_type(4)));
typedef short bf16x8 __attribute__((ext_vector_type(8)));
#define LDS_WAIT() asm volatile("s_waitcnt lgkmcnt(0)" ::: "memory")
#define VM_WAIT() asm volatile("s_waitcnt vmcnt(0)" ::: "memory")
__device__ __forceinline__ unsigned f2bf(float f) { unsigned u = __builtin_bit_cast(unsigned, f); return (u + 0x7fffu + ((u >> 16) & 1u)) >> 16; }
__device__ __forceinline__ unsigned pk2(float lo, float hi) { return f2bf(lo) | (f2bf(hi) << 16); }
__device__ __forceinline__ float bf2f(unsigned short b) { return __builtin_bit_cast(float, ((unsigned)b) << 16); }
__device__ __forceinline__ float wave_sum(float v) {
#pragma unroll
    for (int o = 1; o < 64; o <<= 1) v += __shfl_xor(v, o);
    return v;
}
#define XB_TMO      128
#define XB_XCNT(j)  (256  + 64 * (j))
#define XB_XSUB(j)  (1280 + 64 * (j))
#define XB_XGEN(j)  (2304 + 64 * (j))
#define XB_TOP      3328
#define XB_TOPGEN   3392
#define XCD_BAR_WORDS 3456
#define XB_SPIN_CAP (1u << 18)
#define LAS __attribute__((address_space(3)))

__device__ __forceinline__ unsigned xb_ld(unsigned* p)              { return __hip_atomic_load(p, __ATOMIC_RELAXED, __HIP_MEMORY_SCOPE_AGENT); }
__device__ __forceinline__ unsigned xb_add(unsigned* p, unsigned v) { return __hip_atomic_fetch_add(p, v, __ATOMIC_RELAXED, __HIP_MEMORY_SCOPE_AGENT); }
__device__ __forceinline__ unsigned xb_xcc_id() { return (unsigned)__builtin_amdgcn_s_getreg((3 << 11) | 20) & 0xFu; }
#define XB_SPIN(cond, bar) do { unsigned _sp = 0; while (cond) { __builtin_amdgcn_s_sleep(1); \
    if ((++_sp & 255u) == 0u) { if (xb_ld(&(bar)[XB_TMO])) break; if (_sp > XB_SPIN_CAP) { atomicAdd(&(bar)[XB_TMO], 1u); break; } } } } while (0)

struct XcdBarrier {
    unsigned* bar; unsigned x;
    volatile LAS unsigned* st;
};

__device__ __forceinline__ XcdBarrier xcd_barrier_post(unsigned* bar, volatile LAS unsigned* st) {
    XcdBarrier b; b.bar = bar; b.x = xb_xcc_id(); b.st = st;
    if (threadIdx.x == 0) (void)xb_add(&bar[XB_XCNT(b.x)], 1u);
    return b;
}
__device__ __forceinline__ void xcd_barrier_complete(unsigned* bar, unsigned x, unsigned& nloc, unsigned& nx) {
    const unsigned G = gridDim.x * gridDim.y * gridDim.z;
    unsigned sum, cnt, mine, sp = 0u;
    for (;;) {
        sum = 0u; cnt = 0u; mine = 0u;
#pragma unroll
        for (unsigned j = 0; j < 16; ++j) { const unsigned c = xb_ld(&bar[XB_XCNT(j)]); sum += c; cnt += (c > 0u) ? 1u : 0u; mine = (j == x) ? c : mine; }
        if (sum == G) break;
        __builtin_amdgcn_s_sleep(1);
        if ((++sp & 255u) == 0u) { if (xb_ld(&bar[XB_TMO])) break; if (sp > XB_SPIN_CAP) { atomicAdd(&bar[XB_TMO], 1u); break; } }
    }
    nloc = mine > 0u ? mine : 1u; nx = cnt > 0u ? cnt : 1u;
}

__device__ __forceinline__ void xcd_barrier(const XcdBarrier& b) {
    asm volatile("s_waitcnt vmcnt(0)" ::: "memory");
    __syncthreads();
    if (threadIdx.x == 0) {
        unsigned* bar = b.bar;
        __builtin_amdgcn_s_waitcnt(0);
        unsigned nloc = b.st[0], nx = b.st[1];
        if (nloc == 0u) { xcd_barrier_complete(bar, b.x, nloc, nx); b.st[0] = nloc; b.st[1] = nx; }
        const unsigned old = xb_add(&bar[XB_XSUB(b.x)], 1u);
        const unsigned gen = old / nloc;
        if (old + 1u == (gen + 1u) * nloc) {
            __builtin_amdgcn_fence(__ATOMIC_RELEASE, "agent");
            asm volatile("s_waitcnt vmcnt(0)" ::: "memory");
            const unsigned og = xb_add(&bar[XB_TOP], 1u);
            const unsigned tg = og / nx;
            if (og + 1u == (tg + 1u) * nx) xb_add(&bar[XB_TOPGEN], 1u);
            else XB_SPIN(xb_ld(&bar[XB_TOPGEN]) == tg, bar);
            __builtin_amdgcn_fence(__ATOMIC_ACQUIRE, "agent");
            xb_add(&bar[XB_XGEN(b.x)], 1u);
            asm volatile("s_waitcnt vmcnt(0)" ::: "memory");
        } else {
            XB_SPIN(xb_ld(&bar[XB_XGEN(b.x)]) == gen, bar);
            __builtin_amdgcn_fence(__ATOMIC_ACQUIRE, "agent");
            asm volatile("s_waitcnt vmcnt(0)" ::: "memory");
        }
    }
    __syncthreads();
}

constexpr size_t O_Y = 0, O_KP = 17301504, O_VP = O_KP + 8388608, O_KS = O_VP + 8388608, O_VS = O_KS + 262144, O_CP = O_VS + 262144, O_CS = O_CP + 61440, O_HP = O_CS + 1966080, O_HS = O_HP + 524288, O_END = O_HS + 16777216;
enum { I_XP = 0, I_XS, I_CK, I_CV, I_SCONV, I_SHGRN, I_PT, I_NORM0, I_WIN0, I_QN, I_KN, I_CW, I_CB, I_LNG, I_LNB, I_WOUT0, I_NORM1, I_WIN1, I_LBL, I_ONORM, I_WOUT1, N_IN };
struct Args { const void* in[N_IN]; float* out; unsigned char* ws; };

__device__ __forceinline__ void p0_transpose_item(const float* W, int K, int N, bf16* WT, int k0, int n0, int drow0, const float* gain, LAS float* scr, int lane) {
#pragma unroll 8
    for (int i = 0; i < 32; ++i) { const int kk = 2 * i + (lane >> 5); const float gsc = gain ? gain[k0 + kk] : 1.0f; scr[kk * 33 + (lane & 31)] = W[(size_t)(k0 + kk) * N + n0 + (lane & 31)] * gsc; }
    LDS_WAIT(); asm volatile("" ::: "memory");
    const int c = lane & 7;
#pragma unroll
    for (int j = 0; j < 4; ++j) { const int n = (lane >> 3) + 8 * j; const LAS float* s = scr + (8 * c) * 33 + n;
        v4u o; o.x = pk2(s[0 * 33], s[1 * 33]); o.y = pk2(s[2 * 33], s[3 * 33]); o.z = pk2(s[4 * 33], s[5 * 33]); o.w = pk2(s[6 * 33], s[7 * 33]);
        *(GAS v4u*)(WT + (size_t)(drow0 + n) * K + k0 + 8 * c) = o; }
    LDS_WAIT(); asm volatile("" ::: "memory");
}
__device__ __forceinline__ int l0_src_group(int dg) {
    const int pnD = dg >> 3, gi = dg & 7, bj = gi >> 2, wc = gi & 3;
    if (pnD >= 8 && pnD < 12) return (bj ? 80 : 64) + 4 * (pnD - 8) + wc;
    return 8 * pnD + 2 * wc + bj;
}


__device__ __forceinline__ void conv_phase(LAS unsigned char* lds, int vcu, int G, const bf16* U, const bf16* GCs, const float* state_conv,
                                           const float* cw, const float* cb, const float* lng, const float* lnb, bf16* M0) {
    const int tid = threadIdx.x, c = tid, wave = tid >> 6, lane = tid & 63;
    LAS float* Y = (LAS float*)lds;
    LAS float* ST = (LAS float*)(lds + 32768);
    float w[31];
#pragma unroll
    for (int i = 0; i < 31; ++i) w[i] = cw[i * 512 + c];
    const float bias = cb[c], gg = lng[c], be = lnb[c];
    for (int unit = vcu; unit < 1056; unit += G) {
        float y[16];
        if (unit < 1024) {
            const int r0 = unit * 16, tok0 = r0 & 4095;
            float uw[46];
#pragma unroll
            for (int i = 0; i < 46; ++i) { const int tt = tok0 - 30 + i; uw[i] = tt >= 0 ? bf2f(U[(size_t)(r0 - 30 + i) * 512 + c]) : 0.f; }
#pragma unroll
            for (int t = 0; t < 16; ++t) { float a = bias;
#pragma unroll
                for (int i = 0; i < 31; ++i) a += w[i] * uw[t + i];
                y[t] = a; }
        } else {
            const int s0 = (unit - 1024) * 4;
#pragma unroll
            for (int sq = 0; sq < 4; ++sq) { const int n = s0 + sq; float uw[34];
#pragma unroll
                for (int i = 0; i < 30; ++i) uw[i] = state_conv[((size_t)n * 30 + i) * 512 + c];
#pragma unroll
                for (int i = 0; i < 4; ++i) uw[30 + i] = bf2f(U[(size_t)(MPROMPT + n * 4 + i) * 512 + c]);
#pragma unroll
                for (int t = 0; t < 4; ++t) { float a = bias;
#pragma unroll
                    for (int i = 0; i < 31; ++i) a += w[i] * uw[t + i];
                    y[sq * 4 + t] = a; } }
        }
#pragma unroll
        for (int t = 0; t < 16; ++t) Y[t * 512 + c] = y[t];
        __syncthreads();
#pragma unroll
        for (int k = 0; k < 2; ++k) { const int t = 2 * wave + k; float v[8]; float s = 0.f;
#pragma unroll
            for (int j = 0; j < 8; ++j) { v[j] = Y[t * 512 + lane + 64 * j]; s += v[j]; }
            const float mean = wave_sum(s) * (1.0f / 512.0f); float q = 0.f;
#pragma unroll
            for (int j = 0; j < 8; ++j) { const float d = v[j] - mean; q += d * d; }
            const float var = wave_sum(q) * (1.0f / 512.0f);
            if (lane == 0) { ST[2 * t] = mean; ST[2 * t + 1] = 1.0f / sqrtf(var + 1e-6f); } }
        __syncthreads();
        const int rbase = unit < 1024 ? unit * 16 : MPROMPT + (unit - 1024) * 16;
#pragma unroll
        for (int t = 0; t < 16; ++t) { const float ln = (y[t] - ST[2 * t]) * ST[2 * t + 1] * gg + be; const float oc = pg8::fsilu(ln); const size_t r = (size_t)(rbase + t);
            M0[r * 1024 + 512 + c] = (bf16)f2bf(oc * bf2f(GCs[r * 512 + c])); }
        __syncthreads();
    }
}


typedef unsigned u32x4_t __attribute__((ext_vector_type(4)));
typedef unsigned u32x2_t __attribute__((ext_vector_type(2)));
__device__ __forceinline__ float fexp(float x) { return __builtin_amdgcn_exp2f(x * 1.4426950408889634f); }
__device__ __forceinline__ bf16x8 mk_frag(u32x2_t a, u32x2_t b) { u32x4_t w; w.x = a.x; w.y = a.y; w.z = b.x; w.w = b.y; return __builtin_bit_cast(bf16x8, w); }
__device__ __forceinline__ unsigned cvtpk(float lo, float hi) { return pg8::cvt_pk_bf16(lo, hi); }
constexpr int P1_QB = 0, P1_QT = 17408, P1_QTS = 34816, P1_KD = 47872, P1_KE = 65280, P1_KLT = 78336, P1_VT = 96768, P1_AB = 115200, P1_TOT = 124416, P1_DV = 126464;
constexpr int RP = 272, RS = 144;

__device__ __forceinline__ void scan_a_block(LAS unsigned char* lds, int aoff, int boff, int I, int J, bool diag, int lane) {
    const int l15 = lane & 15, g4 = lane >> 4;
    f32x4 acc = (f32x4){0.f, 0.f, 0.f, 0.f};
#pragma unroll
    for (int ks = 0; ks < 4; ++ks) {
        const bf16x8 a = *(const LAS bf16x8*)(lds + aoff + l15 * RP + (32 * ks + 8 * g4) * 2);
        const bf16x8 b = *(const LAS bf16x8*)(lds + boff + l15 * RP + (32 * ks + 8 * g4) * 2);
        acc = __builtin_amdgcn_mfma_f32_16x16x32_bf16(a, b, acc, 0, 0, 0);
    }
#pragma unroll
    for (int r = 0; r < 4; ++r) { const int t = 4 * g4 + r; const float v = (diag && l15 > t) ? 0.f : acc[r];
        *(LAS unsigned short*)(lds + P1_AB + (16 * I + t) * RS + (16 * J + l15) * 2) = (unsigned short)f2bf(v); }
}

__device__ __forceinline__ void scan_pass1(LAS unsigned char* lds, int vcu, int G, const bf16* QQ, const float* LOGF, const bf16* VV, float* OLOC, bf16* QBS, float* USEG, float* DSEG) {
    const int tid = threadIdx.x, lane = tid & 63, wave = __builtin_amdgcn_readfirstlane(tid >> 6), l15 = lane & 15, g4 = lane >> 4;
    const int k = tid & 127, I = __builtin_amdgcn_readfirstlane(tid >> 7);
    LAS float* TOT = (LAS float*)(lds + P1_TOT); LAS float* DV = (LAS float*)(lds + P1_DV);
    for (int unit = vcu; unit < 256; unit += G) {
        const int b = unit >> 6, h = (unit >> 3) & 7, g = unit & 7;
        for (int i = tid; i < 64 * RS / 4; i += 512) ((LAS unsigned*)(lds + P1_AB))[i] = 0u;
        f32x4 S[8];
#pragma unroll
        for (int kt = 0; kt < 8; ++kt) S[kt] = (f32x4){0.f, 0.f, 0.f, 0.f};
        float Bprev = 0.f;
        __syncthreads();
        for (int ch = 0; ch < 8; ++ch) {
            const size_t row0 = (size_t)b * 4096 + g * 512 + ch * 64;
            float lf[16], c[16]; unsigned short qv[16], vvv[16];
#pragma unroll
            for (int i = 0; i < 16; ++i) { const size_t o = (row0 + 16 * I + i) * 1024 + h * 128 + k; lf[i] = LOGF[o]; qv[i] = QQ[o]; vvv[i] = VV[o]; }
            { u32x4_t w0, w1;
              w0.x = vvv[0] | ((unsigned)vvv[1] << 16); w0.y = vvv[2] | ((unsigned)vvv[3] << 16); w0.z = vvv[4] | ((unsigned)vvv[5] << 16); w0.w = vvv[6] | ((unsigned)vvv[7] << 16);
              w1.x = vvv[8] | ((unsigned)vvv[9] << 16); w1.y = vvv[10] | ((unsigned)vvv[11] << 16); w1.z = vvv[12] | ((unsigned)vvv[13] << 16); w1.w = vvv[14] | ((unsigned)vvv[15] << 16);
              *(LAS u32x4_t*)(lds + P1_VT + k * RS + I * 32) = w0; *(LAS u32x4_t*)(lds + P1_VT + k * RS + I * 32 + 16) = w1; }
            c[0] = lf[0];
#pragma unroll
            for (int i = 1; i < 16; ++i) c[i] = c[i - 1] + lf[i];
            TOT[I * 128 + k] = c[15];
            __syncthreads();
            const float t0 = TOT[k], t1 = TOT[128 + k], t2 = TOT[256 + k], t3 = TOT[384 + k];
            const float rI = I == 0 ? 0.f : (I == 1 ? t0 : (I == 2 ? t0 + t1 : (t0 + t1) + t2));
            const float totI = I == 0 ? t0 : (I == 1 ? t1 : (I == 2 ? t2 : t3));
            const float btot = (t0 + t1) + (t2 + t3);
            const float e_rI = fexp(rI), e_prev = fexp(Bprev), e_klt = fexp(btot - rI - totI);
            const float sc1 = I == 2 ? fexp(t1) : fexp(t2), sc2 = fexp(t2 + t1);
            unsigned kl2[8];
#pragma unroll
            for (int i = 0; i < 16; ++i) {
                const int t = 16 * I + i;
                const float q = bf2f(qv[i]);
                const float qt = q * fexp(c[i]), qb = qt * e_rI;
                const float kk = 1.0f - fexp(lf[i]);
                const float kd = kk * fexp(fminf(-c[i], 80.f)), ke = kk * fexp(totI - c[i]), kl = ke * e_klt;
                *(LAS unsigned short*)(lds + P1_QB + t * RP + k * 2) = (unsigned short)f2bf(qb);
                *(LAS unsigned short*)(lds + P1_QT + t * RP + k * 2) = (unsigned short)f2bf(qt);
                *(LAS unsigned short*)(lds + P1_KD + t * RP + k * 2) = (unsigned short)f2bf(kd);
                if (I < 3) *(LAS unsigned short*)(lds + P1_KE + t * RP + k * 2) = (unsigned short)f2bf(ke);
                if (I == 2) *(LAS unsigned short*)(lds + P1_QTS + i * RP + k * 2) = (unsigned short)f2bf(qt * sc1);
                if (I == 3) { *(LAS unsigned short*)(lds + P1_QTS + (16 + i) * RP + k * 2) = (unsigned short)f2bf(qt * sc1); *(LAS unsigned short*)(lds + P1_QTS + (32 + i) * RP + k * 2) = (unsigned short)f2bf(qt * sc2); }
                QBS[(row0 + t) * 1024 + h * 128 + k] = (bf16)f2bf(qb * e_prev);
                if (i & 1) kl2[i >> 1] |= f2bf(kl) << 16; else kl2[i >> 1] = f2bf(kl);
            }
            { u32x4_t w0, w1; w0.x = kl2[0]; w0.y = kl2[1]; w0.z = kl2[2]; w0.w = kl2[3]; w1.x = kl2[4]; w1.y = kl2[5]; w1.z = kl2[6]; w1.w = kl2[7];
              *(LAS u32x4_t*)(lds + P1_KLT + k * RS + I * 32) = w0; *(LAS u32x4_t*)(lds + P1_KLT + k * RS + I * 32 + 16) = w1; }
            if (I == 0) DV[k] = fexp(btot);
            Bprev += btot;
            __syncthreads();
            if (wave < 4) scan_a_block(lds, P1_QT + 16 * wave * RP, P1_KD + 16 * wave * RP, wave, wave, true, lane);
            else if (wave < 7) scan_a_block(lds, P1_QT + 16 * (wave - 3) * RP, P1_KE + 16 * (wave - 4) * RP, wave - 3, wave - 4, false, lane);
            else scan_a_block(lds, P1_QTS, P1_KE, 2, 0, false, lane);
            if (wave == 0) scan_a_block(lds, P1_QTS + 16 * RP, P1_KE + 16 * RP, 3, 1, false, lane);
            if (wave == 1) scan_a_block(lds, P1_QTS + 32 * RP, P1_KE, 3, 0, false, lane);
            __syncthreads();
            {
                bf16x8 vfr[2];
#pragma unroll
                for (int ss = 0; ss < 2; ++ss) vfr[ss] = *(const LAS bf16x8*)(lds + P1_VT + (16 * wave + l15) * RS + (32 * ss + 8 * g4) * 2);
                bf16x8 sfr[4];
#pragma unroll
                for (int ks = 0; ks < 4; ++ks) { u32x4_t w; w.x = cvtpk(S[2 * ks][0], S[2 * ks][1]); w.y = cvtpk(S[2 * ks][2], S[2 * ks][3]); w.z = cvtpk(S[2 * ks + 1][0], S[2 * ks + 1][1]); w.w = cvtpk(S[2 * ks + 1][2], S[2 * ks + 1][3]); sfr[ks] = __builtin_bit_cast(bf16x8, w); }
#pragma unroll
                for (int ti = 0; ti < 4; ++ti) {
                    f32x4 o = (f32x4){0.f, 0.f, 0.f, 0.f};
#pragma unroll
                    for (int ks = 0; ks < 4; ++ks) {
                        const u32x2_t a0 = *(const LAS u32x2_t*)(lds + P1_QB + (16 * ti + l15) * RP + (32 * ks + 4 * g4) * 2);
                        const u32x2_t a1 = *(const LAS u32x2_t*)(lds + P1_QB + (16 * ti + l15) * RP + (32 * ks + 16 + 4 * g4) * 2);
                        o = __builtin_amdgcn_mfma_f32_16x16x32_bf16(mk_frag(a0, a1), sfr[ks], o, 0, 0, 0);
                    }
#pragma unroll
                    for (int ss = 0; ss < 2; ++ss) {
                        const bf16x8 a = *(const LAS bf16x8*)(lds + P1_AB + (16 * ti + l15) * RS + (32 * ss + 8 * g4) * 2);
                        o = __builtin_amdgcn_mfma_f32_16x16x32_bf16(a, vfr[ss], o, 0, 0, 0);
                    }
#pragma unroll
                    for (int r = 0; r < 4; ++r) OLOC[(row0 + 16 * ti + 4 * g4 + r) * 1024 + h * 128 + 16 * wave + l15] = o[r];
                }
#pragma unroll
                for (int kt = 0; kt < 8; ++kt) {
                    const f32x4 dv = *(const LAS f32x4*)(lds + P1_DV + (16 * kt + 4 * g4) * 4);
                    S[kt] = S[kt] * dv;
#pragma unroll
                    for (int ss = 0; ss < 2; ++ss) {
                        const bf16x8 a = *(const LAS bf16x8*)(lds + P1_KLT + (16 * kt + l15) * RS + (32 * ss + 8 * g4) * 2);
                        S[kt] = __builtin_amdgcn_mfma_f32_16x16x32_bf16(a, vfr[ss], S[kt], 0, 0, 0);
                    }
                }
            }
            __syncthreads();
        }
#pragma unroll
        for (int kt = 0; kt < 8; ++kt)
#pragma unroll
            for (int r = 0; r < 4; ++r) USEG[((size_t)unit * 128 + 16 * kt + 4 * g4 + r) * 128 + 16 * wave + l15] = S[kt][r];
        if (I == 0) DSEG[unit * 128 + k] = fexp(Bprev);
    }
}

__device__ __forceinline__ void scan_sample(LAS unsigned char* lds, int vcu, int G, const bf16* QQ, const float* LOGF, const bf16* VV, const bf16* GS, const float* og,
                                            const float* S0, float* Sout, bf16* M1) {
    const int tid = threadIdx.x, lane = tid & 63, wave = tid >> 6, v = tid & 127, kq = tid >> 7;
    LAS float* FS = (LAS float*)lds; LAS float* QS = FS + 512; LAS float* VS = QS + 512; LAS float* PART = VS + 512; LAS float* RED = PART + 2048;
    for (int su = vcu; su < 1024; su += G) {
        const int n = su >> 3, h = su & 7;
        float S[32];
        const float* s0 = S0 + (((size_t)(n * 8 + h)) * 128 + kq * 32) * 128 + v;
#pragma unroll
        for (int i = 0; i < 32; ++i) S[i] = s0[(size_t)i * 128];
        { const size_t o = (size_t)(MPROMPT + n * 4 + kq) * 1024 + h * 128 + v; FS[kq * 128 + v] = fexp(LOGF[o]); QS[kq * 128 + v] = bf2f(QQ[o]); VS[kq * 128 + v] = bf2f(VV[o]); }
        __syncthreads();
        float po[4];
#pragma unroll
        for (int t = 0; t < 4; ++t) { const float vv = VS[t * 128 + v]; float p = 0.f;
#pragma unroll
            for (int i = 0; i < 32; ++i) { const int kk = kq * 32 + i; const float f = FS[t * 128 + kk]; S[i] = f * S[i] + (1.0f - f) * vv; p += QS[t * 128 + kk] * S[i]; }
            po[t] = p; }
#pragma unroll
        for (int t = 0; t < 4; ++t) PART[(kq * 4 + t) * 128 + v] = po[t];
        float* so = Sout + (((size_t)(n * 8 + h)) * 128 + kq * 32) * 128 + v;
#pragma unroll
        for (int i = 0; i < 32; ++i) so[(size_t)i * 128] = S[i];
        __syncthreads();
        const int t = kq;
        const float o = (PART[(0 * 4 + t) * 128 + v] + PART[(1 * 4 + t) * 128 + v]) + (PART[(2 * 4 + t) * 128 + v] + PART[(3 * 4 + t) * 128 + v]);
        const float ss = wave_sum(o * o);
        if (lane == 0) RED[wave] = ss;
        __syncthreads();
        const float rs = __builtin_amdgcn_rsqf((RED[2 * t] + RED[2 * t + 1]) * (1.0f / 128.0f) + 1e-6f);
        const size_t ro = (size_t)(MPROMPT + n * 4 + t) * 1024 + h * 128 + v;
        M1[ro] = (bf16)f2bf(o * rs * og[v] * bf2f(GS[ro]));
        __syncthreads();
    }
}

constexpr int P3_SIN = 0;
__device__ __forceinline__ void scan_pass3(LAS unsigned char* lds, int vcu, int G, const bf16* QBS, const float* OLOC, const float* USEG, const float* DSEG, const bf16* GS, const float* og,
                                           bf16* M1, float* hgrn_prompt) {
    const int tid = threadIdx.x, lane = tid & 63, wave = __builtin_amdgcn_readfirstlane(tid >> 6), l15 = lane & 15, g4 = lane >> 4, v = tid & 127, kq = tid >> 7;
    for (int u3 = vcu; u3 < 512; u3 += G) {
        const int half = u3 & 1, g = (u3 >> 1) & 7, h = (u3 >> 4) & 7, b = u3 >> 7, bh = b * 8 + h;
        float S[32];
#pragma unroll
        for (int i = 0; i < 32; ++i) S[i] = 0.f;
        for (int gp = 0; gp < g; ++gp) {
            const float* U = USEG + (((size_t)(bh * 8 + gp)) * 128 + kq * 32) * 128 + v; const float* Dg = DSEG + (bh * 8 + gp) * 128 + kq * 32;
#pragma unroll
            for (int i = 0; i < 32; ++i) S[i] = Dg[i] * S[i] + U[(size_t)i * 128];
        }
        if (g == 7 && half == 0) {
            const float* U = USEG + (((size_t)(bh * 8 + 7)) * 128 + kq * 32) * 128 + v; const float* Dg = DSEG + (bh * 8 + 7) * 128 + kq * 32;
            float* hp = hgrn_prompt + (((size_t)bh) * 128 + kq * 32) * 128 + v;
#pragma unroll
            for (int i = 0; i < 32; ++i) hp[(size_t)i * 128] = Dg[i] * S[i] + U[(size_t)i * 128];
        }
#pragma unroll
        for (int j = 0; j < 4; ++j) { u32x4_t w; w.x = cvtpk(S[8 * j], S[8 * j + 1]); w.y = cvtpk(S[8 * j + 2], S[8 * j + 3]); w.z = cvtpk(S[8 * j + 4], S[8 * j + 5]); w.w = cvtpk(S[8 * j + 6], S[8 * j + 7]);
            *(LAS u32x4_t*)(lds + P3_SIN + v * RP + (kq * 32 + 8 * j) * 2) = w; }
        __syncthreads();
        const size_t rbase = (size_t)b * 4096 + g * 512 + half * 256 + 32 * wave;
        f32x4 acc[2][8];
#pragma unroll
        for (int ti = 0; ti < 2; ++ti)
#pragma unroll
            for (int vt = 0; vt < 8; ++vt) acc[ti][vt] = (f32x4){0.f, 0.f, 0.f, 0.f};
        if (g > 0) {
#pragma unroll
            for (int ks = 0; ks < 4; ++ks) {
                bf16x8 afr[2];
#pragma unroll
                for (int ti = 0; ti < 2; ++ti) afr[ti] = *(const bf16x8*)(QBS + (rbase + 16 * ti + l15) * 1024 + h * 128 + 32 * ks + 8 * g4);
#pragma unroll
                for (int vt = 0; vt < 8; ++vt) { const bf16x8 bfr = *(const LAS bf16x8*)(lds + P3_SIN + (16 * vt + l15) * RP + (32 * ks + 8 * g4) * 2);
#pragma unroll
                    for (int ti = 0; ti < 2; ++ti) acc[ti][vt] = __builtin_amdgcn_mfma_f32_16x16x32_bf16(afr[ti], bfr, acc[ti][vt], 0, 0, 0); }
            }
        }
        float ogv[8];
#pragma unroll
        for (int vt = 0; vt < 8; ++vt) ogv[vt] = og[16 * vt + l15];
#pragma unroll
        for (int ti = 0; ti < 2; ++ti)
#pragma unroll
            for (int r = 0; r < 4; ++r) {
                const size_t ro = (rbase + 16 * ti + 4 * g4 + r) * 1024 + h * 128 + l15;
                float o[8]; float ss = 0.f;
#pragma unroll
                for (int vt = 0; vt < 8; ++vt) { o[vt] = OLOC[ro + 16 * vt] + acc[ti][vt][r]; ss += o[vt] * o[vt]; }
                ss += __shfl_xor(ss, 1); ss += __shfl_xor(ss, 2); ss += __shfl_xor(ss, 4); ss += __shfl_xor(ss, 8);
                const float rs = __builtin_amdgcn_rsqf(ss * (1.0f / 128.0f) + 1e-6f);
#pragma unroll
                for (int vt = 0; vt < 8; ++vt) M1[ro + 16 * vt] = (bf16)f2bf(o[vt] * rs * ogv[vt] * bf2f(GS[ro + 16 * vt]));
            }
        __syncthreads();
    }
}


typedef float f32x16 __attribute__((ext_vector_type(16)));
typedef short v4i16_t __attribute__((ext_vector_type(4)));
constexpr int AT_KV = 0;
constexpr int AT_PITCH = 144, AT_TILE = 64 * AT_PITCH, AT_BUF = 2 * AT_TILE;
constexpr int AT_KM = 2 * AT_BUF;
constexpr int AT_WS = AT_KM + 4096;
constexpr float SM_C = 0.125f * 1.4426950408889634f;
__device__ __forceinline__ int crow(int r, int hi) { return (r & 3) + 8 * (r >> 2) + 4 * hi; }

__device__ __forceinline__ void attn_prompt_unit(LAS unsigned char* lds, int b, int h, int j, const bf16* Qb, const bf16* Kb, const bf16* Vb, const bf16* GAs, const float* KMP,
                                                 const float* qg, const float* kg, bf16* M0) {
    const int tid = threadIdx.x, lane = tid & 63, wave = __builtin_amdgcn_readfirstlane(tid >> 6), l31 = lane & 31, hh = lane >> 5;
    LAS float* KM = (LAS float*)(lds + AT_KM); LAS float* WSF = (LAS float*)(lds + AT_WS) + wave * 32;
    for (int i = tid; i < j * 64; i += 512) { const int n = i >> 6, d = i & 63; const float* p = KMP + ((size_t)(b * 16 + n) * 4) * 512 + h * 64 + d; KM[i] = ((p[0] + p[512]) + (p[1024] + p[1536])) * (1.0f / 256.0f); }
    float gq = fabsf(qg[lane]), gk = fabsf(kg[lane]);
#pragma unroll
    for (int o = 1; o < 64; o <<= 1) { gq = fmaxf(gq, __shfl_xor(gq, o)); gk = fmaxf(gk, __shfl_xor(gk, o)); }
    const float m0c = 8.0f * gq * gk * 1.4426950408889634f;
    const size_t qrow = (size_t)b * 4096 + 256 * j + 32 * wave + l31;
    bf16x8 qf[4];
#pragma unroll
    for (int ds = 0; ds < 4; ++ds) qf[ds] = *(const bf16x8*)(Qb + qrow * 512 + h * 64 + 16 * ds + 8 * hh);
    const int srow = tid >> 3, sch = tid & 7;
    const size_t kvbase = (size_t)b * 4096 * 512 + h * 64 + sch * 8;
    const int sdst = srow * AT_PITCH + sch * 16;
    const int T = 4 * (j + 1);
    u32x4_t kreg, vreg;
    { const size_t r0 = (size_t)(256 * j + srow) * 512; kreg = *(const u32x4_t*)(Kb + kvbase + r0); vreg = *(const u32x4_t*)(Vb + kvbase + r0); }
    __syncthreads();
    unsigned selmask;
    if (j <= 3) selmask = (1u << j) - 1u;
    else {
        float g0 = -INFINITY, g1 = -INFINITY, g2 = -INFINITY; int s0 = 0, s1 = 0, s2 = 0;
        for (int n = 0; n < j; ++n) {
            float part = 0.f;
#pragma unroll
            for (int ds = 0; ds < 4; ++ds)
#pragma unroll
                for (int e = 0; e < 8; ++e) part += bf2f((unsigned short)qf[ds][e]) * KM[n * 64 + 16 * ds + 8 * hh + e];
            const float g = part + __shfl_xor(part, 32);
            if (g > g0) { g2 = g1; s2 = s1; g1 = g0; s1 = s0; g0 = g; s0 = n; }
            else if (g > g1) { g2 = g1; s2 = s1; g1 = g; s1 = n; }
            else if (g > g2) { g2 = g; s2 = n; }
        }
        selmask = (1u << s0) | (1u << s1) | (1u << s2);
    }
    *(LAS u32x4_t*)(lds + AT_KV + sdst) = kreg; *(LAS u32x4_t*)(lds + AT_KV + AT_TILE + sdst) = vreg;
    __syncthreads();
    f32x16 o0, o1;
#pragma unroll
    for (int r = 0; r < 16; ++r) { o0[r] = 0.f; o1[r] = 0.f; }
    float lsum = 0.f;
    const int qp = 32 * wave + l31;
    const int koff = l31 * AT_PITCH + hh * 16;
    const int voff = (4 * hh + ((lane & 15) >> 2)) * AT_PITCH + (16 * ((lane >> 4) & 1) + 4 * (lane & 3)) * 2;
    for (int t = 0; t < T; ++t) {
        const bool more = (t + 1 < T);
        if (more) { const int t1 = t + 1; const int nb = t1 < 4 ? j : (t1 >> 2) - 1; const size_t r0 = (size_t)(256 * nb + 64 * (t1 & 3) + srow) * 512; kreg = *(const u32x4_t*)(Kb + kvbase + r0); vreg = *(const u32x4_t*)(Vb + kvbase + r0); }
        const int buf = (t & 1) * AT_BUF;
        const bool own = t < 4; const int nbk = own ? j : (t >> 2) - 1;
        const bool act = own || ((selmask >> nbk) & 1u);
        f32x16 p0, p1;
#pragma unroll
        for (int r = 0; r < 16; ++r) { p0[r] = 0.f; p1[r] = 0.f; }
#pragma unroll
        for (int ds = 0; ds < 4; ++ds) {
            const bf16x8 ka0 = *(const LAS bf16x8*)(lds + AT_KV + buf + koff + ds * 32);
            const bf16x8 ka1 = *(const LAS bf16x8*)(lds + AT_KV + buf + koff + 32 * AT_PITCH + ds * 32);
            p0 = __builtin_amdgcn_mfma_f32_32x32x16_bf16(ka0, qf[ds], p0, 0, 0, 0);
            p1 = __builtin_amdgcn_mfma_f32_32x32x16_bf16(ka1, qf[ds], p1, 0, 0, 0);
        }
        const int kp0 = 64 * (t & 3);
        float ls = 0.f;
#pragma unroll
        for (int r = 0; r < 16; ++r) {
            const int kp = kp0 + crow(r, hh);
            const bool v0 = own ? (kp <= qp) : act, v1 = own ? (kp + 32 <= qp) : act;
            const float e0 = v0 ? __builtin_amdgcn_exp2f(p0[r] * SM_C - m0c) : 0.f, e1 = v1 ? __builtin_amdgcn_exp2f(p1[r] * SM_C - m0c) : 0.f;
            p0[r] = e0; p1[r] = e1; ls += e0 + e1;
        }
        lsum += ls;
        bf16x8 pa[4];
        { u32x4_t w;
          w.x = cvtpk(p0[0], p0[1]); w.y = cvtpk(p0[2], p0[3]); w.z = cvtpk(p0[4], p0[5]); w.w = cvtpk(p0[6], p0[7]); pa[0] = __builtin_bit_cast(bf16x8, w);
          w.x = cvtpk(p0[8], p0[9]); w.y = cvtpk(p0[10], p0[11]); w.z = cvtpk(p0[12], p0[13]); w.w = cvtpk(p0[14], p0[15]); pa[1] = __builtin_bit_cast(bf16x8, w);
          w.x = cvtpk(p1[0], p1[1]); w.y = cvtpk(p1[2], p1[3]); w.z = cvtpk(p1[4], p1[5]); w.w = cvtpk(p1[6], p1[7]); pa[2] = __builtin_bit_cast(bf16x8, w);
          w.x = cvtpk(p1[8], p1[9]); w.y = cvtpk(p1[10], p1[11]); w.z = cvtpk(p1[12], p1[13]); w.w = cvtpk(p1[14], p1[15]); pa[3] = __builtin_bit_cast(bf16x8, w); }
#pragma unroll
        for (int ks = 0; ks < 4; ++ks) {
            const LAS unsigned char* vb = lds + AT_KV + buf + AT_TILE + voff + 16 * ks * AT_PITCH;
            const v4i16_t a0 = __builtin_amdgcn_ds_read_tr16_b64_v4i16((LAS v4i16_t*)(vb));
            const v4i16_t a1 = __builtin_amdgcn_ds_read_tr16_b64_v4i16((LAS v4i16_t*)(vb + 8 * AT_PITCH));
            const v4i16_t c0 = __builtin_amdgcn_ds_read_tr16_b64_v4i16((LAS v4i16_t*)(vb + 64));
            const v4i16_t c1 = __builtin_amdgcn_ds_read_tr16_b64_v4i16((LAS v4i16_t*)(vb + 8 * AT_PITCH + 64));
            const bf16x8 vf0 = (bf16x8){a0[0], a0[1], a0[2], a0[3], a1[0], a1[1], a1[2], a1[3]};
            const bf16x8 vf1 = (bf16x8){c0[0], c0[1], c0[2], c0[3], c1[0], c1[1], c1[2], c1[3]};
            o0 = __builtin_amdgcn_mfma_f32_32x32x16_bf16(pa[ks], vf0, o0, 0, 0, 0);
            o1 = __builtin_amdgcn_mfma_f32_32x32x16_bf16(pa[ks], vf1, o1, 0, 0, 0);
        }
        if (more) { const int nbuf = ((t + 1) & 1) * AT_BUF; *(LAS u32x4_t*)(lds + AT_KV + nbuf + sdst) = kreg; *(LAS u32x4_t*)(lds + AT_KV + nbuf + AT_TILE + sdst) = vreg; }
        __syncthreads();
    }
    lsum += __shfl_xor(lsum, 32);
    if (hh == 0) WSF[l31] = 1.0f / lsum;
    asm volatile("s_waitcnt lgkmcnt(0)" ::: "memory");
    const size_t orow0 = (size_t)b * 4096 + 256 * j + 32 * wave;
#pragma unroll
    for (int r = 0; r < 16; ++r) {
        const int q = crow(r, hh); const float li = WSF[q]; const size_t ro = orow0 + q;
        const float ga0 = bf2f(GAs[ro * 512 + h * 64 + l31]), ga1 = bf2f(GAs[ro * 512 + h * 64 + 32 + l31]);
        M0[ro * 1024 + h * 64 + l31] = (bf16)f2bf(o0[r] * li * ga0);
        M0[ro * 1024 + h * 64 + 32 + l31] = (bf16)f2bf(o1[r] * li * ga1);
    }
}
__device__ __forceinline__ void attn_prompt_phase(LAS unsigned char* lds, int vcu, int G, const bf16* Qb, const bf16* Kb, const bf16* Vb, const bf16* GAs, const float* KMP, const float* qg, const float* kg, bf16* M0) {
    for (int u = vcu; u < 256; u += G) {
        const int b = u >> 6, h = (u >> 3) & 7, jj = u & 7;
        attn_prompt_unit(lds, b, h, 15 - jj, Qb, Kb, Vb, GAs, KMP, qg, kg, M0);
        attn_prompt_unit(lds, b, h, jj, Qb, Kb, Vb, GAs, KMP, qg, kg, M0);
    }
}


__device__ __forceinline__ void attn_sample_passA(LAS unsigned char* lds, int vcu, int G, const bf16* Qb, const float* cache_k, const int* pt, float* SC, float* KMS) {
    const int tid = threadIdx.x, c4 = tid & 127, hd = c4 >> 4, d4 = c4 & 15, rsub = tid >> 7;
    LAS float* SCT = (LAS float*)lds;
    LAS float* KSUM = (LAS float*)(lds + 32768);
    for (int unit = vcu; unit < 1024; unit += G) {
        const int n = unit >> 3, blk = unit & 7;
        f32x4 qv[4];
#pragma unroll
        for (int t = 0; t < 4; ++t) { const u32x2_t w = *(const u32x2_t*)(Qb + (size_t)(MPROMPT + n * 4 + t) * 512 + 4 * c4);
            qv[t] = (f32x4){__builtin_bit_cast(float, w.x << 16), __builtin_bit_cast(float, w.x & 0xffff0000u), __builtin_bit_cast(float, w.y << 16), __builtin_bit_cast(float, w.y & 0xffff0000u)}; }
        const int pg0 = pt[n * 16 + blk * 2], pg1 = pt[n * 16 + blk * 2 + 1];
        f32x4 ksum = (f32x4){0.f, 0.f, 0.f, 0.f};
#pragma unroll 4
        for (int it = 0; it < 64; ++it) {
            const int r = rsub + 4 * it; const int page = it < 32 ? pg0 : pg1;
            const f32x4 kv = *(const f32x4*)(cache_k + ((size_t)page * 128 + (r & 127)) * 512 + 4 * c4);
            ksum += kv;
            float s[4];
#pragma unroll
            for (int t = 0; t < 4; ++t) s[t] = (qv[t][0] * kv[0] + qv[t][1] * kv[1]) + (qv[t][2] * kv[2] + qv[t][3] * kv[3]);
#pragma unroll
            for (int o = 1; o < 16; o <<= 1) {
#pragma unroll
                for (int t = 0; t < 4; ++t) s[t] += __shfl_xor(s[t], o);
            }
            if (d4 == 0) {
#pragma unroll
                for (int t = 0; t < 4; ++t) SCT[(hd * 4 + t) * 256 + r] = s[t];
            }
        }
        *(LAS f32x4*)(lds + 32768 + (rsub * 512 + 4 * c4) * 4) = ksum;
        __syncthreads();
#pragma unroll
        for (int k = 0; k < 16; ++k) { const int idx = tid + 512 * k; SC[((size_t)n * 32 + (idx >> 8)) * 2048 + blk * 256 + (idx & 255)] = SCT[idx]; }
        KMS[((size_t)n * 8 + blk) * 512 + tid] = ((KSUM[tid] + KSUM[512 + tid]) + (KSUM[1024 + tid] + KSUM[1536 + tid])) * (1.0f / 256.0f);
        __syncthreads();
    }
}
__device__ __forceinline__ void attn_sample_passB(LAS unsigned char* lds, int vcu, int G, const bf16* Qb, const bf16* Kb, const bf16* Vb, const bf16* GAs, const float* cache_v, const int* pt,
                                                  const float* SC, const float* KMS, const float* qg, const float* kg, bf16* M0) {
    const int tid = threadIdx.x, lane = tid & 63, wave = __builtin_amdgcn_readfirstlane(tid >> 6);
    LAS float* PL = (LAS float*)lds;
    LAS float* OP = (LAS float*)(lds + 32768);
    LAS unsigned* SEL = (LAS unsigned*)(lds + 65536);
    LAS float* POWN = (LAS float*)(lds + 65536 + 64);
    LAS float* REDL = (LAS float*)(lds + 65536 + 128);
    float gq = fabsf(qg[lane]), gk = fabsf(kg[lane]);
#pragma unroll
    for (int o = 1; o < 64; o <<= 1) { gq = fmaxf(gq, __shfl_xor(gq, o)); gk = fmaxf(gk, __shfl_xor(gk, o)); }
    const float m0c = 8.0f * gq * gk * 1.4426950408889634f;
    for (int unit = vcu; unit < 1024; unit += G) {
        const int n = unit >> 3, h = unit & 7;
        if (wave < 4) {
            const int t = wave; const size_t qrow = (size_t)(MPROMPT + n * 4 + t);
            const float q = bf2f(Qb[qrow * 512 + h * 64 + lane]);
            float g0 = -INFINITY, g1 = -INFINITY, g2 = -INFINITY; int s0 = 0, s1 = 0, s2 = 0;
            for (int blk = 0; blk < 8; ++blk) {
                const float g = wave_sum(q * KMS[((size_t)n * 8 + blk) * 512 + h * 64 + lane]);
                if (g > g0) { g2 = g1; s2 = s1; g1 = g0; s1 = s0; g0 = g; s0 = blk; }
                else if (g > g1) { g2 = g1; s2 = s1; g1 = g; s1 = blk; }
                else if (g > g2) { g2 = g; s2 = blk; }
            }
            if (lane == 0) SEL[t] = (1u << s0) | (1u << s1) | (1u << s2);
#pragma unroll
            for (int tp = 0; tp < 4; ++tp) {
                const float s = wave_sum(q * bf2f(Kb[(size_t)(MPROMPT + n * 4 + tp) * 512 + h * 64 + lane]));
                if (lane == 0) POWN[t * 4 + tp] = tp <= t ? __builtin_amdgcn_exp2f(s * SM_C - m0c) : 0.f;
            }
        }
        __syncthreads();
        const unsigned sel0 = SEL[0], sel1 = SEL[1], sel2 = SEL[2], sel3 = SEL[3], anym = sel0 | sel1 | sel2 | sel3;
        {
            float lp[4] = {0.f, 0.f, 0.f, 0.f};
#pragma unroll
            for (int k = 0; k < 16; ++k) {
                const int i = tid + 512 * k, t = k >> 2, idx = i & 2047, blk = idx >> 8;
                const unsigned sm = t == 0 ? sel0 : (t == 1 ? sel1 : (t == 2 ? sel2 : sel3));
                const float p = ((sm >> blk) & 1u) ? __builtin_amdgcn_exp2f(SC[(((size_t)n * 8 + h) * 4 + t) * 2048 + idx] * SM_C - m0c) : 0.f;
                PL[i] = p; lp[t] += p;
            }
#pragma unroll
            for (int t = 0; t < 4; ++t) { const float s = wave_sum(lp[t]); if (lane == 0) REDL[wave * 4 + t] = s; }
        }
        __syncthreads();
        {
            const int d4 = tid & 15, rl = tid >> 4;
            f32x4 acc[4];
#pragma unroll
            for (int t = 0; t < 4; ++t) acc[t] = (f32x4){0.f, 0.f, 0.f, 0.f};
            for (int blk = 0; blk < 8; ++blk) {
                if (!((anym >> blk) & 1u)) continue;
                const int pg0 = pt[n * 16 + blk * 2], pg1 = pt[n * 16 + blk * 2 + 1];
#pragma unroll
                for (int rr = 0; rr < 8; ++rr) {
                    const int r = rl + 32 * rr; const int page = rr < 4 ? pg0 : pg1;
                    const f32x4 v4 = *(const f32x4*)(cache_v + (((size_t)page * 128 + (r & 127)) * 8 + h) * 64 + 4 * d4);
#pragma unroll
                    for (int t = 0; t < 4; ++t) acc[t] += PL[t * 2048 + blk * 256 + r] * v4;
                }
            }
#pragma unroll
            for (int t = 0; t < 4; ++t) *(LAS f32x4*)(lds + 32768 + ((rl * 4 + t) * 64 + 4 * d4) * 4) = acc[t];
        }
        __syncthreads();
        if (tid < 256) {
            const int t = tid >> 6, d = tid & 63; float o = 0.f;
#pragma unroll 8
            for (int rl = 0; rl < 32; ++rl) o += OP[(rl * 4 + t) * 64 + d];
            float l = 0.f;
#pragma unroll
            for (int w = 0; w < 8; ++w) l += REDL[w * 4 + t];
#pragma unroll
            for (int tp = 0; tp < 4; ++tp) { const float p = POWN[t * 4 + tp]; l += p; o += p * bf2f(Vb[(size_t)(MPROMPT + n * 4 + tp) * 512 + h * 64 + d]); }
            const size_t ro = (size_t)(MPROMPT + n * 4 + t);
            M0[ro * 1024 + h * 64 + d] = (bf16)f2bf(o / l * bf2f(GAs[ro * 512 + h * 64 + d]));
        }
        __syncthreads();
    }
}

__global__ void __launch_bounds__(NWAVES * 64, 2) fwd(Args args) {
    extern __shared__ __attribute__((aligned(16))) unsigned char lds_raw[];
    LAS unsigned char* lds = (LAS unsigned char*)lds_raw;
    volatile LAS unsigned* MISC = (volatile LAS unsigned*)(lds + MISC_OFF);
    const int tid = threadIdx.x, lane = tid & 63, wave = __builtin_amdgcn_readfirstlane(tid >> 6);
    const int G = gridDim.x; const int bx = blockIdx.x; const int vcu = (G % 8 == 0) ? (bx % 8) * (G / 8) + bx / 8 : bx;
    unsigned char* ws = args.ws;
    for (int u = tid; u < (LDS_BYTES - LDSCTL_OFF) / 4; u += NWAVES * 64) ((LAS unsigned*)(lds + LDSCTL_OFF))[u] = 0u;
    __syncthreads();
    XcdBarrier bar = xcd_barrier_post((unsigned*)(ws + WS_CTL) + CW_BAR, MISC + 8);

    const float* x_prompt = (const float*)args.in[I_XP]; const float* x_sample = (const float*)args.in[I_XS];
    float* out = args.out;
    bf16* W0T = (bf16*)(ws + WS_W0T); bf16* WO0T = (bf16*)(ws + WS_WO0T); bf16* W1T = (bf16*)(ws + WS_W1T); bf16* WO1T = (bf16*)(ws + WS_WO1T);
    float* RSTD0 = (float*)(ws + WS_RSTD0); float* LB = (float*)(ws + WS_LB); float* KMP = (float*)(ws + WS_KMP); float* SSQ = (float*)(ws + WS_SSQ);
    bf16* XB = (bf16*)(ws + WS_XB); bf16* Qb = (bf16*)(ws + WS_Q); bf16* Kb = (bf16*)(ws + WS_K); bf16* Vb = (bf16*)(ws + WS_V);
    bf16* GA = (bf16*)(ws + WS_GA); bf16* Ub = (bf16*)(ws + WS_U); bf16* GC = (bf16*)(ws + WS_GC);
    bf16* M0 = (bf16*)(ws + WS_M0); float* X1 = (float*)(ws + WS_X1); bf16* XB1 = (bf16*)(ws + WS_XB1); bf16* QQ = (bf16*)(ws + WS_QQ); float* LOGF = (float*)(ws + WS_LOGF);
    bf16* VV = (bf16*)(ws + WS_VV); bf16* GS = (bf16*)(ws + WS_GS); bf16* M1 = (bf16*)(ws + WS_M1);
    float* SCb = (float*)(ws + WS_SC); float* KMS = (float*)(ws + WS_KMS);
    float* OLOC = (float*)(ws + WS_OLOC); bf16* QBS = (bf16*)(ws + WS_QBS); float* USEG = (float*)(ws + WS_USEG); float* DSEG = (float*)(ws + WS_DSEG);

    {
        LAS float* scr = (LAS float*)(lds + wave * 16384);
        const int gw = vcu * NWAVES + wave, NGW = G * NWAVES;
        constexpr int I0 = 16 * (N0 / 32), IO = 16 * 32, I1 = 16 * (N1 / 32);
        constexpr int NITEMS = I0 + IO + I1 + IO;
        for (int it = gw; it < NITEMS; it += NGW) {
            int r = it;
            if (r < I0) { const int kb = r / (N0 / 32), dg = r % (N0 / 32); p0_transpose_item((const float*)args.in[I_WIN0], D, N0, W0T, 64 * kb, 32 * l0_src_group(dg), 32 * dg, (const float*)args.in[I_NORM0], scr, lane); continue; } r -= I0;
            if (r < IO) { const int kb = r / 32, dg = r % 32; p0_transpose_item((const float*)args.in[I_WOUT0], D, D, WO0T, 64 * kb, 32 * dg, 32 * dg, nullptr, scr, lane); continue; } r -= IO;
            if (r < I1) { const int kb = r / (N1 / 32), dg = r % (N1 / 32); p0_transpose_item((const float*)args.in[I_WIN1], D, N1, W1T, 64 * kb, 32 * dg, 32 * dg, (const float*)args.in[I_NORM1], scr, lane); continue; } r -= I1;
            { const int kb = r / 32, dg = r % 32; p0_transpose_item((const float*)args.in[I_WOUT1], D, D, WO1T, 64 * kb, 32 * dg, 32 * dg, nullptr, scr, lane); }
        }
        for (int m = gw; m < MTOT; m += NGW) {
            const float* xrow = m < MPROMPT ? x_prompt + (size_t)m * D : x_sample + (size_t)(m - MPROMPT) * D;
            const GAS f32x4* xr = (const GAS f32x4*)xrow + lane;
            f32x4 v[4]; float s = 0.f;
#pragma unroll
            for (int j = 0; j < 4; ++j) { v[j] = xr[64 * j]; s += (v[j].x * v[j].x + v[j].y * v[j].y) + (v[j].z * v[j].z + v[j].w * v[j].w); }
            s = wave_sum(s);
            if (lane == 0) RSTD0[m] = __builtin_amdgcn_rsqf(s * (1.0f / D) + 1e-6f);
            GAS unsigned long long* o8 = (GAS unsigned long long*)(XB + (size_t)m * D) + lane;
#pragma unroll
            for (int j = 0; j < 4; ++j) o8[64 * j] = (unsigned long long)pk2(v[j].x, v[j].y) | ((unsigned long long)pk2(v[j].z, v[j].w) << 32);
        }
        { const int gt = vcu * (NWAVES * 64) + tid; if (gt < 1024) { const float* l = (const float*)args.in[I_LBL]; LB[gt] = 1.0f / (1.0f + __expf(l[gt] - l[1024 + gt])); } }
        { const f32x4* sc = (const f32x4*)args.in[I_SCONV]; f32x4* cs = (f32x4*)(out + O_CS);
          for (int i = vcu * (NWAVES * 64) + tid; i < NDEC * 26 * 128; i += G * NWAVES * 64) { const int n = i / (26 * 128), rem = i % (26 * 128); cs[(size_t)n * 30 * 128 + rem] = sc[(size_t)n * 30 * 128 + 4 * 128 + rem]; } }
    }
    xcd_barrier(bar);

    {
        pg8::Gemm g{XB, W0T, MTOT, N0, D}; pg8::StaticOrder S; S.init(MTOT, N0, G, bx);
        pg8::EpiIn0 E{RSTD0, (const float*)args.in[I_QN], (const float*)args.in[I_KN], Qb, Kb, Vb, GA, Ub, GC,
                      out + O_KP, out + O_VP, out + O_KS, out + O_VS, out + O_CP, out + O_CS, KMP};
        pg8::gemm_phase<pg8::EpiIn0, pg8::StaticOrder, true, true>(lds, g, S, E);
    }
    xcd_barrier(bar);

    conv_phase(lds, vcu, G, Ub, GC, (const float*)args.in[I_SCONV], (const float*)args.in[I_CW], (const float*)args.in[I_CB], (const float*)args.in[I_LNG], (const float*)args.in[I_LNB], M0);
    attn_sample_passA(lds, vcu, G, Qb, (const float*)args.in[I_CK], (const int*)args.in[I_PT], SCb, KMS);
    xcd_barrier(bar);

    attn_prompt_phase(lds, vcu, G, Qb, Kb, Vb, GA, KMP, (const float*)args.in[I_QN], (const float*)args.in[I_KN], M0);
    attn_sample_passB(lds, vcu, G, Qb, Kb, Vb, GA, (const float*)args.in[I_CV], (const int*)args.in[I_PT], SCb, KMS, (const float*)args.in[I_QN], (const float*)args.in[I_KN], M0);
    xcd_barrier(bar);

    {
        pg8::Gemm g{M0, WO0T, MTOT, D, D}; pg8::StaticOrder S; S.init(MTOT, D, G, bx);
        pg8::EpiOut0 E{x_prompt, x_sample, X1, XB1, SSQ};
        pg8::gemm_phase<pg8::EpiOut0, pg8::StaticOrder, true, true>(lds, g, S, E);
    }
    xcd_barrier(bar);

    {
        pg8::Gemm g{XB1, W1T, MTOT, N1, D}; pg8::StaticOrder S; S.init(MTOT, N1, G, bx);
        pg8::EpiIn1 E{SSQ, LB, QQ, VV, GS, LOGF};
        pg8::gemm_phase<pg8::EpiIn1, pg8::StaticOrder, true, true>(lds, g, S, E);
    }
    xcd_barrier(bar);

    scan_pass1(lds, vcu, G, QQ, LOGF, VV, OLOC, QBS, USEG, DSEG);
    scan_sample(lds, vcu, G, QQ, LOGF, VV, GS, (const float*)args.in[I_ONORM], (const float*)args.in[I_SHGRN], out + O_HS, M1);
    xcd_barrier(bar);

    scan_pass3(lds, vcu, G, QBS, OLOC, USEG, DSEG, GS, (const float*)args.in[I_ONORM], M1, out + O_HP);
    xcd_barrier(bar);

    {
        pg8::Gemm g{M1, WO1T, MTOT, D, D}; pg8::StaticOrder S; S.init(MTOT, D, G, bx);
        pg8::EpiOut1 E{X1, out + O_Y};
        pg8::gemm_phase<pg8::EpiOut1, pg8::StaticOrder, true, true>(lds, g, S, E);
    }
}
extern "C" void kernel_launch(void* const* d_in, const int* in_sizes, int n_in, void* d_out, int out_size, void* d_ws, size_t ws_size, hipStream_t stream) {
    static int grid = 0;
    if (grid == 0) {
        if (n_in != N_IN || (size_t)out_size != O_END || ws_size < WS_END) { fprintf(stderr, "kernel_launch: unexpected shapes (n_in %d out %d ws %zu)\n", n_in, out_size, ws_size); grid = -1; return; }
        int dev = 0, cus = 0, per_cu = 0;
        if (hipGetDevice(&dev) != hipSuccess || hipDeviceGetAttribute(&cus, hipDeviceAttributeMultiprocessorCount, dev) != hipSuccess) { grid = -1; return; }
        if (hipFuncSetAttribute((const void*)fwd, hipFuncAttributeMaxDynamicSharedMemorySize, LDS_BYTES) != hipSuccess) { fprintf(stderr, "kernel_launch: hipFuncSetAttribute failed\n"); grid = -1; return; }
        if (hipOccupancyMaxActiveBlocksPerMultiprocessor(&per_cu, (const void*)fwd, NWAVES * 64, LDS_BYTES) != hipSuccess || per_cu < 1) fprintf(stderr, "kernel_launch: occupancy query reports %d\n", per_cu);
        (void)hipGetLastError();
        grid = cus;
    }
    if (grid < 0) return;
    if (hipMemsetAsync((char*)d_ws + WS_CTL, 0, CTL_ZERO_BYTES, stream) != hipSuccess) return;
    Args a{};
    for (int i = 0; i < N_IN; ++i) a.in[i] = d_in[i];
    a.out = (float*)d_out; a.ws = (unsigned char*)d_ws;
    hipLaunchKernelGGL(fwd, dim3(grid), dim3(NWAVES * 64), LDS_BYTES, stream, a);
}
```

```cpp
#include <hip/hip_runtime.h>
#include <cstdio>
#include <cstdint>
namespace pg8 {
#define PG8_LAS __attribute__((address_space(3)))
typedef unsigned short bf16_t;
typedef short bf16x8 __attribute__((ext_vector_type(8)));
typedef float f32x4 __attribute__((ext_vector_type(4)));
typedef unsigned u32x4 __attribute__((ext_vector_type(4)));
constexpr int BM = 256, BK = 64, HALF = 128, HTB = HALF * BK * 2  , STAGE_BYTES = 8 * HTB, NXCD = 8, WGM = 8;

__host__ __device__ __forceinline__ int lds_byte(int r, int c) { const int st = (r >> 4) * 2 + (c >> 5), rr = r & 15, cc = c & 31, ob = rr * 64 + cc * 2; return st * 1024 + (ob ^ (((ob >> 9) & 1) << 5)); }
__host__ __device__ __forceinline__ void stage_rc(int b, int& R, int& C) { const int st = b / 1024, sb = b % 1024, swz = sb ^ (((sb >> 9) & 1) << 5); R = (st >> 1) * 16 + swz / 64; C = (st & 1) * 32 + (swz % 64) / 2; }
__host__ __device__ __forceinline__ int perm32(int rho) { const int n = rho >> 4, i = rho & 15; return 8 * (i >> 2) + 4 * n + (i & 3); }

struct Unit { int pm, pn; };
struct Gemm { const bf16_t* A; const bf16_t* Bt; int M, N, K; };

struct StaticOrder {
    int nM, nN, nwg, G, c;
    __host__ __device__ void init(int M, int N, int G_, int c_) { nM = M / BM; nN = N / BM; nwg = nM * nN; G = G_; c = c_; }
    __host__ __device__ bool next(int i, Unit& u) const {
        const long L = (long)i * G + c; if (L >= nwg) return false;
        int wgid = (int)L; { const int q = nwg / NXCD, r = nwg % NXCD, xcd = wgid % NXCD, off = wgid / NXCD; wgid = (xcd < r ? xcd * (q + 1) : r * (q + 1) + (xcd - r) * q) + off; }
        const int nig = WGM * nN, gid = wgid / nig, fm = gid * WGM, gsz = (nM - fm) < WGM ? (nM - fm) : WGM;
        u.pm = fm + ((wgid % nig) % gsz); u.pn = (wgid % nig) / gsz; return true;
    }
    __device__ __forceinline__ void a_ready(const Unit&) const {}
    __device__ __forceinline__ void done(const Unit&) const {}
};
__device__ __forceinline__ unsigned cvt_pk_bf16(float lo, float hi) { unsigned r; asm volatile("v_cvt_pk_bf16_f32 %0, %1, %2" : "=v"(r) : "v"(lo), "v"(hi)); return r; }
typedef float f32x2 __attribute__((ext_vector_type(2)));
typedef unsigned u32x2 __attribute__((ext_vector_type(2)));
__device__ __forceinline__ float fsigmoid(float x) { return __builtin_amdgcn_rcpf(1.0f + __builtin_amdgcn_exp2f(-1.4426950408889634f * x)); }
__device__ __forceinline__ float fsilu(float x) { return x * fsigmoid(x); }
__device__ __forceinline__ f32x4 silu4(f32x4 v) { return (f32x4){fsilu(v[0]), fsilu(v[1]), fsilu(v[2]), fsilu(v[3])}; }
__device__ __forceinline__ f32x4 sigm4(f32x4 v) { return (f32x4){fsigmoid(v[0]), fsigmoid(v[1]), fsigmoid(v[2]), fsigmoid(v[3])}; }
__device__ __forceinline__ u32x4 pack8(f32x4 a, f32x4 b) { u32x4 w; w.x = cvt_pk_bf16(a[0], a[1]); w.y = cvt_pk_bf16(a[2], a[3]); w.z = cvt_pk_bf16(b[0], b[1]); w.w = cvt_pk_bf16(b[2], b[3]); return w; }
__device__ __forceinline__ float dot4(f32x4 a) { return (a[0] * a[0] + a[1] * a[1]) + (a[2] * a[2] + a[3] * a[3]); }

constexpr int MP = 16384;
constexpr float RMS_EPS = 1e-6f;

struct EpiIn0 {
    static constexpr bool PERM = true, AFTER_DRAIN = false;
    const float* rstd; const float* qg; const float* kg;
    bf16_t *Q, *Kb, *Vb, *GA, *U, *GC;
    float *k_prompt, *v_prompt, *k_sample, *v_sample, *conv_prompt, *conv_sample;
    float* kmp;
    __device__ __forceinline__ void operator()(const f32x4 (&acc)[2][2][4][2], const Unit& u, int wr, int wc, int fr, int fq) const {
        const int pn = u.pn;
        const int rowb = u.pm * BM + wr * 64 + fr;
        const bool sample = u.pm >= 64;
        if (pn < 4) {
            const bool isk = pn >= 2;
            const float* g = isk ? kg : qg;
            f32x4 gv[2][2];
#pragma unroll
            for (int bj = 0; bj < 2; ++bj)
#pragma unroll
                for (int n = 0; n < 2; ++n) gv[bj][n] = *(const f32x4*)(g + 32 * bj + 8 * fq + 4 * n);
            const int colb = 256 * (pn & 1) + 64 * wc + 8 * fq;
            bf16_t* ob = isk ? Kb : Q;
            float* of = sample ? (k_sample - (size_t)MP * 512) : k_prompt;
#pragma unroll
            for (int ai = 0; ai < 2; ++ai) {
                f32x4 ks[2][2];
#pragma unroll
                for (int bj = 0; bj < 2; ++bj)
#pragma unroll
                    for (int n = 0; n < 2; ++n) ks[bj][n] = (f32x4){0.f, 0.f, 0.f, 0.f};
#pragma unroll
                for (int m = 0; m < 4; ++m) {
                    const int r = rowb + ai * HALF + m * 16;
                    const float rs = rstd[r];
                    f32x4 v[2][2]; float ss = 0.f;
#pragma unroll
                    for (int bj = 0; bj < 2; ++bj)
#pragma unroll
                        for (int n = 0; n < 2; ++n) { v[bj][n] = acc[ai][bj][m][n] * rs; ss += dot4(v[bj][n]); }
                    ss += __shfl_xor(ss, 16); ss += __shfl_xor(ss, 32);
                    const float inv = __builtin_amdgcn_rsqf(ss * (1.0f / 64.0f) + RMS_EPS);
#pragma unroll
                    for (int bj = 0; bj < 2; ++bj) {
                        const f32x4 o0 = v[bj][0] * inv * gv[bj][0], o1 = v[bj][1] * inv * gv[bj][1];
                        const size_t off = (size_t)r * 512 + colb + 32 * bj;
                        *(u32x4*)(ob + off) = pack8(o0, o1);
                        if (isk) { *(f32x4*)(of + off) = o0; *(f32x4*)(of + off + 4) = o1; ks[bj][0] += o0; ks[bj][1] += o1; }
                    }
                }
                if (isk && !sample) {
#pragma unroll
                    for (int bj = 0; bj < 2; ++bj)
#pragma unroll
                        for (int n = 0; n < 2; ++n) {
                            f32x4 s = ks[bj][n];
#pragma unroll
                            for (int o = 1; o < 16; o <<= 1) { s[0] += __shfl_xor(s[0], o); s[1] += __shfl_xor(s[1], o); s[2] += __shfl_xor(s[2], o); s[3] += __shfl_xor(s[3], o); }
                            if (fr == 0) *(f32x4*)(kmp + ((size_t)(u.pm * 4 + ai * 2 + wr)) * 512 + colb + 32 * bj + 4 * n) = s;
                        }
                }
            }
        } else if (pn < 6) {
            const int colb = 256 * (pn & 1) + 64 * wc + 8 * fq;
            float* of = sample ? (v_sample - (size_t)MP * 512) : v_prompt;
#pragma unroll
            for (int ai = 0; ai < 2; ++ai)
#pragma unroll
                for (int m = 0; m < 4; ++m) {
                    const int r = rowb + ai * HALF + m * 16;
                    const float rs = rstd[r];
#pragma unroll
                    for (int bj = 0; bj < 2; ++bj) {
                        const f32x4 o0 = acc[ai][bj][m][0] * rs, o1 = acc[ai][bj][m][1] * rs;
                        const size_t off = (size_t)r * 512 + colb + 32 * bj;
                        *(u32x4*)(Vb + off) = pack8(o0, o1);
                        *(f32x4*)(of + off) = o0; *(f32x4*)(of + off + 4) = o1;
                    }
                }
        } else if (pn < 8 || pn >= 12) {
            const int colb = 256 * (pn & 1) + 64 * wc + 8 * fq;
            bf16_t* ob = pn < 8 ? GA : GC;
#pragma unroll
            for (int ai = 0; ai < 2; ++ai)
#pragma unroll
                for (int m = 0; m < 4; ++m) {
                    const int r = rowb + ai * HALF + m * 16;
                    const float rs = rstd[r];
#pragma unroll
                    for (int bj = 0; bj < 2; ++bj) {
                        const f32x4 o0 = silu4(acc[ai][bj][m][0] * rs), o1 = silu4(acc[ai][bj][m][1] * rs);
                        *(u32x4*)(ob + (size_t)r * 512 + colb + 32 * bj) = pack8(o0, o1);
                    }
                }
        } else {
            const int ch0 = 128 * (pn - 8) + 32 * wc + 8 * fq;
            const bool tailp = !sample && ((u.pm & 15) == 15);
#pragma unroll
            for (int ai = 0; ai < 2; ++ai)
#pragma unroll
                for (int m = 0; m < 4; ++m) {
                    const int r = rowb + ai * HALF + m * 16;
                    const float rs = rstd[r];
                    const f32x4 o0 = (acc[ai][0][m][0] * rs) * sigm4(acc[ai][1][m][0] * rs), o1 = (acc[ai][0][m][1] * rs) * sigm4(acc[ai][1][m][1] * rs);
                    *(u32x4*)(U + (size_t)r * 512 + ch0) = pack8(o0, o1);
                    if (tailp) { const int tok = r & 4095; if (tok >= 4066) { float* d = conv_prompt + ((size_t)((r >> 12) * 30 + (tok - 4066))) * 512 + ch0; *(f32x4*)d = o0; *(f32x4*)(d + 4) = o1; } }
                    if (sample) { const int rr = r - MP; float* d = conv_sample + ((size_t)((rr >> 2) * 30 + 26 + (rr & 3))) * 512 + ch0; *(f32x4*)d = o0; *(f32x4*)(d + 4) = o1; }
                }
        }
    }
};

struct EpiOut0 {
    static constexpr bool PERM = false, AFTER_DRAIN = false;
    const float* xp; const float* xs; float* X1; bf16_t* XB1; float* SSQ;
    __device__ __forceinline__ void operator()(const f32x4 (&acc)[2][2][4][2], const Unit& u, int wr, int wc, int fr, int fq) const {
        const int rowb = u.pm * BM + wr * 64 + fr, col0 = u.pn * BM + wc * 32 + 4 * fq;
        const float* xb = u.pm >= 64 ? xs - (size_t)MP * 1024 : xp;
#pragma unroll
        for (int ai = 0; ai < 2; ++ai)
#pragma unroll
            for (int m = 0; m < 4; ++m) {
                const int r = rowb + ai * HALF + m * 16; const size_t ro = (size_t)r * 1024 + col0; float ss = 0.f;
#pragma unroll
                for (int bj = 0; bj < 2; ++bj)
#pragma unroll
                    for (int n = 0; n < 2; ++n) {
                        const size_t o_ = ro + bj * HALF + n * 16;
                        const f32x4 o = *(const f32x4*)(xb + o_) + acc[ai][bj][m][n];
                        *(f32x4*)(X1 + o_) = o; u32x2 w; w.x = cvt_pk_bf16(o[0], o[1]); w.y = cvt_pk_bf16(o[2], o[3]); *(u32x2*)(XB1 + o_) = w; ss += dot4(o);
                    }
                ss += __shfl_xor(ss, 16); ss += __shfl_xor(ss, 32);
                if (fq == 0) SSQ[(size_t)r * 16 + u.pn * 4 + wc] = ss;
            }
    }
};
struct EpiIn1 {
    static constexpr bool PERM = true, AFTER_DRAIN = false;
    const float* SSQ; const float* LB; bf16_t *QQ, *VV, *GS; float* LOGF;
    __device__ __forceinline__ void operator()(const f32x4 (&acc)[2][2][4][2], const Unit& u, int wr, int wc, int fr, int fq) const {
        const int rowb = u.pm * BM + wr * 64 + fr, type = u.pn >> 2, cl0 = (u.pn & 3) * BM + wc * 32 + 8 * fq;
#pragma unroll
        for (int ai = 0; ai < 2; ++ai)
#pragma unroll
            for (int m = 0; m < 4; ++m) {
                const int r = rowb + ai * HALF + m * 16;
                const f32x4* sp = (const f32x4*)(SSQ + (size_t)r * 16);
                const f32x4 s0 = sp[0], s1 = sp[1], s2 = sp[2], s3 = sp[3];
                const float tot = (((s0[0] + s0[1]) + (s0[2] + s0[3])) + ((s1[0] + s1[1]) + (s1[2] + s1[3]))) + (((s2[0] + s2[1]) + (s2[2] + s2[3])) + ((s3[0] + s3[1]) + (s3[2] + s3[3])));
                const float rs = __builtin_amdgcn_rsqf(tot * (1.0f / 1024.0f) + RMS_EPS);
#pragma unroll
                for (int bj = 0; bj < 2; ++bj) {
                    const f32x4 v0 = acc[ai][bj][m][0] * rs, v1 = acc[ai][bj][m][1] * rs;
                    const int c = cl0 + bj * HALF; const size_t off = (size_t)r * 1024 + c;
                    if (type == 0) *(u32x4*)(QQ + off) = pack8(silu4(v0), silu4(v1));
                    else if (type == 1) {
                        const f32x4 l0 = *(const f32x4*)(LB + c), l1 = *(const f32x4*)(LB + c + 4);
                        const f32x4 f0 = l0 + (1.0f - l0) * sigm4(v0), f1 = l1 + (1.0f - l1) * sigm4(v1);
                        *(f32x4*)(LOGF + off) = (f32x4){__logf(f0[0]), __logf(f0[1]), __logf(f0[2]), __logf(f0[3])};
                        *(f32x4*)(LOGF + off + 4) = (f32x4){__logf(f1[0]), __logf(f1[1]), __logf(f1[2]), __logf(f1[3])};
                    }
                    else if (type == 2) *(u32x4*)(VV + off) = pack8(v0, v1);
                    else *(u32x4*)(GS + off) = pack8(silu4(v0), silu4(v1));
                }
            }
    }
};
struct EpiOut1 {
    static constexpr bool PERM = false, AFTER_DRAIN = false;
    const float* X1; float* Y;
    __device__ __forceinline__ void operator()(const f32x4 (&acc)[2][2][4][2], const Unit& u, int wr, int wc, int fr, int fq) const {
        const int rowb = u.pm * BM + wr * 64 + fr, col0 = u.pn * BM + wc * 32 + 4 * fq;
#pragma unroll
        for (int ai = 0; ai < 2; ++ai)
#pragma unroll
            for (int m = 0; m < 4; ++m) {
                const size_t ro = (size_t)(rowb + ai * HALF + m * 16) * 1024 + col0;
#pragma unroll
                for (int bj = 0; bj < 2; ++bj)
#pragma unroll
                    for (int n = 0; n < 2; ++n) { const size_t o_ = ro + bj * HALF + n * 16; *(f32x4*)(Y + o_) = *(const f32x4*)(X1 + o_) + acc[ai][bj][m][n]; }
            }
    }
};
template <class Epi, class Sched, bool ALIGN_EPI = false, bool SP2 = false>
__device__ __forceinline__ void gemm_phase(PG8_LAS unsigned char* lds, const Gemm g, const Sched& S, const Epi& E) {
    const int tid = threadIdx.x, wid = __builtin_amdgcn_readfirstlane(tid >> 6), lane = tid & 63, wr = wid >> 2, wc = wid & 3, fr = lane & 15, fq = lane >> 4;
    const int K = g.K, nt = K / BK;
    unsigned voffA[2], voffB[2];
#pragma unroll
    for (int i = 0; i < 2; ++i) { int R, C; stage_rc(tid * 16 + i * 8192, R, C); const int Rb = Epi::PERM ? ((R & ~31) + perm32(R & 31)) : R;
        voffA[i] = (unsigned)(R * K + C) * 2u; voffB[i] = (unsigned)(Rb * K + C) * 2u; }
    const size_t kstep = (size_t)(BK * 2);
    const size_t hstep = (size_t)HALF * K * 2;
    const size_t tstep = 2 * hstep;
    const unsigned ldsw = (unsigned)wid * 1024u;
    const int aoff = lds_byte(wr * 64 + fr, fq * 8), boff = lds_byte(wc * 32 + fr, fq * 8);
#define PG8_SA(b, h) (((b) * 2 + (h)) * HTB)
#define PG8_SB(b, h) ((4 + (b) * 2 + (h)) * HTB)
#define PG8_STAGE(bufoff, gbase, voff) do { _Pragma("unroll") for (int _i = 0; _i < 2; ++_i) \
        __builtin_amdgcn_global_load_lds((const unsigned*)((const char*)(gbase) + (voff)[_i]), (PG8_LAS unsigned*)(lds + (bufoff) + ldsw + _i * 8192), 16, 0, 0); } while (0)
#define PG8_LDA(dst, b, h) do { _Pragma("unroll") for (int m = 0; m < 4; ++m) _Pragma("unroll") for (int k = 0; k < 2; ++k) dst[m][k] = *(const PG8_LAS bf16x8*)(lds + PG8_SA(b, h) + aoff + m * 2048 + k * 1024); } while (0)
#define PG8_LDB(dst, b, h) do { _Pragma("unroll") for (int n = 0; n < 2; ++n) _Pragma("unroll") for (int k = 0; k < 2; ++k) dst[n][k] = *(const PG8_LAS bf16x8*)(lds + PG8_SB(b, h) + boff + n * 2048 + k * 1024); } while (0)
#define PG8_MMA(ai, bj, At, Bt) do { __builtin_amdgcn_s_setprio(1); _Pragma("unroll") for (int m = 0; m < 4; ++m) _Pragma("unroll") for (int n = 0; n < 2; ++n) _Pragma("unroll") for (int k = 0; k < 2; ++k) \
        acc[ai][bj][m][n] = __builtin_amdgcn_mfma_f32_16x16x32_bf16(Bt[n][k], At[m][k], acc[ai][bj][m][n], 0, 0, 0); __builtin_amdgcn_s_setprio(0); } while (0)
#define PG8_WAIT_V(n) asm volatile("s_waitcnt vmcnt(" #n ")" ::: "memory")
#define PG8_WAIT_L(n) asm volatile("s_waitcnt lgkmcnt(" #n ")" ::: "memory")
#define PG8_BAR __builtin_amdgcn_s_barrier()
#define PG8_SCHED __builtin_amdgcn_sched_barrier(0)
    Unit cur, nxt; int ui = 0;
    if (!S.next(0, cur)) return;
    f32x4 acc[2][2][4][2];
#pragma unroll
    for (int a = 0; a < 2; ++a)
#pragma unroll
        for (int b = 0; b < 2; ++b)
#pragma unroll
            for (int m = 0; m < 4; ++m)
#pragma unroll
                for (int n = 0; n < 2; ++n) acc[a][b][m][n] = (f32x4){0.f, 0.f, 0.f, 0.f};
    bf16x8 At[4][2], B0[2][2], B1[2][2];
    const char* cA = (const char*)g.A + (size_t)cur.pm * tstep; const char* cB = (const char*)g.Bt + (size_t)cur.pn * tstep;
    S.a_ready(cur);
    if constexpr (SP2) {
        PG8_STAGE(PG8_SB(0, 0), cB, voffB); PG8_STAGE(PG8_SB(0, 1), cB + hstep, voffB); PG8_STAGE(PG8_SA(0, 0), cA, voffA); PG8_STAGE(PG8_SA(0, 1), cA + hstep, voffA);
        if (wr == 1) PG8_BAR;
        PG8_WAIT_V(2); PG8_BAR;
        PG8_STAGE(PG8_SB(1, 0), cB + kstep, voffB); PG8_STAGE(PG8_SA(1, 0), cA + kstep, voffA); PG8_STAGE(PG8_SB(1, 1), cB + hstep + kstep, voffB);
        PG8_WAIT_V(6); PG8_BAR;
    } else {
        PG8_STAGE(PG8_SB(0, 0), cB, voffB); PG8_STAGE(PG8_SA(0, 0), cA, voffA); PG8_STAGE(PG8_SB(0, 1), cB + hstep, voffB); PG8_STAGE(PG8_SA(0, 1), cA + hstep, voffA);
        if (wr == 1) PG8_BAR;
        PG8_WAIT_V(4); PG8_BAR;
        PG8_STAGE(PG8_SB(1, 0), cB + kstep, voffB); PG8_STAGE(PG8_SA(1, 0), cA + kstep, voffA); PG8_STAGE(PG8_SB(1, 1), cB + hstep + kstep, voffB);
        PG8_WAIT_V(6); PG8_BAR;
    }
    for (;;) {
        const bool has_next = S.next(ui + 1, nxt);
        const char* nA = has_next ? (const char*)g.A + (size_t)nxt.pm * tstep : cA; const char* nB = has_next ? (const char*)g.Bt + (size_t)nxt.pn * tstep : cB;
        for (int t = 0; t < nt; t += 2) {
            const bool last = (t == nt - 2);
            const char* a1 = cA + (size_t)(t + 1) * kstep;
            const char* a2 = last ? nA : cA + (size_t)(t + 2) * kstep; const char* b2 = last ? nB : cB + (size_t)(t + 2) * kstep;
            const char* a3 = a2 + kstep; const char* b3 = b2 + kstep;
            if (last && has_next) S.a_ready(nxt);
            if constexpr (SP2) {
            PG8_LDB(B0, 0, 0); PG8_LDB(B1, 0, 1); PG8_SCHED; PG8_LDA(At, 0, 0); PG8_STAGE(PG8_SA(1, 1), a1 + hstep, voffA);
            PG8_WAIT_V(8); PG8_WAIT_L(0); PG8_BAR; PG8_MMA(0, 0, At, B0); PG8_MMA(0, 1, At, B1); PG8_BAR; PG8_SCHED;
            PG8_LDA(At, 0, 1); PG8_STAGE(PG8_SB(0, 0), b2, voffB); PG8_STAGE(PG8_SB(0, 1), b2 + hstep, voffB); PG8_STAGE(PG8_SA(0, 0), a2, voffA);
            PG8_WAIT_V(8); PG8_WAIT_L(0); PG8_BAR; PG8_MMA(1, 0, At, B0); PG8_MMA(1, 1, At, B1); PG8_BAR; PG8_SCHED;
            PG8_LDB(B0, 1, 0); PG8_LDB(B1, 1, 1); PG8_SCHED; PG8_LDA(At, 1, 0); PG8_STAGE(PG8_SA(0, 1), a2 + hstep, voffA);
            PG8_WAIT_V(8); PG8_WAIT_L(0); PG8_BAR; PG8_MMA(0, 0, At, B0); PG8_MMA(0, 1, At, B1); PG8_BAR; PG8_SCHED;
            PG8_LDA(At, 1, 1); PG8_STAGE(PG8_SB(1, 0), b3, voffB); PG8_STAGE(PG8_SB(1, 1), b3 + hstep, voffB); PG8_STAGE(PG8_SA(1, 0), a3, voffA);
            PG8_WAIT_V(8); PG8_WAIT_L(0); PG8_BAR; PG8_MMA(1, 0, At, B0); PG8_MMA(1, 1, At, B1); PG8_BAR; PG8_SCHED;
            } else {
            PG8_LDB(B0, 0, 0); PG8_SCHED; PG8_LDA(At, 0, 0); PG8_STAGE(PG8_SA(1, 1), a1 + hstep, voffA);
            PG8_WAIT_L(8); PG8_BAR; PG8_WAIT_L(0); PG8_MMA(0, 0, At, B0); PG8_BAR; PG8_SCHED;
            PG8_LDB(B1, 0, 1); PG8_STAGE(PG8_SB(0, 0), b2, voffB);
            PG8_BAR; PG8_WAIT_L(0); PG8_MMA(0, 1, At, B1); PG8_BAR;
            PG8_LDA(At, 0, 1); PG8_STAGE(PG8_SA(0, 0), a2, voffA);
            PG8_BAR; PG8_WAIT_L(0); PG8_MMA(1, 0, At, B0); PG8_BAR; PG8_SCHED;
            PG8_STAGE(PG8_SB(0, 1), b2 + hstep, voffB);
            PG8_WAIT_V(6); PG8_BAR; PG8_MMA(1, 1, At, B1); PG8_BAR;
            PG8_LDB(B0, 1, 0); PG8_SCHED; PG8_LDA(At, 1, 0); PG8_STAGE(PG8_SA(0, 1), a2 + hstep, voffA);
            PG8_WAIT_L(8); PG8_BAR; PG8_WAIT_L(0); PG8_MMA(0, 0, At, B0); PG8_BAR; PG8_SCHED;
            PG8_LDB(B1, 1, 1); PG8_STAGE(PG8_SB(1, 0), b3, voffB);
            PG8_BAR; PG8_WAIT_L(0); PG8_MMA(0, 1, At, B1); PG8_BAR;
            PG8_LDA(At, 1, 1); PG8_STAGE(PG8_SA(1, 0), a3, voffA);
            PG8_BAR; PG8_WAIT_L(0); PG8_MMA(1, 0, At, B0); PG8_BAR; PG8_SCHED;
            PG8_STAGE(PG8_SB(1, 1), b3 + hstep, voffB);
            PG8_WAIT_V(6); PG8_BAR; PG8_MMA(1, 1, At, B1); PG8_BAR;
            }
        }
        if constexpr (ALIGN_EPI) { if (wr == 0) PG8_BAR; }
        if constexpr (!Epi::AFTER_DRAIN) { E(acc, cur, wr, wc, fr, fq); S.done(cur); }
        if (!has_next) break;
#pragma unroll
        for (int a = 0; a < 2; ++a)
#pragma unroll
            for (int b = 0; b < 2; ++b)
#pragma unroll
                for (int m = 0; m < 4; ++m)
#pragma unroll
                    for (int n = 0; n < 2; ++n) acc[a][b][m][n] = (f32x4){0.f, 0.f, 0.f, 0.f};
        cur = nxt; cA = nA; cB = nB; ++ui;
        if constexpr (ALIGN_EPI) { if (wr == 1) PG8_BAR; }
    }
    PG8_WAIT_V(0);
    if constexpr (!ALIGN_EPI) { if (wr == 0) PG8_BAR; }
    PG8_BAR;
    if constexpr (Epi::AFTER_DRAIN) { E.fused(acc, cur, wr, wc, fr, fq, lds, wid, lane); S.done(cur); }
#undef PG8_SA
#undef PG8_SB
#undef PG8_STAGE
#undef PG8_LDA
#undef PG8_LDB
#undef PG8_MMA
#undef PG8_WAIT_V
#undef PG8_WAIT_L
#undef PG8_BAR
#undef PG8_SCHED
}
}

constexpr int NWAVES = 8;
constexpr int D = 1024, MPROMPT = 16384, MSAMPLE = 512, MTOT = MPROMPT + MSAMPLE;
constexpr int SEQ = 4096, NB = 4, NDEC = 128, TDEC = 4;
constexpr int N0 = 3584, N1 = 4096;
constexpr size_t MiB = 1u << 20;
constexpr size_t WS_CTL = 0, CTL_ZERO_BYTES = 1 * MiB;
constexpr size_t WS_W0T = 2 * MiB, WS_WO0T = 10 * MiB, WS_W1T = 12 * MiB, WS_WO1T = 20 * MiB;
constexpr size_t WS_RSTD0 = 22 * MiB, WS_LB = 23 * MiB, WS_KMP = 24 * MiB, WS_SSQ = 26 * MiB;
constexpr size_t WS_XB = 64 * MiB, WS_Q = 128 * MiB, WS_K = 160 * MiB, WS_V = 192 * MiB, WS_GA = 224 * MiB, WS_U = 256 * MiB, WS_GC = 288 * MiB;
constexpr size_t WS_M0 = 320 * MiB, WS_X1 = 384 * MiB, WS_XB1 = 464 * MiB, WS_QQ = 512 * MiB, WS_LOGF = 576 * MiB, WS_VV = 656 * MiB, WS_GS = 704 * MiB;
constexpr size_t WS_M1 = 752 * MiB, WS_OLOC = 800 * MiB, WS_QBS = 880 * MiB, WS_USEG = 928 * MiB, WS_DSEG = 952 * MiB, WS_SC = 960 * MiB, WS_KMS = 1000 * MiB, WS_END = 1024 * MiB;
constexpr size_t WS_STAMP = 1010 * MiB;
constexpr int CW_BAR = 4096;
constexpr int RING_BYTES = 131072, LDSCTL_OFF = RING_BYTES, MISC_OFF = LDSCTL_OFF + 320, LDS_BYTES = 147456;

#define GAS __attribute__((address_space(1)))
#define LAS __attribute__((address_space(3)))
typedef unsigned short bf16;
typedef unsigned v4u __attribute__((ext_vector_type(4)));
typedef float f32x4 __attribute__((ext_vector_type(4)));
typedef short bf16x8 __attribute__((ext_vector_type(8)));
#define LDS_WAIT() asm volatile("s_waitcnt lgkmcnt(0)" ::: "memory")
#define VM_WAIT() asm volatile("s_waitcnt vmcnt(0)" ::: "memory")
__device__ __forceinline__ unsigned f2bf(float f) { unsigned u = __builtin_bit_cast(unsigned, f); return (u + 0x7fffu + ((u >> 16) & 1u)) >> 16; }
__device__ __forceinline__ unsigned pk2(float lo, float hi) { return f2bf(lo) | (f2bf(hi) << 16); }
__device__ __forceinline__ float bf2f(unsigned short b) { return __builtin_bit_cast(float, ((unsigned)b) << 16); }
__device__ __forceinline__ float wave_sum(float v) {
#pragma unroll
    for (int o = 1; o < 64; o <<= 1) v += __shfl_xor(v, o);
    return v;
}
#define XB_TMO      128
#define XB_XCNT(j)  (256  + 64 * (j))
#define XB_XSUB(j)  (1280 + 64 * (j))
#define XB_XGEN(j)  (2304 + 64 * (j))
#define XB_TOP      3328
#define XB_TOPGEN   3392
#define XCD_BAR_WORDS 3456
#define XB_SPIN_CAP (1u << 18)
#define LAS __attribute__((address_space(3)))

__device__ __forceinline__ unsigned xb_ld(unsigned* p)              { return __hip_atomic_load(p, __ATOMIC_RELAXED, __HIP_MEMORY_SCOPE_AGENT); }
__device__ __forceinline__ unsigned xb_add(unsigned* p, unsigned v) { return __hip_atomic_fetch_add(p, v, __ATOMIC_RELAXED, __HIP_MEMORY_SCOPE_AGENT); }
__device__ __forceinline__ unsigned xb_xcc_id() { return (unsigned)__builtin_amdgcn_s_getreg((3 << 11) | 20) & 0xFu; }
#define XB_SPIN(cond, bar) do { unsigned _sp = 0; while (cond) { __builtin_amdgcn_s_sleep(1); \
    if ((++_sp & 255u) == 0u) { if (xb_ld(&(bar)[XB_TMO])) break; if (_sp > XB_SPIN_CAP) { atomicAdd(&(bar)[XB_TMO], 1u); break; } } } } while (0)

struct XcdBarrier {
    unsigned* bar; unsigned x;
    volatile LAS unsigned* st;
};

__device__ __forceinline__ XcdBarrier xcd_barrier_post(unsigned* bar, volatile LAS unsigned* st) {
    XcdBarrier b; b.bar = bar; b.x = xb_xcc_id(); b.st = st;
    if (threadIdx.x == 0) (void)xb_add(&bar[XB_XCNT(b.x)], 1u);
    return b;
}
__device__ __forceinline__ void xcd_barrier_complete(unsigned* bar, unsigned x, unsigned& nloc, unsigned& nx) {
    const unsigned G = gridDim.x * gridDim.y * gridDim.z;
    unsigned sum, cnt, mine, sp = 0u;
    for (;;) {
        sum = 0u; cnt = 0u; mine = 0u;
#pragma unroll
        for (unsigned j = 0; j < 16; ++j) { const unsigned c = xb_ld(&bar[XB_XCNT(j)]); sum += c; cnt += (c > 0u) ? 1u : 0u; mine = (j == x) ? c : mine; }
        if (sum == G) break;
        __builtin_amdgcn_s_sleep(1);
        if ((++sp & 255u) == 0u) { if (xb_ld(&bar[XB_TMO])) break; if (sp > XB_SPIN_CAP) { atomicAdd(&bar[XB_TMO], 1u); break; } }
    }
    nloc = mine > 0u ? mine : 1u; nx = cnt > 0u ? cnt : 1u;
}

__device__ __forceinline__ void xcd_barrier(const XcdBarrier& b) {
    asm volatile("s_waitcnt vmcnt(0)" ::: "memory");
    __syncthreads();
    if (threadIdx.x == 0) {
        unsigned* bar = b.bar;
        __builtin_amdgcn_s_waitcnt(0);
        unsigned nloc = b.st[0], nx = b.st[1];
        if (nloc == 0u) { xcd_barrier_complete(bar, b.x, nloc, nx); b.st[0] = nloc; b.st[1] = nx; }
        const unsigned old = xb_add(&bar[XB_XSUB(b.x)], 1u);
        const unsigned gen = old / nloc;
        if (old + 1u == (gen + 1u) * nloc) {
            __builtin_amdgcn_fence(__ATOMIC_RELEASE, "agent");
            asm volatile("s_waitcnt vmcnt(0)" ::: "memory");
            const unsigned og = xb_add(&bar[XB_TOP], 1u);
            const unsigned tg = og / nx;
            if (og + 1u == (tg + 1u) * nx) xb_add(&bar[XB_TOPGEN], 1u);
            else XB_SPIN(xb_ld(&bar[XB_TOPGEN]) == tg, bar);
            __builtin_amdgcn_fence(__ATOMIC_ACQUIRE, "agent");
            xb_add(&bar[XB_XGEN(b.x)], 1u);
            asm volatile("s_waitcnt vmcnt(0)" ::: "memory");
        } else {
            XB_SPIN(xb_ld(&bar[XB_XGEN(b.x)]) == gen, bar);
            __builtin_amdgcn_fence(__ATOMIC_ACQUIRE, "agent");
            asm volatile("s_waitcnt vmcnt(0)" ::: "memory");
        }
    }
    __syncthreads();
}

constexpr size_t O_Y = 0, O_KP = 17301504, O_VP = O_KP + 8388608, O_KS = O_VP + 8388608, O_VS = O_KS + 262144, O_CP = O_VS + 262144, O_CS = O_CP + 61440, O_HP = O_CS + 1966080, O_HS = O_HP + 524288, O_END = O_HS + 16777216;
enum { I_XP = 0, I_XS, I_CK, I_CV, I_SCONV, I_SHGRN, I_PT, I_NORM0, I_WIN0, I_QN, I_KN, I_CW, I_CB, I_LNG, I_LNB, I_WOUT0, I_NORM1, I_WIN1, I_LBL, I_ONORM, I_WOUT1, N_IN };
struct Args { const void* in[N_IN]; float* out; unsigned char* ws; };

__device__ __forceinline__ void p0_transpose_item(const float* W, int K, int N, bf16* WT, int k0, int n0, int drow0, const float* gain, LAS float* scr, int lane) {
#pragma unroll 8
    for (int i = 0; i < 32; ++i) { const int kk = 2 * i + (lane >> 5); const float gsc = gain ? gain[k0 + kk] : 1.0f; scr[kk * 33 + (lane & 31)] = W[(size_t)(k0 + kk) * N + n0 + (lane & 31)] * gsc; }
    LDS_WAIT(); asm volatile("" ::: "memory");
    const int c = lane & 7;
#pragma unroll
    for (int j = 0; j < 4; ++j) { const int n = (lane >> 3) + 8 * j; const LAS float* s = scr + (8 * c) * 33 + n;
        v4u o; o.x = pk2(s[0 * 33], s[1 * 33]); o.y = pk2(s[2 * 33], s[3 * 33]); o.z = pk2(s[4 * 33], s[5 * 33]); o.w = pk2(s[6 * 33], s[7 * 33]);
        *(GAS v4u*)(WT + (size_t)(drow0 + n) * K + k0 + 8 * c) = o; }
    LDS_WAIT(); asm volatile("" ::: "memory");
}
__device__ __forceinline__ int l0_src_group(int dg) {
    const int pnD = dg >> 3, gi = dg & 7, bj = gi >> 2, wc = gi & 3;
    if (pnD >= 8 && pnD < 12) return (bj ? 80 : 64) + 4 * (pnD - 8) + wc;
    return 8 * pnD + 2 * wc + bj;
}


__device__ __forceinline__ void conv_phase(LAS unsigned char* lds, int vcu, int G, const bf16* U, const bf16* GCs, const float* state_conv,
                                           const float* cw, const float* cb, const float* lng, const float* lnb, bf16* M0) {
    const int tid = threadIdx.x, c = tid, wave = tid >> 6, lane = tid & 63;
    LAS float* Y = (LAS float*)lds;
    LAS float* ST = (LAS float*)(lds + 32768);
    float w[31];
#pragma unroll
    for (int i = 0; i < 31; ++i) w[i] = cw[i * 512 + c];
    const float bias = cb[c], gg = lng[c], be = lnb[c];
    for (int unit = vcu; unit < 1056; unit += G) {
        float y[16];
        if (unit < 1024) {
            const int r0 = unit * 16, tok0 = r0 & 4095;
            float uw[46];
#pragma unroll
            for (int i = 0; i < 46; ++i) { const int tt = tok0 - 30 + i; uw[i] = tt >= 0 ? bf2f(U[(size_t)(r0 - 30 + i) * 512 + c]) : 0.f; }
#pragma unroll
            for (int t = 0; t < 16; ++t) { float a = bias;
#pragma unroll
                for (int i = 0; i < 31; ++i) a += w[i] * uw[t + i];
                y[t] = a; }
        } else {
            const int s0 = (unit - 1024) * 4;
#pragma unroll
            for (int sq = 0; sq < 4; ++sq) { const int n = s0 + sq; float uw[34];
#pragma unroll
                for (int i = 0; i < 30; ++i) uw[i] = state_conv[((size_t)n * 30 + i) * 512 + c];
#pragma unroll
                for (int i = 0; i < 4; ++i) uw[30 + i] = bf2f(U[(size_t)(MPROMPT + n * 4 + i) * 512 + c]);
#pragma unroll
                for (int t = 0; t < 4; ++t) { float a = bias;
#pragma unroll
                    for (int i = 0; i < 31; ++i) a += w[i] * uw[t + i];
                    y[sq * 4 + t] = a; } }
        }
#pragma unroll
        for (int t = 0; t < 16; ++t) Y[t * 512 + c] = y[t];
        __syncthreads();
#pragma unroll
        for (int k = 0; k < 2; ++k) { const int t = 2 * wave + k; float v[8]; float s = 0.f;
#pragma unroll
            for (int j = 0; j < 8; ++j) { v[j] = Y[t * 512 + lane + 64 * j]; s += v[j]; }
            const float mean = wave_sum(s) * (1.0f / 512.0f); float q = 0.f;
#pragma unroll
            for (int j = 0; j < 8; ++j) { const float d = v[j] - mean; q += d * d; }
            const float var = wave_sum(q) * (1.0f / 512.0f);
            if (lane == 0) { ST[2 * t] = mean; ST[2 * t + 1] = 1.0f / sqrtf(var + 1e-6f); } }
        __syncthreads();
        const int rbase = unit < 1024 ? unit * 16 : MPROMPT + (unit - 1024) * 16;
#pragma unroll
        for (int t = 0; t < 16; ++t) { const float ln = (y[t] - ST[2 * t]) * ST[2 * t + 1] * gg + be; const float oc = pg8::fsilu(ln); const size_t r = (size_t)(rbase + t);
            M0[r * 1024 + 512 + c] = (bf16)f2bf(oc * bf2f(GCs[r * 512 + c])); }
        __syncthreads();
    }
}


typedef unsigned u32x4_t __attribute__((ext_vector_type(4)));
typedef unsigned u32x2_t __attribute__((ext_vector_type(2)));
__device__ __forceinline__ float fexp(float x) { return __builtin_amdgcn_exp2f(x * 1.4426950408889634f); }
__device__ __forceinline__ bf16x8 mk_frag(u32x2_t a, u32x2_t b) { u32x4_t w; w.x = a.x; w.y = a.y; w.z = b.x; w.w = b.y; return __builtin_bit_cast(bf16x8, w); }
__device__ __forceinline__ unsigned cvtpk(float lo, float hi) { return pg8::cvt_pk_bf16(lo, hi); }
constexpr int P1_QB = 0, P1_QT = 17408, P1_QTS = 34816, P1_KD = 47872, P1_KE = 65280, P1_KLT = 78336, P1_VT = 96768, P1_AB = 115200, P1_TOT = 124416, P1_DV = 126464;
constexpr int RP = 272, RS = 144;

__device__ __forceinline__ void scan_a_block(LAS unsigned char* lds, int aoff, int boff, int I, int J, bool diag, int lane) {
    const int l15 = lane & 15, g4 = lane >> 4;
    f32x4 acc = (f32x4){0.f, 0.f, 0.f, 0.f};
#pragma unroll
    for (int ks = 0; ks < 4; ++ks) {
        const bf16x8 a = *(const LAS bf16x8*)(lds + aoff + l15 * RP + (32 * ks + 8 * g4) * 2);
        const bf16x8 b = *(const LAS bf16x8*)(lds + boff + l15 * RP + (32 * ks + 8 * g4) * 2);
        acc = __builtin_amdgcn_mfma_f32_16x16x32_bf16(a, b, acc, 0, 0, 0);
    }
#pragma unroll
    for (int r = 0; r < 4; ++r) { const int t = 4 * g4 + r; const float v = (diag && l15 > t) ? 0.f : acc[r];
        *(LAS unsigned short*)(lds + P1_AB + (16 * I + t) * RS + (16 * J + l15) * 2) = (unsigned short)f2bf(v); }
}

__device__ __forceinline__ void scan_pass1(LAS unsigned char* lds, int vcu, int G, const bf16* QQ, const float* LOGF, const bf16* VV, float* OLOC, bf16* QBS, float* USEG, float* DSEG) {
    const int tid = threadIdx.x, lane = tid & 63, wave = __builtin_amdgcn_readfirstlane(tid >> 6), l15 = lane & 15, g4 = lane >> 4;
    const int k = tid & 127, I = __builtin_amdgcn_readfirstlane(tid >> 7);
    LAS float* TOT = (LAS float*)(lds + P1_TOT); LAS float* DV = (LAS float*)(lds + P1_DV);
    for (int unit = vcu; unit < 256; unit += G) {
        const int b = unit >> 6, h = (unit >> 3) & 7, g = unit & 7;
        for (int i = tid; i < 64 * RS / 4; i += 512) ((LAS unsigned*)(lds + P1_AB))[i] = 0u;
        f32x4 S[8];
#pragma unroll
        for (int kt = 0; kt < 8; ++kt) S[kt] = (f32x4){0.f, 0.f, 0.f, 0.f};
        float Bprev = 0.f;
        __syncthreads();
        for (int ch = 0; ch < 8; ++ch) {
            const size_t row0 = (size_t)b * 4096 + g * 512 + ch * 64;
            float lf[16], c[16]; unsigned short qv[16], vvv[16];
#pragma unroll
            for (int i = 0; i < 16; ++i) { const size_t o = (row0 + 16 * I + i) * 1024 + h * 128 + k; lf[i] = LOGF[o]; qv[i] = QQ[o]; vvv[i] = VV[o]; }
            { u32x4_t w0, w1;
              w0.x = vvv[0] | ((unsigned)vvv[1] << 16); w0.y = vvv[2] | ((unsigned)vvv[3] << 16); w0.z = vvv[4] | ((unsigned)vvv[5] << 16); w0.w = vvv[6] | ((unsigned)vvv[7] << 16);
              w1.x = vvv[8] | ((unsigned)vvv[9] << 16); w1.y = vvv[10] | ((unsigned)vvv[11] << 16); w1.z = vvv[12] | ((unsigned)vvv[13] << 16); w1.w = vvv[14] | ((unsigned)vvv[15] << 16);
              *(LAS u32x4_t*)(lds + P1_VT + k * RS + I * 32) = w0; *(LAS u32x4_t*)(lds + P1_VT + k * RS + I * 32 + 16) = w1; }
            c[0] = lf[0];
#pragma unroll
            for (int i = 1; i < 16; ++i) c[i] = c[i - 1] + lf[i];
            TOT[I * 128 + k] = c[15];
            __syncthreads();
            const float t0 = TOT[k], t1 = TOT[128 + k], t2 = TOT[256 + k], t3 = TOT[384 + k];
            const float rI = I == 0 ? 0.f : (I == 1 ? t0 : (I == 2 ? t0 + t1 : (t0 + t1) + t2));
            const float totI = I == 0 ? t0 : (I == 1 ? t1 : (I == 2 ? t2 : t3));
            const float btot = (t0 + t1) + (t2 + t3);
            const float e_rI = fexp(rI), e_prev = fexp(Bprev), e_klt = fexp(btot - rI - totI);
            const float sc1 = I == 2 ? fexp(t1) : fexp(t2), sc2 = fexp(t2 + t1);
            unsigned kl2[8];
#pragma unroll
            for (int i = 0; i < 16; ++i) {
                const int t = 16 * I + i;
                const float q = bf2f(qv[i]);
                const float qt = q * fexp(c[i]), qb = qt * e_rI;
                const float kk = 1.0f - fexp(lf[i]);
                const float kd = kk * fexp(fminf(-c[i], 80.f)), ke = kk * fexp(totI - c[i]), kl = ke * e_klt;
                *(LAS unsigned short*)(lds + P1_QB + t * RP + k * 2) = (unsigned short)f2bf(qb);
                *(LAS unsigned short*)(lds + P1_QT + t * RP + k * 2) = (unsigned short)f2bf(qt);
                *(LAS unsigned short*)(lds + P1_KD + t * RP + k * 2) = (unsigned short)f2bf(kd);
                if (I < 3) *(LAS unsigned short*)(lds + P1_KE + t * RP + k * 2) = (unsigned short)f2bf(ke);
                if (I == 2) *(LAS unsigned short*)(lds + P1_QTS + i * RP + k * 2) = (unsigned short)f2bf(qt * sc1);
                if (I == 3) { *(LAS unsigned short*)(lds + P1_QTS + (16 + i) * RP + k * 2) = (unsigned short)f2bf(qt * sc1); *(LAS unsigned short*)(lds + P1_QTS + (32 + i) * RP + k * 2) = (unsigned short)f2bf(qt * sc2); }
                QBS[(row0 + t) * 1024 + h * 128 + k] = (bf16)f2bf(qb * e_prev);
                if (i & 1) kl2[i >> 1] |= f2bf(kl) << 16; else kl2[i >> 1] = f2bf(kl);
            }
            { u32x4_t w0, w1; w0.x = kl2[0]; w0.y = kl2[1]; w0.z = kl2[2]; w0.w = kl2[3]; w1.x = kl2[4]; w1.y = kl2[5]; w1.z = kl2[6]; w1.w = kl2[7];
              *(LAS u32x4_t*)(lds + P1_KLT + k * RS + I * 32) = w0; *(LAS u32x4_t*)(lds + P1_KLT + k * RS + I * 32 + 16) = w1; }
            if (I == 0) DV[k] = fexp(btot);
            Bprev += btot;
            __syncthreads();
            if (wave < 4) scan_a_block(lds, P1_QT + 16 * wave * RP, P1_KD + 16 * wave * RP, wave, wave, true, lane);
            else if (wave < 7) scan_a_block(lds, P1_QT + 16 * (wave - 3) * RP, P1_KE + 16 * (wave - 4) * RP, wave - 3, wave - 4, false, lane);
            else scan_a_block(lds, P1_QTS, P1_KE, 2, 0, false, lane);
            if (wave == 0) scan_a_block(lds, P1_QTS + 16 * RP, P1_KE + 16 * RP, 3, 1, false, lane);
            if (wave == 1) scan_a_block(lds, P1_QTS + 32 * RP, P1_KE, 3, 0, false, lane);
            __syncthreads();
            {
                bf16x8 vfr[2];
#pragma unroll
                for (int ss = 0; ss < 2; ++ss) vfr[ss] = *(const LAS bf16x8*)(lds + P1_VT + (16 * wave + l15) * RS + (32 * ss + 8 * g4) * 2);
                bf16x8 sfr[4];
#pragma unroll
                for (int ks = 0; ks < 4; ++ks) { u32x4_t w; w.x = cvtpk(S[2 * ks][0], S[2 * ks][1]); w.y = cvtpk(S[2 * ks][2], S[2 * ks][3]); w.z = cvtpk(S[2 * ks + 1][0], S[2 * ks + 1][1]); w.w = cvtpk(S[2 * ks + 1][2], S[2 * ks + 1][3]); sfr[ks] = __builtin_bit_cast(bf16x8, w); }
#pragma unroll
                for (int ti = 0; ti < 4; ++ti) {
                    f32x4 o = (f32x4){0.f, 0.f, 0.f, 0.f};
#pragma unroll
                    for (int ks = 0; ks < 4; ++ks) {
                        const u32x2_t a0 = *(const LAS u32x2_t*)(lds + P1_QB + (16 * ti + l15) * RP + (32 * ks + 4 * g4) * 2);
                        const u32x2_t a1 = *(const LAS u32x2_t*)(lds + P1_QB + (16 * ti + l15) * RP + (32 * ks + 16 + 4 * g4) * 2);
                        o = __builtin_amdgcn_mfma_f32_16x16x32_bf16(mk_frag(a0, a1), sfr[ks], o, 0, 0, 0);
                    }
#pragma unroll
                    for (int ss = 0; ss < 2; ++ss) {
                        const bf16x8 a = *(const LAS bf16x8*)(lds + P1_AB + (16 * ti + l15) * RS + (32 * ss + 8 * g4) * 2);
                        o = __builtin_amdgcn_mfma_f32_16x16x32_bf16(a, vfr[ss], o, 0, 0, 0);
                    }
#pragma unroll
                    for (int r = 0; r < 4; ++r) OLOC[(row0 + 16 * ti + 4 * g4 + r) * 1024 + h * 128 + 16 * wave + l15] = o[r];
                }
#pragma unroll
                for (int kt = 0; kt < 8; ++kt) {
                    const f32x4 dv = *(const LAS f32x4*)(lds + P1_DV + (16 * kt + 4 * g4) * 4);
                    S[kt] = S[kt] * dv;
#pragma unroll
                    for (int ss = 0; ss < 2; ++ss) {
                        const bf16x8 a = *(const LAS bf16x8*)(lds + P1_KLT + (16 * kt + l15) * RS + (32 * ss + 8 * g4) * 2);
                        S[kt] = __builtin_amdgcn_mfma_f32_16x16x32_bf16(a, vfr[ss], S[kt], 0, 0, 0);
                    }
                }
            }
            __syncthreads();
        }
#pragma unroll
        for (int kt = 0; kt < 8; ++kt)
#pragma unroll
            for (int r = 0; r < 4; ++r) USEG[((size_t)unit * 128 + 16 * kt + 4 * g4 + r) * 128 + 16 * wave + l15] = S[kt][r];
        if (I == 0) DSEG[unit * 128 + k] = fexp(Bprev);
    }
}

__device__ __forceinline__ void scan_sample(LAS unsigned char* lds, int vcu, int G, const bf16* QQ, const float* LOGF, const bf16* VV, const bf16* GS, const float* og,
                                            const float* S0, float* Sout, bf16* M1) {
    const int tid = threadIdx.x, lane = tid & 63, wave = tid >> 6, v = tid & 127, kq = tid >> 7;
    LAS float* FS = (LAS float*)lds; LAS float* QS = FS + 512; LAS float* VS = QS + 512; LAS float* PART = VS + 512; LAS float* RED = PART + 2048;
    for (int su = vcu; su < 1024; su += G) {
        const int n = su >> 3, h = su & 7;
        float S[32];
        const float* s0 = S0 + (((size_t)(n * 8 + h)) * 128 + kq * 32) * 128 + v;
#pragma unroll
        for (int i = 0; i < 32; ++i) S[i] = s0[(size_t)i * 128];
        { const size_t o = (size_t)(MPROMPT + n * 4 + kq) * 1024 + h * 128 + v; FS[kq * 128 + v] = fexp(LOGF[o]); QS[kq * 128 + v] = bf2f(QQ[o]); VS[kq * 128 + v] = bf2f(VV[o]); }
        __syncthreads();
        float po[4];
#pragma unroll
        for (int t = 0; t < 4; ++t) { const float vv = VS[t * 128 + v]; float p = 0.f;
#pragma unroll
            for (int i = 0; i < 32; ++i) { const int kk = kq * 32 + i; const float f = FS[t * 128 + kk]; S[i] = f * S[i] + (1.0f - f) * vv; p += QS[t * 128 + kk] * S[i]; }
            po[t] = p; }
#pragma unroll
        for (int t = 0; t < 4; ++t) PART[(kq * 4 + t) * 128 + v] = po[t];
        float* so = Sout + (((size_t)(n * 8 + h)) * 128 + kq * 32) * 128 + v;
#pragma unroll
        for (int i = 0; i < 32; ++i) so[(size_t)i * 128] = S[i];
        __syncthreads();
        const int t = kq;
        const float o = (PART[(0 * 4 + t) * 128 + v] + PART[(1 * 4 + t) * 128 + v]) + (PART[(2 * 4 + t) * 128 + v] + PART[(3 * 4 + t) * 128 + v]);
        const float ss = wave_sum(o * o);
        if (lane == 0) RED[wave] = ss;
        __syncthreads();
        const float rs = __builtin_amdgcn_rsqf((RED[2 * t] + RED[2 * t + 1]) * (1.0f / 128.0f) + 1e-6f);
        const size_t ro = (size_t)(MPROMPT + n * 4 + t) * 1024 + h * 128 + v;
        M1[ro] = (bf16)f2bf(o * rs * og[v] * bf2f(GS[ro]));
        __syncthreads();
    }
}

constexpr int P3_SIN = 0;
__device__ __forceinline__ void scan_pass3(LAS unsigned char* lds, int vcu, int G, const bf16* QBS, const float* OLOC, const float* USEG, const float* DSEG, const bf16* GS, const float* og,
                                           bf16* M1, float* hgrn_prompt) {
    const int tid = threadIdx.x, lane = tid & 63, wave = __builtin_amdgcn_readfirstlane(tid >> 6), l15 = lane & 15, g4 = lane >> 4, v = tid & 127, kq = tid >> 7;
    for (int u3 = vcu; u3 < 512; u3 += G) {
        const int half = u3 & 1, g = (u3 >> 1) & 7, h = (u3 >> 4) & 7, b = u3 >> 7, bh = b * 8 + h;
        float S[32];
#pragma unroll
        for (int i = 0; i < 32; ++i) S[i] = 0.f;
        for (int gp = 0; gp < g; ++gp) {
            const float* U = USEG + (((size_t)(bh * 8 + gp)) * 128 + kq * 32) * 128 + v; const float* Dg = DSEG + (bh * 8 + gp) * 128 + kq * 32;
#pragma unroll
            for (int i = 0; i < 32; ++i) S[i] = Dg[i] * S[i] + U[(size_t)i * 128];
        }
        if (g == 7 && half == 0) {
            const float* U = USEG + (((size_t)(bh * 8 + 7)) * 128 + kq * 32) * 128 + v; const float* Dg = DSEG + (bh * 8 + 7) * 128 + kq * 32;
            float* hp = hgrn_prompt + (((size_t)bh) * 128 + kq * 32) * 128 + v;
#pragma unroll
            for (int i = 0; i < 32; ++i) hp[(size_t)i * 128] = Dg[i] * S[i] + U[(size_t)i * 128];
        }
#pragma unroll
        for (int j = 0; j < 4; ++j) { u32x4_t w; w.x = cvtpk(S[8 * j], S[8 * j + 1]); w.y = cvtpk(S[8 * j + 2], S[8 * j + 3]); w.z = cvtpk(S[8 * j + 4], S[8 * j + 5]); w.w = cvtpk(S[8 * j + 6], S[8 * j + 7]);
            *(LAS u32x4_t*)(lds + P3_SIN + v * RP + (kq * 32 + 8 * j) * 2) = w; }
        __syncthreads();
        const size_t rbase = (size_t)b * 4096 + g * 512 + half * 256 + 32 * wave;
        f32x4 acc[2][8];
#pragma unroll
        for (int ti = 0; ti < 2; ++ti)
#pragma unroll
            for (int vt = 0; vt < 8; ++vt) acc[ti][vt] = (f32x4){0.f, 0.f, 0.f, 0.f};
        if (g > 0) {
#pragma unroll
            for (int ks = 0; ks < 4; ++ks) {
                bf16x8 afr[2];
#pragma unroll
                for (int ti = 0; ti < 2; ++ti) afr[ti] = *(const bf16x8*)(QBS + (rbase + 16 * ti + l15) * 1024 + h * 128 + 32 * ks + 8 * g4);
#pragma unroll
                for (int vt = 0; vt < 8; ++vt) { const bf16x8 bfr = *(const LAS bf16x8*)(lds + P3_SIN + (16 * vt + l15) * RP + (32 * ks + 8 * g4) * 2);
#pragma unroll
                    for (int ti = 0; ti < 2; ++ti) acc[ti][vt] = __builtin_amdgcn_mfma_f32_16x16x32_bf16(afr[ti], bfr, acc[ti][vt], 0, 0, 0); }
            }
        }
        float ogv[8];
#pragma unroll
        for (int vt = 0; vt < 8; ++vt) ogv[vt] = og[16 * vt + l15];
#pragma unroll
        for (int ti = 0; ti < 2; ++ti)
#pragma unroll
            for (int r = 0; r < 4; ++r) {
                const size_t ro = (rbase + 16 * ti + 4 * g4 + r) * 1024 + h * 128 + l15;
                float o[8]; float ss = 0.f;
#pragma unroll
                for (int vt = 0; vt < 8; ++vt) { o[vt] = OLOC[ro + 16 * vt] + acc[ti][vt][r]; ss += o[vt] * o[vt]; }
                ss += __shfl_xor(ss, 1); ss += __shfl_xor(ss, 2); ss += __shfl_xor(ss, 4); ss += __shfl_xor(ss, 8);
                const float rs = __builtin_amdgcn_rsqf(ss * (1.0f / 128.0f) + 1e-6f);
#pragma unroll
                for (int vt = 0; vt < 8; ++vt) M1[ro + 16 * vt] = (bf16)f2bf(o[vt] * rs * ogv[vt] * bf2f(GS[ro + 16 * vt]));
            }
        __syncthreads();
    }
}


typedef float f32x16 __attribute__((ext_vector_type(16)));
typedef short v4i16_t __attribute__((ext_vector_type(4)));
constexpr int AT_KV = 0;
constexpr int AT_PITCH = 144, AT_TILE = 64 * AT_PITCH, AT_BUF = 2 * AT_TILE;
constexpr int AT_KM = 2 * AT_BUF;
constexpr int AT_WS = AT_KM + 4096;
constexpr float SM_C = 0.125f * 1.4426950408889634f;
__device__ __forceinline__ int crow(int r, int hi) { return (r & 3) + 8 * (r >> 2) + 4 * hi; }

__device__ __forceinline__ void attn_prompt_unit(LAS unsigned char* lds, int b, int h, int j, const bf16* Qb, const bf16* Kb, const bf16* Vb, const bf16* GAs, const float* KMP,
                                                 const float* qg, const float* kg, bf16* M0) {
    const int tid = threadIdx.x, lane = tid & 63, wave = __builtin_amdgcn_readfirstlane(tid >> 6), l31 = lane & 31, hh = lane >> 5;
    LAS float* KM = (LAS float*)(lds + AT_KM); LAS float* WSF = (LAS float*)(lds + AT_WS) + wave * 32;
    for (int i = tid; i < j * 64; i += 512) { const int n = i >> 6, d = i & 63; const float* p = KMP + ((size_t)(b * 16 + n) * 4) * 512 + h * 64 + d; KM[i] = ((p[0] + p[512]) + (p[1024] + p[1536])) * (1.0f / 256.0f); }
    float gq = fabsf(qg[lane]), gk = fabsf(kg[lane]);
#pragma unroll
    for (int o = 1; o < 64; o <<= 1) { gq = fmaxf(gq, __shfl_xor(gq, o)); gk = fmaxf(gk, __shfl_xor(gk, o)); }
    const float m0c = 8.0f * gq * gk * 1.4426950408889634f;
    const size_t qrow = (size_t)b * 4096 + 256 * j + 32 * wave + l31;
    bf16x8 qf[4];
#pragma unroll
    for (int ds = 0; ds < 4; ++ds) qf[ds] = *(const bf16x8*)(Qb + qrow * 512 + h * 64 + 16 * ds + 8 * hh);
    const int srow = tid >> 3, sch = tid & 7;
    const size_t kvbase = (size_t)b * 4096 * 512 + h * 64 + sch * 8;
    const int sdst = srow * AT_PITCH + sch * 16;
    const int T = 4 * (j + 1);
    u32x4_t kreg, vreg;
    { const size_t r0 = (size_t)(256 * j + srow) * 512; kreg = *(const u32x4_t*)(Kb + kvbase + r0); vreg = *(const u32x4_t*)(Vb + kvbase + r0); }
    __syncthreads();
    unsigned selmask;
    if (j <= 3) selmask = (1u << j) - 1u;
    else {
        float g0 = -INFINITY, g1 = -INFINITY, g2 = -INFINITY; int s0 = 0, s1 = 0, s2 = 0;
        for (int n = 0; n < j; ++n) {
            float part = 0.f;
#pragma unroll
            for (int ds = 0; ds < 4; ++ds)
#pragma unroll
                for (int e = 0; e < 8; ++e) part += bf2f((unsigned short)qf[ds][e]) * KM[n * 64 + 16 * ds + 8 * hh + e];
            const float g = part + __shfl_xor(part, 32);
            if (g > g0) { g2 = g1; s2 = s1; g1 = g0; s1 = s0; g0 = g; s0 = n; }
            else if (g > g1) { g2 = g1; s2 = s1; g1 = g; s1 = n; }
            else if (g > g2) { g2 = g; s2 = n; }
        }
        selmask = (1u << s0) | (1u << s1) | (1u << s2);
    }
    *(LAS u32x4_t*)(lds + AT_KV + sdst) = kreg; *(LAS u32x4_t*)(lds + AT_KV + AT_TILE + sdst) = vreg;
    __syncthreads();
    f32x16 o0, o1;
#pragma unroll
    for (int r = 0; r < 16; ++r) { o0[r] = 0.f; o1[r] = 0.f; }
    float lsum = 0.f;
    const int qp = 32 * wave + l31;
    const int koff = l31 * AT_PITCH + hh * 16;
    const int voff = (4 * hh + ((lane & 15) >> 2)) * AT_PITCH + (16 * ((lane >> 4) & 1) + 4 * (lane & 3)) * 2;
    for (int t = 0; t < T; ++t) {
        const bool more = (t + 1 < T);
        if (more) { const int t1 = t + 1; const int nb = t1 < 4 ? j : (t1 >> 2) - 1; const size_t r0 = (size_t)(256 * nb + 64 * (t1 & 3) + srow) * 512; kreg = *(const u32x4_t*)(Kb + kvbase + r0); vreg = *(const u32x4_t*)(Vb + kvbase + r0); }
        const int buf = (t & 1) * AT_BUF;
        const bool own = t < 4; const int nbk = own ? j : (t >> 2) - 1;
        const bool act = own || ((selmask >> nbk) & 1u);
        f32x16 p0, p1;
#pragma unroll
        for (int r = 0; r < 16; ++r) { p0[r] = 0.f; p1[r] = 0.f; }
#pragma unroll
        for (int ds = 0; ds < 4; ++ds) {
            const bf16x8 ka0 = *(const LAS bf16x8*)(lds + AT_KV + buf + koff + ds * 32);
            const bf16x8 ka1 = *(const LAS bf16x8*)(lds + AT_KV + buf + koff + 32 * AT_PITCH + ds * 32);
            p0 = __builtin_amdgcn_mfma_f32_32x32x16_bf16(ka0, qf[ds], p0, 0, 0, 0);
            p1 = __builtin_amdgcn_mfma_f32_32x32x16_bf16(ka1, qf[ds], p1, 0, 0, 0);
        }
        const int kp0 = 64 * (t & 3);
        float ls = 0.f;
#pragma unroll
        for (int r = 0; r < 16; ++r) {
            const int kp = kp0 + crow(r, hh);
            const bool v0 = own ? (kp <= qp) : act, v1 = own ? (kp + 32 <= qp) : act;
            const float e0 = v0 ? __builtin_amdgcn_exp2f(p0[r] * SM_C - m0c) : 0.f, e1 = v1 ? __builtin_amdgcn_exp2f(p1[r] * SM_C - m0c) : 0.f;
            p0[r] = e0; p1[r] = e1; ls += e0 + e1;
        }
        lsum += ls;
        bf16x8 pa[4];
        { u32x4_t w;
          w.x = cvtpk(p0[0], p0[1]); w.y = cvtpk(p0[2], p0[3]); w.z = cvtpk(p0[4], p0[5]); w.w = cvtpk(p0[6], p0[7]); pa[0] = __builtin_bit_cast(bf16x8, w);
          w.x = cvtpk(p0[8], p0[9]); w.y = cvtpk(p0[10], p0[11]); w.z = cvtpk(p0[12], p0[13]); w.w = cvtpk(p0[14], p0[15]); pa[1] = __builtin_bit_cast(bf16x8, w);
          w.x = cvtpk(p1[0], p1[1]); w.y = cvtpk(p1[2], p1[3]); w.z = cvtpk(p1[4], p1[5]); w.w = cvtpk(p1[6], p1[7]); pa[2] = __builtin_bit_cast(bf16x8, w);
          w.x = cvtpk(p1[8], p1[9]); w.y = cvtpk(p1[10], p1[11]); w.z = cvtpk(p1[12], p1[13]); w.w = cvtpk(p1[14], p1[15]); pa[3] = __builtin_bit_cast(bf16x8, w); }
#pragma unroll
        for (int ks = 0; ks < 4; ++ks) {
            const LAS unsigned char* vb = lds + AT_KV + buf + AT_TILE + voff + 16 * ks * AT_PITCH;
            const v4i16_t a0 = __builtin_amdgcn_ds_read_tr16_b64_v4i16((LAS v4i16_t*)(vb));
            const v4i16_t a1 = __builtin_amdgcn_ds_read_tr16_b64_v4i16((LAS v4i16_t*)(vb + 8 * AT_PITCH));
            const v4i16_t c0 = __builtin_amdgcn_ds_read_tr16_b64_v4i16((LAS v4i16_t*)(vb + 64));
            const v4i16_t c1 = __builtin_amdgcn_ds_read_tr16_b64_v4i16((LAS v4i16_t*)(vb + 8 * AT_PITCH + 64));
            const bf16x8 vf0 = (bf16x8){a0[0], a0[1], a0[2], a0[3], a1[0], a1[1], a1[2], a1[3]};
            const bf16x8 vf1 = (bf16x8){c0[0], c0[1], c0[2], c0[3], c1[0], c1[1], c1[2], c1[3]};
            o0 = __builtin_amdgcn_mfma_f32_32x32x16_bf16(pa[ks], vf0, o0, 0, 0, 0);
            o1 = __builtin_amdgcn_mfma_f32_32x32x16_bf16(pa[ks], vf1, o1, 0, 0, 0);
        }
        if (more) { const int nbuf = ((t + 1) & 1) * AT_BUF; *(LAS u32x4_t*)(lds + AT_KV + nbuf + sdst) = kreg; *(LAS u32x4_t*)(lds + AT_KV + nbuf + AT_TILE + sdst) = vreg; }
        __syncthreads();
    }
    lsum += __shfl_xor(lsum, 32);
    if (hh == 0) WSF[l31] = 1.0f / lsum;
    asm volatile("s_waitcnt lgkmcnt(0)" ::: "memory");
    const size_t orow0 = (size_t)b * 4096 + 256 * j + 32 * wave;
#pragma unroll
    for (int r = 0; r < 16; ++r) {
        const int q = crow(r, hh); const float li = WSF[q]; const size_t ro = orow0 + q;
        const float ga0 = bf2f(GAs[ro * 512 + h * 64 + l31]), ga1 = bf2f(GAs[ro * 512 + h * 64 + 32 + l31]);
        M0[ro * 1024 + h * 64 + l31] = (bf16)f2bf(o0[r] * li * ga0);
        M0[ro * 1024 + h * 64 + 32 + l31] = (bf16)f2bf(o1[r] * li * ga1);
    }
}
__device__ __forceinline__ void attn_prompt_phase(LAS unsigned char* lds, int vcu, int G, const bf16* Qb, const bf16* Kb, const bf16* Vb, const bf16* GAs, const float* KMP, const float* qg, const float* kg, bf16* M0) {
    for (int u = vcu; u < 256; u += G) {
        const int b = u >> 6, h = (u >> 3) & 7, jj = u & 7;
        attn_prompt_unit(lds, b, h, 15 - jj, Qb, Kb, Vb, GAs, KMP, qg, kg, M0);
        attn_prompt_unit(lds, b, h, jj, Qb, Kb, Vb, GAs, KMP, qg, kg, M0);
    }
}


__device__ __forceinline__ void attn_sample_passA(LAS unsigned char* lds, int vcu, int G, const bf16* Qb, const float* cache_k, const int* pt, float* SC, float* KMS) {
    const int tid = threadIdx.x, lane = tid & 63, h = __builtin_amdgcn_readfirstlane(tid >> 6), rowi = lane & 15, kq = lane >> 4;
    for (int unit = vcu; unit < 1024; unit += G) {
        const int n = unit >> 3, blk = unit & 7;
        bf16x8 qfr[2];
#pragma unroll
        for (int s = 0; s < 2; ++s) { u32x4_t w = (u32x4_t){0u, 0u, 0u, 0u}; if (rowi < 4) w = *(const u32x4_t*)(Qb + (size_t)(MPROMPT + n * 4 + rowi) * 512 + h * 64 + 32 * s + 8 * kq); qfr[s] = __builtin_bit_cast(bf16x8, w); }
        const int pg0 = pt[n * 16 + blk * 2], pg1 = pt[n * 16 + blk * 2 + 1];
        f32x4 ks[2][2];
#pragma unroll
        for (int s = 0; s < 2; ++s) { ks[s][0] = (f32x4){0.f, 0.f, 0.f, 0.f}; ks[s][1] = (f32x4){0.f, 0.f, 0.f, 0.f}; }
        float* scb = SC + (((size_t)n * 8 + h) * 4 + rowi) * 2048 + blk * 256 + 4 * kq;
#pragma unroll 4
        for (int rg = 0; rg < 16; ++rg) {
            const int row = 16 * rg + rowi; const int page = rg < 8 ? pg0 : pg1;
            const float* base = cache_k + (((size_t)page * 128 + (row & 127)) * 8 + h) * 64 + 8 * kq;
            const f32x4 a0 = *(const f32x4*)(base), a1 = *(const f32x4*)(base + 4), b0 = *(const f32x4*)(base + 32), b1 = *(const f32x4*)(base + 36);
            ks[0][0] += a0; ks[0][1] += a1; ks[1][0] += b0; ks[1][1] += b1;
            f32x4 acc = (f32x4){0.f, 0.f, 0.f, 0.f};
            acc = __builtin_amdgcn_mfma_f32_16x16x32_bf16(__builtin_bit_cast(bf16x8, pg8::pack8(a0, a1)), qfr[0], acc, 0, 0, 0);
            acc = __builtin_amdgcn_mfma_f32_16x16x32_bf16(__builtin_bit_cast(bf16x8, pg8::pack8(b0, b1)), qfr[1], acc, 0, 0, 0);
            if (rowi < 4) *(f32x4*)(scb + 16 * rg) = acc;
        }
#pragma unroll
        for (int s = 0; s < 2; ++s)
#pragma unroll
            for (int e = 0; e < 2; ++e) {
                f32x4 v = ks[s][e];
#pragma unroll
                for (int o = 1; o < 16; o <<= 1) { v[0] += __shfl_xor(v[0], o); v[1] += __shfl_xor(v[1], o); v[2] += __shfl_xor(v[2], o); v[3] += __shfl_xor(v[3], o); }
                if (rowi == 0) *(f32x4*)(KMS + ((size_t)n * 8 + blk) * 512 + h * 64 + 32 * s + 8 * kq + 4 * e) = v * (1.0f / 256.0f);
            }
    }
}
__device__ __forceinline__ void attn_sample_passB(LAS unsigned char* lds, int vcu, int G, const bf16* Qb, const bf16* Kb, const bf16* Vb, const bf16* GAs, const float* cache_v, const int* pt,
                                                  const float* SC, const float* KMS, const float* qg, const float* kg, bf16* M0) {
    const int tid = threadIdx.x, lane = tid & 63, wave = __builtin_amdgcn_readfirstlane(tid >> 6);
    LAS float* PL = (LAS float*)lds;
    LAS float* OP = (LAS float*)(lds + 32768);
    LAS unsigned* SEL = (LAS unsigned*)(lds + 65536);
    LAS float* POWN = (LAS float*)(lds + 65536 + 64);
    LAS float* REDL = (LAS float*)(lds + 65536 + 128);
    float gq = fabsf(qg[lane]), gk = fabsf(kg[lane]);
#pragma unroll
    for (int o = 1; o < 64; o <<= 1) { gq = fmaxf(gq, __shfl_xor(gq, o)); gk = fmaxf(gk, __shfl_xor(gk, o)); }
    const float m0c = 8.0f * gq * gk * 1.4426950408889634f;
    for (int unit = vcu; unit < 1024; unit += G) {
        const int n = unit >> 3, h = unit & 7;
        if (wave < 4) {
            const int t = wave; const size_t qrow = (size_t)(MPROMPT + n * 4 + t);
            const float q = bf2f(Qb[qrow * 512 + h * 64 + lane]);
            float g0 = -INFINITY, g1 = -INFINITY, g2 = -INFINITY; int s0 = 0, s1 = 0, s2 = 0;
            for (int blk = 0; blk < 8; ++blk) {
                const float g = wave_sum(q * KMS[((size_t)n * 8 + blk) * 512 + h * 64 + lane]);
                if (g > g0) { g2 = g1; s2 = s1; g1 = g0; s1 = s0; g0 = g; s0 = blk; }
                else if (g > g1) { g2 = g1; s2 = s1; g1 = g; s1 = blk; }
                else if (g > g2) { g2 = g; s2 = blk; }
            }
            if (lane == 0) SEL[t] = (1u << s0) | (1u << s1) | (1u << s2);
#pragma unroll
            for (int tp = 0; tp < 4; ++tp) {
                const float s = wave_sum(q * bf2f(Kb[(size_t)(MPROMPT + n * 4 + tp) * 512 + h * 64 + lane]));
                if (lane == 0) POWN[t * 4 + tp] = tp <= t ? __builtin_amdgcn_exp2f(s * SM_C - m0c) : 0.f;
            }
        }
        __syncthreads();
        const unsigned sel0 = SEL[0], sel1 = SEL[1], sel2 = SEL[2], sel3 = SEL[3], anym = sel0 | sel1 | sel2 | sel3;
        {
            float lp[4] = {0.f, 0.f, 0.f, 0.f};
#pragma unroll
            for (int k = 0; k < 16; ++k) {
                const int i = tid + 512 * k, t = k >> 2, idx = i & 2047, blk = idx >> 8;
                const unsigned sm = t == 0 ? sel0 : (t == 1 ? sel1 : (t == 2 ? sel2 : sel3));
                const float p = ((sm >> blk) & 1u) ? __builtin_amdgcn_exp2f(SC[(((size_t)n * 8 + h) * 4 + t) * 2048 + idx] * SM_C - m0c) : 0.f;
                PL[i] = p; lp[t] += p;
            }
#pragma unroll
            for (int t = 0; t < 4; ++t) { const float s = wave_sum(lp[t]); if (lane == 0) REDL[wave * 4 + t] = s; }
        }
        __syncthreads();
        {
            const int d4 = tid & 15, rl = tid >> 4;
            f32x4 acc[4];
#pragma unroll
            for (int t = 0; t < 4; ++t) acc[t] = (f32x4){0.f, 0.f, 0.f, 0.f};
            const float* cvb = cache_v + (size_t)h * 64 + 4 * d4;
            f32x4 cur[8], nxt[8];
            unsigned rem = anym & 0xffu;
            int blk = rem ? __builtin_ctz(rem) : 8;
            if (blk < 8) { const int pg0 = pt[n * 16 + blk * 2], pg1 = pt[n * 16 + blk * 2 + 1];
#pragma unroll
                for (int rr = 0; rr < 8; ++rr) { const int r = rl + 32 * rr; cur[rr] = *(const f32x4*)(cvb + ((size_t)(rr < 4 ? pg0 : pg1) * 128 + (r & 127)) * 512); } }
            while (blk < 8) {
                rem &= rem - 1u;
                const int nb = rem ? __builtin_ctz(rem) : 8;
                if (nb < 8) { const int pg0 = pt[n * 16 + nb * 2], pg1 = pt[n * 16 + nb * 2 + 1];
#pragma unroll
                    for (int rr = 0; rr < 8; ++rr) { const int r = rl + 32 * rr; nxt[rr] = *(const f32x4*)(cvb + ((size_t)(rr < 4 ? pg0 : pg1) * 128 + (r & 127)) * 512); } }
#pragma unroll
                for (int rr = 0; rr < 8; ++rr) { const int r = rl + 32 * rr;
#pragma unroll
                    for (int t = 0; t < 4; ++t) acc[t] += PL[t * 2048 + blk * 256 + r] * cur[rr]; }
#pragma unroll
                for (int rr = 0; rr < 8; ++rr) cur[rr] = nxt[rr];
                blk = nb;
            }
#pragma unroll
            for (int t = 0; t < 4; ++t) *(LAS f32x4*)(lds + 32768 + ((rl * 4 + t) * 64 + 4 * d4) * 4) = acc[t];
        }
        __syncthreads();
        if (tid < 256) {
            const int t = tid >> 6, d = tid & 63; float o = 0.f;
#pragma unroll 8
            for (int rl = 0; rl < 32; ++rl) o += OP[(rl * 4 + t) * 64 + d];
            float l = 0.f;
#pragma unroll
            for (int w = 0; w < 8; ++w) l += REDL[w * 4 + t];
#pragma unroll
            for (int tp = 0; tp < 4; ++tp) { const float p = POWN[t * 4 + tp]; l += p; o += p * bf2f(Vb[(size_t)(MPROMPT + n * 4 + tp) * 512 + h * 64 + d]); }
            const size_t ro = (size_t)(MPROMPT + n * 4 + t);
            M0[ro * 1024 + h * 64 + d] = (bf16)f2bf(o / l * bf2f(GAs[ro * 512 + h * 64 + d]));
        }
        __syncthreads();
    }
}

__global__ void __launch_bounds__(NWAVES * 64, 2) fwd(Args args) {
    extern __shared__ __attribute__((aligned(16))) unsigned char lds_raw[];
    LAS unsigned char* lds = (LAS unsigned char*)lds_raw;
    volatile LAS unsigned* MISC = (volatile LAS unsigned*)(lds + MISC_OFF);
    const int tid = threadIdx.x, lane = tid & 63, wave = __builtin_amdgcn_readfirstlane(tid >> 6);
    const int G = gridDim.x; const int bx = blockIdx.x; const int vcu = (G % 8 == 0) ? (bx % 8) * (G / 8) + bx / 8 : bx;
    unsigned char* ws = args.ws;
    for (int u = tid; u < (LDS_BYTES - LDSCTL_OFF) / 4; u += NWAVES * 64) ((LAS unsigned*)(lds + LDSCTL_OFF))[u] = 0u;
    __syncthreads();
    XcdBarrier bar = xcd_barrier_post((unsigned*)(ws + WS_CTL) + CW_BAR, MISC + 8);
#ifdef FWD_STAMPS
    unsigned long long* stamps_ = (unsigned long long*)(ws + WS_STAMP);
#define STAMP(k) do { if (bx == 0 && tid == 0) stamps_[k] = __builtin_amdgcn_s_memrealtime(); } while (0)
#else
#define STAMP(k) do {} while (0)
#endif
    STAMP(0);

    const float* x_prompt = (const float*)args.in[I_XP]; const float* x_sample = (const float*)args.in[I_XS];
    float* out = args.out;
    bf16* W0T = (bf16*)(ws + WS_W0T); bf16* WO0T = (bf16*)(ws + WS_WO0T); bf16* W1T = (bf16*)(ws + WS_W1T); bf16* WO1T = (bf16*)(ws + WS_WO1T);
    float* RSTD0 = (float*)(ws + WS_RSTD0); float* LB = (float*)(ws + WS_LB); float* KMP = (float*)(ws + WS_KMP); float* SSQ = (float*)(ws + WS_SSQ);
    bf16* XB = (bf16*)(ws + WS_XB); bf16* Qb = (bf16*)(ws + WS_Q); bf16* Kb = (bf16*)(ws + WS_K); bf16* Vb = (bf16*)(ws + WS_V);
    bf16* GA = (bf16*)(ws + WS_GA); bf16* Ub = (bf16*)(ws + WS_U); bf16* GC = (bf16*)(ws + WS_GC);
    bf16* M0 = (bf16*)(ws + WS_M0); float* X1 = (float*)(ws + WS_X1); bf16* XB1 = (bf16*)(ws + WS_XB1); bf16* QQ = (bf16*)(ws + WS_QQ); float* LOGF = (float*)(ws + WS_LOGF);
    bf16* VV = (bf16*)(ws + WS_VV); bf16* GS = (bf16*)(ws + WS_GS); bf16* M1 = (bf16*)(ws + WS_M1);
    float* SCb = (float*)(ws + WS_SC); float* KMS = (float*)(ws + WS_KMS);
    float* OLOC = (float*)(ws + WS_OLOC); bf16* QBS = (bf16*)(ws + WS_QBS); float* USEG = (float*)(ws + WS_USEG); float* DSEG = (float*)(ws + WS_DSEG);

    {
        LAS float* scr = (LAS float*)(lds + wave * 16384);
        const int gw = vcu * NWAVES + wave, NGW = G * NWAVES;
        constexpr int I0 = 16 * (N0 / 32), IO = 16 * 32, I1 = 16 * (N1 / 32);
        constexpr int NITEMS = I0 + IO + I1 + IO;
        for (int it = gw; it < NITEMS; it += NGW) {
            int r = it;
            if (r < I0) { const int kb = r / (N0 / 32), dg = r % (N0 / 32); p0_transpose_item((const float*)args.in[I_WIN0], D, N0, W0T, 64 * kb, 32 * l0_src_group(dg), 32 * dg, (const float*)args.in[I_NORM0], scr, lane); continue; } r -= I0;
            if (r < IO) { const int kb = r / 32, dg = r % 32; p0_transpose_item((const float*)args.in[I_WOUT0], D, D, WO0T, 64 * kb, 32 * dg, 32 * dg, nullptr, scr, lane); continue; } r -= IO;
            if (r < I1) { const int kb = r / (N1 / 32), dg = r % (N1 / 32); p0_transpose_item((const float*)args.in[I_WIN1], D, N1, W1T, 64 * kb, 32 * dg, 32 * dg, (const float*)args.in[I_NORM1], scr, lane); continue; } r -= I1;
            { const int kb = r / 32, dg = r % 32; p0_transpose_item((const float*)args.in[I_WOUT1], D, D, WO1T, 64 * kb, 32 * dg, 32 * dg, nullptr, scr, lane); }
        }
        for (int m = gw; m < MTOT; m += NGW) {
            const float* xrow = m < MPROMPT ? x_prompt + (size_t)m * D : x_sample + (size_t)(m - MPROMPT) * D;
            const GAS f32x4* xr = (const GAS f32x4*)xrow + lane;
            f32x4 v[4]; float s = 0.f;
#pragma unroll
            for (int j = 0; j < 4; ++j) { v[j] = xr[64 * j]; s += (v[j].x * v[j].x + v[j].y * v[j].y) + (v[j].z * v[j].z + v[j].w * v[j].w); }
            s = wave_sum(s);
            if (lane == 0) RSTD0[m] = __builtin_amdgcn_rsqf(s * (1.0f / D) + 1e-6f);
            GAS unsigned long long* o8 = (GAS unsigned long long*)(XB + (size_t)m * D) + lane;
#pragma unroll
            for (int j = 0; j < 4; ++j) o8[64 * j] = (unsigned long long)pk2(v[j].x, v[j].y) | ((unsigned long long)pk2(v[j].z, v[j].w) << 32);
        }
        { const int gt = vcu * (NWAVES * 64) + tid; if (gt < 1024) { const float* l = (const float*)args.in[I_LBL]; LB[gt] = 1.0f / (1.0f + __expf(l[gt] - l[1024 + gt])); } }
        { const f32x4* sc = (const f32x4*)args.in[I_SCONV]; f32x4* cs = (f32x4*)(out + O_CS);
          for (int i = vcu * (NWAVES * 64) + tid; i < NDEC * 26 * 128; i += G * NWAVES * 64) { const int n = i / (26 * 128), rem = i % (26 * 128); cs[(size_t)n * 30 * 128 + rem] = sc[(size_t)n * 30 * 128 + 4 * 128 + rem]; } }
    }
    xcd_barrier(bar); STAMP(1);

    {
        pg8::Gemm g{XB, W0T, MTOT, N0, D}; pg8::StaticOrder S; S.init(MTOT, N0, G, bx);
        pg8::EpiIn0 E{RSTD0, (const float*)args.in[I_QN], (const float*)args.in[I_KN], Qb, Kb, Vb, GA, Ub, GC,
                      out + O_KP, out + O_VP, out + O_KS, out + O_VS, out + O_CP, out + O_CS, KMP};
        pg8::gemm_phase<pg8::EpiIn0, pg8::StaticOrder, true, true>(lds, g, S, E);
    }
    xcd_barrier(bar); STAMP(2);

    conv_phase(lds, vcu, G, Ub, GC, (const float*)args.in[I_SCONV], (const float*)args.in[I_CW], (const float*)args.in[I_CB], (const float*)args.in[I_LNG], (const float*)args.in[I_LNB], M0); STAMP(3);
    attn_sample_passA(lds, vcu, G, Qb, (const float*)args.in[I_CK], (const int*)args.in[I_PT], SCb, KMS);
    xcd_barrier(bar); STAMP(4);

    attn_prompt_phase(lds, vcu, G, Qb, Kb, Vb, GA, KMP, (const float*)args.in[I_QN], (const float*)args.in[I_KN], M0); STAMP(5);
    attn_sample_passB(lds, vcu, G, Qb, Kb, Vb, GA, (const float*)args.in[I_CV], (const int*)args.in[I_PT], SCb, KMS, (const float*)args.in[I_QN], (const float*)args.in[I_KN], M0);
    xcd_barrier(bar); STAMP(6);

    {
        pg8::Gemm g{M0, WO0T, MTOT, D, D}; pg8::StaticOrder S; S.init(MTOT, D, G, bx);
        pg8::EpiOut0 E{x_prompt, x_sample, X1, XB1, SSQ};
        pg8::gemm_phase<pg8::EpiOut0, pg8::StaticOrder, true, true>(lds, g, S, E);
    }
    xcd_barrier(bar); STAMP(7);

    {
        pg8::Gemm g{XB1, W1T, MTOT, N1, D}; pg8::StaticOrder S; S.init(MTOT, N1, G, bx);
        pg8::EpiIn1 E{SSQ, LB, QQ, VV, GS, LOGF};
        pg8::gemm_phase<pg8::EpiIn1, pg8::StaticOrder, true, true>(lds, g, S, E);
    }
    xcd_barrier(bar); STAMP(8);

    scan_pass1(lds, vcu, G, QQ, LOGF, VV, OLOC, QBS, USEG, DSEG); STAMP(9);
    scan_sample(lds, vcu, G, QQ, LOGF, VV, GS, (const float*)args.in[I_ONORM], (const float*)args.in[I_SHGRN], out + O_HS, M1);
    xcd_barrier(bar); STAMP(10);

    scan_pass3(lds, vcu, G, QBS, OLOC, USEG, DSEG, GS, (const float*)args.in[I_ONORM], M1, out + O_HP);
    xcd_barrier(bar); STAMP(11);

    {
        pg8::Gemm g{M1, WO1T, MTOT, D, D}; pg8::StaticOrder S; S.init(MTOT, D, G, bx);
        pg8::EpiOut1 E{X1, out + O_Y};
        pg8::gemm_phase<pg8::EpiOut1, pg8::StaticOrder, true, true>(lds, g, S, E);
    }
    STAMP(12);
}
extern "C" void kernel_launch(void* const* d_in, const int* in_sizes, int n_in, void* d_out, int out_size, void* d_ws, size_t ws_size, hipStream_t stream) {
    static int grid = 0;
    if (grid == 0) {
        if (n_in != N_IN || (size_t)out_size != O_END || ws_size < WS_END) { fprintf(stderr, "kernel_launch: unexpected shapes (n_in %d out %d ws %zu)\n", n_in, out_size, ws_size); grid = -1; return; }
        int dev = 0, cus = 0, per_cu = 0;
        if (hipGetDevice(&dev) != hipSuccess || hipDeviceGetAttribute(&cus, hipDeviceAttributeMultiprocessorCount, dev) != hipSuccess) { grid = -1; return; }
        if (hipFuncSetAttribute((const void*)fwd, hipFuncAttributeMaxDynamicSharedMemorySize, LDS_BYTES) != hipSuccess) { fprintf(stderr, "kernel_launch: hipFuncSetAttribute failed\n"); grid = -1; return; }
        if (hipOccupancyMaxActiveBlocksPerMultiprocessor(&per_cu, (const void*)fwd, NWAVES * 64, LDS_BYTES) != hipSuccess || per_cu < 1) fprintf(stderr, "kernel_launch: occupancy query reports %d\n", per_cu);
        (void)hipGetLastError();
        grid = cus;
    }
    if (grid < 0) return;
    if (hipMemsetAsync((char*)d_ws + WS_CTL, 0, CTL_ZERO_BYTES, stream) != hipSuccess) return;
    Args a{};
    for (int i = 0; i < N_IN; ++i) a.in[i] = d_in[i];
    a.out = (float*)d_out; a.ws = (unsigned char*)d_ws;
    hipLaunchKernelGGL(fwd, dim3(grid), dim3(NWAVES * 64), LDS_BYTES, stream, a);
}
```

```cpp
#include <hip/hip_runtime.h>
#include <cstdio>
#include <cstdint>
namespace pg8 {
#define PG8_LAS __attribute__((address_space(3)))
typedef unsigned short bf16_t;
typedef short bf16x8 __attribute__((ext_vector_type(8)));
typedef float f32x4 __attribute__((ext_vector_type(4)));
typedef unsigned u32x4 __attribute__((ext_vector_type(4)));
constexpr int BM = 256, BK = 64, HALF = 128, HTB = HALF * BK * 2  , STAGE_BYTES = 8 * HTB, NXCD = 8, WGM = 8;

__host__ __device__ __forceinline__ int lds_byte(int r, int c) { const int st = (r >> 4) * 2 + (c >> 5), rr = r & 15, cc = c & 31, ob = rr * 64 + cc * 2; return st * 1024 + (ob ^ (((ob >> 9) & 1) << 5)); }
__host__ __device__ __forceinline__ void stage_rc(int b, int& R, int& C) { const int st = b / 1024, sb = b % 1024, swz = sb ^ (((sb >> 9) & 1) << 5); R = (st >> 1) * 16 + swz / 64; C = (st & 1) * 32 + (swz % 64) / 2; }
__host__ __device__ __forceinline__ int perm32(int rho) { const int n = rho >> 4, i = rho & 15; return 8 * (i >> 2) + 4 * n + (i & 3); }

struct Unit { int pm, pn; };
struct Gemm { const bf16_t* A; const bf16_t* Bt; int M, N, K; };

struct StaticOrder {
    int nM, nN, nwg, G, c;
    __host__ __device__ void init(int M, int N, int G_, int c_) { nM = M / BM; nN = N / BM; nwg = nM * nN; G = G_; c = c_; }
    __host__ __device__ bool next(int i, Unit& u) const {
        const long L = (long)i * G + c; if (L >= nwg) return false;
        int wgid = (int)L; { const int q = nwg / NXCD, r = nwg % NXCD, xcd = wgid % NXCD, off = wgid / NXCD; wgid = (xcd < r ? xcd * (q + 1) : r * (q + 1) + (xcd - r) * q) + off; }
        const int nig = WGM * nN, gid = wgid / nig, fm = gid * WGM, gsz = (nM - fm) < WGM ? (nM - fm) : WGM;
        u.pm = fm + ((wgid % nig) % gsz); u.pn = (wgid % nig) / gsz; return true;
    }
    __device__ __forceinline__ void a_ready(const Unit&) const {}
    __device__ __forceinline__ void done(const Unit&) const {}
};
__device__ __forceinline__ unsigned cvt_pk_bf16(float lo, float hi) { unsigned r; asm volatile("v_cvt_pk_bf16_f32 %0, %1, %2" : "=v"(r) : "v"(lo), "v"(hi)); return r; }
typedef float f32x2 __attribute__((ext_vector_type(2)));
typedef unsigned u32x2 __attribute__((ext_vector_type(2)));
__device__ __forceinline__ float fsigmoid(float x) { return __builtin_amdgcn_rcpf(1.0f + __builtin_amdgcn_exp2f(-1.4426950408889634f * x)); }
__device__ __forceinline__ float fsilu(float x) { return x * fsigmoid(x); }
__device__ __forceinline__ f32x4 silu4(f32x4 v) { return (f32x4){fsilu(v[0]), fsilu(v[1]), fsilu(v[2]), fsilu(v[3])}; }
__device__ __forceinline__ f32x4 sigm4(f32x4 v) { return (f32x4){fsigmoid(v[0]), fsigmoid(v[1]), fsigmoid(v[2]), fsigmoid(v[3])}; }
__device__ __forceinline__ u32x4 pack8(f32x4 a, f32x4 b) { u32x4 w; w.x = cvt_pk_bf16(a[0], a[1]); w.y = cvt_pk_bf16(a[2], a[3]); w.z = cvt_pk_bf16(b[0], b[1]); w.w = cvt_pk_bf16(b[2], b[3]); return w; }
__device__ __forceinline__ float dot4(f32x4 a) { return (a[0] * a[0] + a[1] * a[1]) + (a[2] * a[2] + a[3] * a[3]); }

constexpr int MP = 16384;
constexpr float RMS_EPS = 1e-6f;

struct EpiIn0 {
    static constexpr bool PERM = true, AFTER_DRAIN = false;
    const float* rstd; const float* qg; const float* kg;
    bf16_t *Q, *Kb, *Vb, *GA, *U, *GC;
    float *k_prompt, *v_prompt, *k_sample, *v_sample, *conv_prompt, *conv_sample;
    float* kmp;
    __device__ __forceinline__ void operator()(const f32x4 (&acc)[2][2][4][2], const Unit& u, int wr, int wc, int fr, int fq) const {
        const int pn = u.pn;
        const int rowb = u.pm * BM + wr * 64 + fr;
        const bool sample = u.pm >= 64;
        if (pn < 4) {
            const bool isk = pn >= 2;
            const float* g = isk ? kg : qg;
            f32x4 gv[2][2];
#pragma unroll
            for (int bj = 0; bj < 2; ++bj)
#pragma unroll
                for (int n = 0; n < 2; ++n) gv[bj][n] = *(const f32x4*)(g + 32 * bj + 8 * fq + 4 * n);
            const int colb = 256 * (pn & 1) + 64 * wc + 8 * fq;
            bf16_t* ob = isk ? Kb : Q;
            float* of = sample ? (k_sample - (size_t)MP * 512) : k_prompt;
#pragma unroll
            for (int ai = 0; ai < 2; ++ai) {
                f32x4 ks[2][2];
#pragma unroll
                for (int bj = 0; bj < 2; ++bj)
#pragma unroll
                    for (int n = 0; n < 2; ++n) ks[bj][n] = (f32x4){0.f, 0.f, 0.f, 0.f};
#pragma unroll
                for (int m = 0; m < 4; ++m) {
                    const int r = rowb + ai * HALF + m * 16;
                    const float rs = rstd[r];
                    f32x4 v[2][2]; float ss = 0.f;
#pragma unroll
                    for (int bj = 0; bj < 2; ++bj)
#pragma unroll
                        for (int n = 0; n < 2; ++n) { v[bj][n] = acc[ai][bj][m][n] * rs; ss += dot4(v[bj][n]); }
                    ss += __shfl_xor(ss, 16); ss += __shfl_xor(ss, 32);
                    const float inv = __builtin_amdgcn_rsqf(ss * (1.0f / 64.0f) + RMS_EPS);
#pragma unroll
                    for (int bj = 0; bj < 2; ++bj) {
                        const f32x4 o0 = v[bj][0] * inv * gv[bj][0], o1 = v[bj][1] * inv * gv[bj][1];
                        const size_t off = (size_t)r * 512 + colb + 32 * bj;
                        *(u32x4*)(ob + off) = pack8(o0, o1);
                        if (isk) { *(f32x4*)(of + off) = o0; *(f32x4*)(of + off + 4) = o1; ks[bj][0] += o0; ks[bj][1] += o1; }
                    }
                }
                if (isk && !sample) {
#pragma unroll
                    for (int bj = 0; bj < 2; ++bj)
#pragma unroll
                        for (int n = 0; n < 2; ++n) {
                            f32x4 s = ks[bj][n];
#pragma unroll
                            for (int o = 1; o < 16; o <<= 1) { s[0] += __shfl_xor(s[0], o); s[1] += __shfl_xor(s[1], o); s[2] += __shfl_xor(s[2], o); s[3] += __shfl_xor(s[3], o); }
                            if (fr == 0) *(f32x4*)(kmp + ((size_t)(u.pm * 4 + ai * 2 + wr)) * 512 + colb + 32 * bj + 4 * n) = s;
                        }
                }
            }
        } else if (pn < 6) {
            const int colb = 256 * (pn & 1) + 64 * wc + 8 * fq;
            float* of = sample ? (v_sample - (size_t)MP * 512) : v_prompt;
#pragma unroll
            for (int ai = 0; ai < 2; ++ai)
#pragma unroll
                for (int m = 0; m < 4; ++m) {
                    const int r = rowb + ai * HALF + m * 16;
                    const float rs = rstd[r];
#pragma unroll
                    for (int bj = 0; bj < 2; ++bj) {
                        const f32x4 o0 = acc[ai][bj][m][0] * rs, o1 = acc[ai][bj][m][1] * rs;
                        const size_t off = (size_t)r * 512 + colb + 32 * bj;
                        *(u32x4*)(Vb + off) = pack8(o0, o1);
                        *(f32x4*)(of + off) = o0; *(f32x4*)(of + off + 4) = o1;
                    }
                }
        } else if (pn < 8 || pn >= 12) {
            const int colb = 256 * (pn & 1) + 64 * wc + 8 * fq;
            bf16_t* ob = pn < 8 ? GA : GC;
#pragma unroll
            for (int ai = 0; ai < 2; ++ai)
#pragma unroll
                for (int m = 0; m < 4; ++m) {
                    const int r = rowb + ai * HALF + m * 16;
                    const float rs = rstd[r];
#pragma unroll
                    for (int bj = 0; bj < 2; ++bj) {
                        const f32x4 o0 = silu4(acc[ai][bj][m][0] * rs), o1 = silu4(acc[ai][bj][m][1] * rs);
                        *(u32x4*)(ob + (size_t)r * 512 + colb + 32 * bj) = pack8(o0, o1);
                    }
                }
        } else {
            const int ch0 = 128 * (pn - 8) + 32 * wc + 8 * fq;
            const bool tailp = !sample && ((u.pm & 15) == 15);
#pragma unroll
            for (int ai = 0; ai < 2; ++ai)
#pragma unroll
                for (int m = 0; m < 4; ++m) {
                    const int r = rowb + ai * HALF + m * 16;
                    const float rs = rstd[r];
                    const f32x4 o0 = (acc[ai][0][m][0] * rs) * sigm4(acc[ai][1][m][0] * rs), o1 = (acc[ai][0][m][1] * rs) * sigm4(acc[ai][1][m][1] * rs);
                    *(u32x4*)(U + (size_t)r * 512 + ch0) = pack8(o0, o1);
                    if (tailp) { const int tok = r & 4095; if (tok >= 4066) { float* d = conv_prompt + ((size_t)((r >> 12) * 30 + (tok - 4066))) * 512 + ch0; *(f32x4*)d = o0; *(f32x4*)(d + 4) = o1; } }
                    if (sample) { const int rr = r - MP; float* d = conv_sample + ((size_t)((rr >> 2) * 30 + 26 + (rr & 3))) * 512 + ch0; *(f32x4*)d = o0; *(f32x4*)(d + 4) = o1; }
                }
        }
    }
};

struct EpiOut0 {
    static constexpr bool PERM = false, AFTER_DRAIN = false;
    const float* xp; const float* xs; float* X1; bf16_t* XB1; float* SSQ;
    __device__ __forceinline__ void operator()(const f32x4 (&acc)[2][2][4][2], const Unit& u, int wr, int wc, int fr, int fq) const {
        const int rowb = u.pm * BM + wr * 64 + fr, col0 = u.pn * BM + wc * 32 + 4 * fq;
        const float* xb = u.pm >= 64 ? xs - (size_t)MP * 1024 : xp;
#pragma unroll
        for (int ai = 0; ai < 2; ++ai)
#pragma unroll
            for (int m = 0; m < 4; ++m) {
                const int r = rowb + ai * HALF + m * 16; const size_t ro = (size_t)r * 1024 + col0; float ss = 0.f;
#pragma unroll
                for (int bj = 0; bj < 2; ++bj)
#pragma unroll
                    for (int n = 0; n < 2; ++n) {
                        const size_t o_ = ro + bj * HALF + n * 16;
                        const f32x4 o = *(const f32x4*)(xb + o_) + acc[ai][bj][m][n];
                        *(f32x4*)(X1 + o_) = o; u32x2 w; w.x = cvt_pk_bf16(o[0], o[1]); w.y = cvt_pk_bf16(o[2], o[3]); *(u32x2*)(XB1 + o_) = w; ss += dot4(o);
                    }
                ss += __shfl_xor(ss, 16); ss += __shfl_xor(ss, 32);
                if (fq == 0) SSQ[(size_t)r * 16 + u.pn * 4 + wc] = ss;
            }
    }
};
struct EpiIn1 {
    static constexpr bool PERM = true, AFTER_DRAIN = false;
    const float* SSQ; const float* LB; bf16_t *QQ, *VV, *GS; float* LOGF;
    __device__ __forceinline__ void operator()(const f32x4 (&acc)[2][2][4][2], const Unit& u, int wr, int wc, int fr, int fq) const {
        const int rowb = u.pm * BM + wr * 64 + fr, type = u.pn >> 2, cl0 = (u.pn & 3) * BM + wc * 32 + 8 * fq;
#pragma unroll
        for (int ai = 0; ai < 2; ++ai)
#pragma unroll
            for (int m = 0; m < 4; ++m) {
                const int r = rowb + ai * HALF + m * 16;
                const f32x4* sp = (const f32x4*)(SSQ + (size_t)r * 16);
                const f32x4 s0 = sp[0], s1 = sp[1], s2 = sp[2], s3 = sp[3];
                const float tot = (((s0[0] + s0[1]) + (s0[2] + s0[3])) + ((s1[0] + s1[1]) + (s1[2] + s1[3]))) + (((s2[0] + s2[1]) + (s2[2] + s2[3])) + ((s3[0] + s3[1]) + (s3[2] + s3[3])));
                const float rs = __builtin_amdgcn_rsqf(tot * (1.0f / 1024.0f) + RMS_EPS);
#pragma unroll
                for (int bj = 0; bj < 2; ++bj) {
                    const f32x4 v0 = acc[ai][bj][m][0] * rs, v1 = acc[ai][bj][m][1] * rs;
                    const int c = cl0 + bj * HALF; const size_t off = (size_t)r * 1024 + c;
                    if (type == 0) *(u32x4*)(QQ + off) = pack8(silu4(v0), silu4(v1));
                    else if (type == 1) {
                        const f32x4 l0 = *(const f32x4*)(LB + c), l1 = *(const f32x4*)(LB + c + 4);
                        const f32x4 f0 = l0 + (1.0f - l0) * sigm4(v0), f1 = l1 + (1.0f - l1) * sigm4(v1);
                        *(f32x4*)(LOGF + off) = (f32x4){__logf(f0[0]), __logf(f0[1]), __logf(f0[2]), __logf(f0[3])};
                        *(f32x4*)(LOGF + off + 4) = (f32x4){__logf(f1[0]), __logf(f1[1]), __logf(f1[2]), __logf(f1[3])};
                    }
                    else if (type == 2) *(u32x4*)(VV + off) = pack8(v0, v1);
                    else *(u32x4*)(GS + off) = pack8(silu4(v0), silu4(v1));
                }
            }
    }
};
struct EpiOut1 {
    static constexpr bool PERM = false, AFTER_DRAIN = false;
    const float* X1; float* Y;
    __device__ __forceinline__ void operator()(const f32x4 (&acc)[2][2][4][2], const Unit& u, int wr, int wc, int fr, int fq) const {
        const int rowb = u.pm * BM + wr * 64 + fr, col0 = u.pn * BM + wc * 32 + 4 * fq;
#pragma unroll
        for (int ai = 0; ai < 2; ++ai)
#pragma unroll
            for (int m = 0; m < 4; ++m) {
                const size_t ro = (size_t)(rowb + ai * HALF + m * 16) * 1024 + col0;
#pragma unroll
                for (int bj = 0; bj < 2; ++bj)
#pragma unroll
                    for (int n = 0; n < 2; ++n) { const size_t o_ = ro + bj * HALF + n * 16; *(f32x4*)(Y + o_) = *(const f32x4*)(X1 + o_) + acc[ai][bj][m][n]; }
            }
    }
};
template <class Epi, class Sched, bool ALIGN_EPI = false, bool SP2 = false>
__device__ __forceinline__ void gemm_phase(PG8_LAS unsigned char* lds, const Gemm g, const Sched& S, const Epi& E) {
    const int tid = threadIdx.x, wid = __builtin_amdgcn_readfirstlane(tid >> 6), lane = tid & 63, wr = wid >> 2, wc = wid & 3, fr = lane & 15, fq = lane >> 4;
    const int K = g.K, nt = K / BK;
    unsigned voffA[2], voffB[2];
#pragma unroll
    for (int i = 0; i < 2; ++i) { int R, C; stage_rc(tid * 16 + i * 8192, R, C); const int Rb = Epi::PERM ? ((R & ~31) + perm32(R & 31)) : R;
        voffA[i] = (unsigned)(R * K + C) * 2u; voffB[i] = (unsigned)(Rb * K + C) * 2u; }
    const size_t kstep = (size_t)(BK * 2);
    const size_t hstep = (size_t)HALF * K * 2;
    const size_t tstep = 2 * hstep;
    const unsigned ldsw = (unsigned)wid * 1024u;
    const int aoff = lds_byte(wr * 64 + fr, fq * 8), boff = lds_byte(wc * 32 + fr, fq * 8);
#define PG8_SA(b, h) (((b) * 2 + (h)) * HTB)
#define PG8_SB(b, h) ((4 + (b) * 2 + (h)) * HTB)
#define PG8_STAGE(bufoff, gbase, voff) do { _Pragma("unroll") for (int _i = 0; _i < 2; ++_i) \
        __builtin_amdgcn_global_load_lds((const unsigned*)((const char*)(gbase) + (voff)[_i]), (PG8_LAS unsigned*)(lds + (bufoff) + ldsw + _i * 8192), 16, 0, 0); } while (0)
#define PG8_LDA(dst, b, h) do { _Pragma("unroll") for (int m = 0; m < 4; ++m) _Pragma("unroll") for (int k = 0; k < 2; ++k) dst[m][k] = *(const PG8_LAS bf16x8*)(lds + PG8_SA(b, h) + aoff + m * 2048 + k * 1024); } while (0)
#define PG8_LDB(dst, b, h) do { _Pragma("unroll") for (int n = 0; n < 2; ++n) _Pragma("unroll") for (int k = 0; k < 2; ++k) dst[n][k] = *(const PG8_LAS bf16x8*)(lds + PG8_SB(b, h) + boff + n * 2048 + k * 1024); } while (0)
#define PG8_MMA(ai, bj, At, Bt) do { __builtin_amdgcn_s_setprio(1); _Pragma("unroll") for (int m = 0; m < 4; ++m) _Pragma("unroll") for (int n = 0; n < 2; ++n) _Pragma("unroll") for (int k = 0; k < 2; ++k) \
        acc[ai][bj][m][n] = __builtin_amdgcn_mfma_f32_16x16x32_bf16(Bt[n][k], At[m][k], acc[ai][bj][m][n], 0, 0, 0); __builtin_amdgcn_s_setprio(0); } while (0)
#define PG8_WAIT_V(n) asm volatile("s_waitcnt vmcnt(" #n ")" ::: "memory")
#define PG8_WAIT_L(n) asm volatile("s_waitcnt lgkmcnt(" #n ")" ::: "memory")
#define PG8_BAR __builtin_amdgcn_s_barrier()
#define PG8_SCHED __builtin_amdgcn_sched_barrier(0)
    Unit cur, nxt; int ui = 0;
    if (!S.next(0, cur)) return;
    f32x4 acc[2][2][4][2];
#pragma unroll
    for (int a = 0; a < 2; ++a)
#pragma unroll
        for (int b = 0; b < 2; ++b)
#pragma unroll
            for (int m = 0; m < 4; ++m)
#pragma unroll
                for (int n = 0; n < 2; ++n) acc[a][b][m][n] = (f32x4){0.f, 0.f, 0.f, 0.f};
    bf16x8 At[4][2], B0[2][2], B1[2][2];
    const char* cA = (const char*)g.A + (size_t)cur.pm * tstep; const char* cB = (const char*)g.Bt + (size_t)cur.pn * tstep;
    S.a_ready(cur);
    if constexpr (SP2) {
        PG8_STAGE(PG8_SB(0, 0), cB, voffB); PG8_STAGE(PG8_SB(0, 1), cB + hstep, voffB); PG8_STAGE(PG8_SA(0, 0), cA, voffA); PG8_STAGE(PG8_SA(0, 1), cA + hstep, voffA);
        if (wr == 1) PG8_BAR;
        PG8_WAIT_V(2); PG8_BAR;
        PG8_STAGE(PG8_SB(1, 0), cB + kstep, voffB); PG8_STAGE(PG8_SA(1, 0), cA + kstep, voffA); PG8_STAGE(PG8_SB(1, 1), cB + hstep + kstep, voffB);
        PG8_WAIT_V(6); PG8_BAR;
    } else {
        PG8_STAGE(PG8_SB(0, 0), cB, voffB); PG8_STAGE(PG8_SA(0, 0), cA, voffA); PG8_STAGE(PG8_SB(0, 1), cB + hstep, voffB); PG8_STAGE(PG8_SA(0, 1), cA + hstep, voffA);
        if (wr == 1) PG8_BAR;
        PG8_WAIT_V(4); PG8_BAR;
        PG8_STAGE(PG8_SB(1, 0), cB + kstep, voffB); PG8_STAGE(PG8_SA(1, 0), cA + kstep, voffA); PG8_STAGE(PG8_SB(1, 1), cB + hstep + kstep, voffB);
        PG8_WAIT_V(6); PG8_BAR;
    }
    for (;;) {
        const bool has_next = S.next(ui + 1, nxt);
        const char* nA = has_next ? (const char*)g.A + (size_t)nxt.pm * tstep : cA; const char* nB = has_next ? (const char*)g.Bt + (size_t)nxt.pn * tstep : cB;
        for (int t = 0; t < nt; t += 2) {
            const bool last = (t == nt - 2);
            const char* a1 = cA + (size_t)(t + 1) * kstep;
            const char* a2 = last ? nA : cA + (size_t)(t + 2) * kstep; const char* b2 = last ? nB : cB + (size_t)(t + 2) * kstep;
            const char* a3 = a2 + kstep; const char* b3 = b2 + kstep;
            if (last && has_next) S.a_ready(nxt);
            if constexpr (SP2) {
            PG8_LDB(B0, 0, 0); PG8_LDB(B1, 0, 1); PG8_SCHED; PG8_LDA(At, 0, 0); PG8_STAGE(PG8_SA(1, 1), a1 + hstep, voffA);
            PG8_WAIT_V(8); PG8_WAIT_L(0); PG8_BAR; PG8_MMA(0, 0, At, B0); PG8_MMA(0, 1, At, B1); PG8_BAR; PG8_SCHED;
            PG8_LDA(At, 0, 1); PG8_STAGE(PG8_SB(0, 0), b2, voffB); PG8_STAGE(PG8_SB(0, 1), b2 + hstep, voffB); PG8_STAGE(PG8_SA(0, 0), a2, voffA);
            PG8_WAIT_V(8); PG8_WAIT_L(0); PG8_BAR; PG8_MMA(1, 0, At, B0); PG8_MMA(1, 1, At, B1); PG8_BAR; PG8_SCHED;
            PG8_LDB(B0, 1, 0); PG8_LDB(B1, 1, 1); PG8_SCHED; PG8_LDA(At, 1, 0); PG8_STAGE(PG8_SA(0, 1), a2 + hstep, voffA);
            PG8_WAIT_V(8); PG8_WAIT_L(0); PG8_BAR; PG8_MMA(0, 0, At, B0); PG8_MMA(0, 1, At, B1); PG8_BAR; PG8_SCHED;
            PG8_LDA(At, 1, 1); PG8_STAGE(PG8_SB(1, 0), b3, voffB); PG8_STAGE(PG8_SB(1, 1), b3 + hstep, voffB); PG8_STAGE(PG8_SA(1, 0), a3, voffA);
            PG8_WAIT_V(8); PG8_WAIT_L(0); PG8_BAR; PG8_MMA(1, 0, At, B0); PG8_MMA(1, 1, At, B1); PG8_BAR; PG8_SCHED;
            } else {
            PG8_LDB(B0, 0, 0); PG8_SCHED; PG8_LDA(At, 0, 0); PG8_STAGE(PG8_SA(1, 1), a1 + hstep, voffA);
            PG8_WAIT_L(8); PG8_BAR; PG8_WAIT_L(0); PG8_MMA(0, 0, At, B0); PG8_BAR; PG8_SCHED;
            PG8_LDB(B1, 0, 1); PG8_STAGE(PG8_SB(0, 0), b2, voffB);
            PG8_BAR; PG8_WAIT_L(0); PG8_MMA(0, 1, At, B1); PG8_BAR;
            PG8_LDA(At, 0, 1); PG8_STAGE(PG8_SA(0, 0), a2, voffA);
            PG8_BAR; PG8_WAIT_L(0); PG8_MMA(1, 0, At, B0); PG8_BAR; PG8_SCHED;
            PG8_STAGE(PG8_SB(0, 1), b2 + hstep, voffB);
            PG8_WAIT_V(6); PG8_BAR; PG8_MMA(1, 1, At, B1); PG8_BAR;
            PG8_LDB(B0, 1, 0); PG8_SCHED; PG8_LDA(At, 1, 0); PG8_STAGE(PG8_SA(0, 1), a2 + hstep, voffA);
            PG8_WAIT_L(8); PG8_BAR; PG8_WAIT_L(0); PG8_MMA(0, 0, At, B0); PG8_BAR; PG8_SCHED;
            PG8_LDB(B1, 1, 1); PG8_STAGE(PG8_SB(1, 0), b3, voffB);
            PG8_BAR; PG8_WAIT_L(0); PG8_MMA(0, 1, At, B1); PG8_BAR;
            PG8_LDA(At, 1, 1); PG8_STAGE(PG8_SA(1, 0), a3, voffA);
            PG8_BAR; PG8_WAIT_L(0); PG8_MMA(1, 0, At, B0); PG8_BAR; PG8_SCHED;
            PG8_STAGE(PG8_SB(1, 1), b3 + hstep, voffB);
            PG8_WAIT_V(6); PG8_BAR; PG8_MMA(1, 1, At, B1); PG8_BAR;
            }
        }
        if constexpr (ALIGN_EPI) { if (wr == 0) PG8_BAR; }
        if constexpr (!Epi::AFTER_DRAIN) { E(acc, cur, wr, wc, fr, fq); S.done(cur); }
        if (!has_next) break;
#pragma unroll
        for (int a = 0; a < 2; ++a)
#pragma unroll
            for (int b = 0; b < 2; ++b)
#pragma unroll
                for (int m = 0; m < 4; ++m)
#pragma unroll
                    for (int n = 0; n < 2; ++n) acc[a][b][m][n] = (f32x4){0.f, 0.f, 0.f, 0.f};
        cur = nxt; cA = nA; cB = nB; ++ui;
        if constexpr (ALIGN_EPI) { if (wr == 1) PG8_BAR; }
    }
    PG8_WAIT_V(0);
    if constexpr (!ALIGN_EPI) { if (wr == 0) PG8_BAR; }
    PG8_BAR;
    if constexpr (Epi::AFTER_DRAIN) { E.fused(acc, cur, wr, wc, fr, fq, lds, wid, lane); S.done(cur); }
#undef PG8_SA
#undef PG8_SB
#undef PG8_STAGE
#undef PG8_LDA
#undef PG8_LDB
#undef PG8_MMA
#undef PG8_WAIT_V
#undef PG8_WAIT_L
#undef PG8_BAR
#undef PG8_SCHED
}
}

constexpr int NWAVES = 8;
constexpr int D = 1024, MPROMPT = 16384, MSAMPLE = 512, MTOT = MPROMPT + MSAMPLE;
constexpr int SEQ = 4096, NB = 4, NDEC = 128, TDEC = 4;
constexpr int N0 = 3584, N1 = 4096;
constexpr size_t MiB = 1u << 20;
constexpr size_t WS_CTL = 0, CTL_ZERO_BYTES = 1 * MiB;
constexpr size_t WS_W0T = 2 * MiB, WS_WO0T = 10 * MiB, WS_W1T = 12 * MiB, WS_WO1T = 20 * MiB;
constexpr size_t WS_RSTD0 = 22 * MiB, WS_LB = 23 * MiB, WS_KMP = 24 * MiB, WS_SSQ = 26 * MiB;
constexpr size_t WS_XB = 64 * MiB, WS_Q = 128 * MiB, WS_K = 160 * MiB, WS_V = 192 * MiB, WS_GA = 224 * MiB, WS_U = 256 * MiB, WS_GC = 288 * MiB;
constexpr size_t WS_M0 = 320 * MiB, WS_X1 = 384 * MiB, WS_XB1 = 464 * MiB, WS_QQ = 512 * MiB, WS_LOGF = 576 * MiB, WS_VV = 656 * MiB, WS_GS = 704 * MiB;
constexpr size_t WS_M1 = 752 * MiB, WS_OLOC = 800 * MiB, WS_QBS = 880 * MiB, WS_USEG = 928 * MiB, WS_DSEG = 952 * MiB, WS_SC = 960 * MiB, WS_KMS = 1000 * MiB, WS_END = 1024 * MiB;
constexpr size_t WS_STAMP = 1010 * MiB;
constexpr int CW_BAR = 4096;
constexpr int RING_BYTES = 131072, LDSCTL_OFF = RING_BYTES, MISC_OFF = LDSCTL_OFF + 320, LDS_BYTES = 147456;

#define GAS __attribute__((address_space(1)))
#define LAS __attribute__((address_space(3)))
typedef unsigned short bf16;
typedef unsigned v4u __attribute__((ext_vector_type(4)));
typedef float f32x4 __attribute__((ext_vector_type(4)));
typedef short bf16x8 __attribute__((ext_vector_type(8)));
#define LDS_WAIT() asm volatile("s_waitcnt lgkmcnt(0)" ::: "memory")
#define VM_WAIT() asm volatile("s_waitcnt vmcnt(0)" ::: "memory")
__device__ __forceinline__ unsigned f2bf(float f) { unsigned u = __builtin_bit_cast(unsigned, f); return (u + 0x7fffu + ((u >> 16) & 1u)) >> 16; }
__device__ __forceinline__ unsigned pk2(float lo, float hi) { return f2bf(lo) | (f2bf(hi) << 16); }
__device__ __forceinline__ float bf2f(unsigned short b) { return __builtin_bit_cast(float, ((unsigned)b) << 16); }
__device__ __forceinline__ float wave_sum(float v) {
#pragma unroll
    for (int o = 1; o < 64; o <<= 1) v += __shfl_xor(v, o);
    return v;
}
#define XB_TMO      128
#define XB_XCNT(j)  (256  + 64 * (j))
#define XB_XSUB(j)  (1280 + 64 * (j))
#define XB_XGEN(j)  (2304 + 64 * (j))
#define XB_TOP      3328
#define XB_TOPGEN   3392
#define XCD_BAR_WORDS 3456
#define XB_SPIN_CAP (1u << 18)
#define LAS __attribute__((address_space(3)))

__device__ __forceinline__ unsigned xb_ld(unsigned* p)              { return __hip_atomic_load(p, __ATOMIC_RELAXED, __HIP_MEMORY_SCOPE_AGENT); }
__device__ __forceinline__ unsigned xb_add(unsigned* p, unsigned v) { return __hip_atomic_fetch_add(p, v, __ATOMIC_RELAXED, __HIP_MEMORY_SCOPE_AGENT); }
__device__ __forceinline__ unsigned xb_xcc_id() { return (unsigned)__builtin_amdgcn_s_getreg((3 << 11) | 20) & 0xFu; }
#define XB_SPIN(cond, bar) do { unsigned _sp = 0; while (cond) { __builtin_amdgcn_s_sleep(1); \
    if ((++_sp & 255u) == 0u) { if (xb_ld(&(bar)[XB_TMO])) break; if (_sp > XB_SPIN_CAP) { atomicAdd(&(bar)[XB_TMO], 1u); break; } } } } while (0)

struct XcdBarrier {
    unsigned* bar; unsigned x;
    volatile LAS unsigned* st;
};

__device__ __forceinline__ XcdBarrier xcd_barrier_post(unsigned* bar, volatile LAS unsigned* st) {
    XcdBarrier b; b.bar = bar; b.x = xb_xcc_id(); b.st = st;
    if (threadIdx.x == 0) (void)xb_add(&bar[XB_XCNT(b.x)], 1u);
    return b;
}
__device__ __forceinline__ void xcd_barrier_complete(unsigned* bar, unsigned x, unsigned& nloc, unsigned& nx) {
    const unsigned G = gridDim.x * gridDim.y * gridDim.z;
    unsigned sum, cnt, mine, sp = 0u;
    for (;;) {
        sum = 0u; cnt = 0u; mine = 0u;
#pragma unroll
        for (unsigned j = 0; j < 16; ++j) { const unsigned c = xb_ld(&bar[XB_XCNT(j)]); sum += c; cnt += (c > 0u) ? 1u : 0u; mine = (j == x) ? c : mine; }
        if (sum == G) break;
        __builtin_amdgcn_s_sleep(1);
        if ((++sp & 255u) == 0u) { if (xb_ld(&bar[XB_TMO])) break; if (sp > XB_SPIN_CAP) { atomicAdd(&bar[XB_TMO], 1u); break; } }
    }
    nloc = mine > 0u ? mine : 1u; nx = cnt > 0u ? cnt : 1u;
}

__device__ __forceinline__ void xcd_barrier(const XcdBarrier& b) {
    asm volatile("s_waitcnt vmcnt(0)" ::: "memory");
    __syncthreads();
    if (threadIdx.x == 0) {
        unsigned* bar = b.bar;
        __builtin_amdgcn_s_waitcnt(0);
        unsigned nloc = b.st[0], nx = b.st[1];
        if (nloc == 0u) { xcd_barrier_complete(bar, b.x, nloc, nx); b.st[0] = nloc; b.st[1] = nx; }
        const unsigned old = xb_add(&bar[XB_XSUB(b.x)], 1u);
        const unsigned gen = old / nloc;
        if (old + 1u == (gen + 1u) * nloc) {
            __builtin_amdgcn_fence(__ATOMIC_RELEASE, "agent");
            asm volatile("s_waitcnt vmcnt(0)" ::: "memory");
            const unsigned og = xb_add(&bar[XB_TOP], 1u);
            const unsigned tg = og / nx;
            if (og + 1u == (tg + 1u) * nx) xb_add(&bar[XB_TOPGEN], 1u);
            else XB_SPIN(xb_ld(&bar[XB_TOPGEN]) == tg, bar);
            __builtin_amdgcn_fence(__ATOMIC_ACQUIRE, "agent");
            xb_add(&bar[XB_XGEN(b.x)], 1u);
            asm volatile("s_waitcnt vmcnt(0)" ::: "memory");
        } else {
            XB_SPIN(xb_ld(&bar[XB_XGEN(b.x)]) == gen, bar);
            __builtin_amdgcn_fence(__ATOMIC_ACQUIRE, "agent");
            asm volatile("s_waitcnt vmcnt(0)" ::: "memory");
        }
    }
    __syncthreads();
}

constexpr size_t O_Y = 0, O_KP = 17301504, O_VP = O_KP + 8388608, O_KS = O_VP + 8388608, O_VS = O_KS + 262144, O_CP = O_VS + 262144, O_CS = O_CP + 61440, O_HP = O_CS + 1966080, O_HS = O_HP + 524288, O_END = O_HS + 16777216;
enum { I_XP = 0, I_XS, I_CK, I_CV, I_SCONV, I_SHGRN, I_PT, I_NORM0, I_WIN0, I_QN, I_KN, I_CW, I_CB, I_LNG, I_LNB, I_WOUT0, I_NORM1, I_WIN1, I_LBL, I_ONORM, I_WOUT1, N_IN };
struct Args { const void* in[N_IN]; float* out; unsigned char* ws; };

__device__ __forceinline__ void p0_transpose_item(const float* W, int K, int N, bf16* WT, int k0, int n0, int drow0, const float* gain, LAS float* scr, int lane) {
#pragma unroll
    for (int i = 0; i < 8; ++i) { const int kk = (lane >> 3) + 8 * i, n4 = (lane & 7) * 4; const float gsc = gain ? gain[k0 + kk] : 1.0f;
        const f32x4 w = *(const f32x4*)(W + (size_t)(k0 + kk) * N + n0 + n4);
        scr[kk * 33 + n4] = w[0] * gsc; scr[kk * 33 + n4 + 1] = w[1] * gsc; scr[kk * 33 + n4 + 2] = w[2] * gsc; scr[kk * 33 + n4 + 3] = w[3] * gsc; }
    LDS_WAIT(); asm volatile("" ::: "memory");
    const int c = lane & 7;
#pragma unroll
    for (int j = 0; j < 4; ++j) { const int n = (lane >> 3) + 8 * j; const LAS float* s = scr + (8 * c) * 33 + n;
        v4u o; o.x = pk2(s[0 * 33], s[1 * 33]); o.y = pk2(s[2 * 33], s[3 * 33]); o.z = pk2(s[4 * 33], s[5 * 33]); o.w = pk2(s[6 * 33], s[7 * 33]);
        *(GAS v4u*)(WT + (size_t)(drow0 + n) * K + k0 + 8 * c) = o; }
    LDS_WAIT(); asm volatile("" ::: "memory");
}
__device__ __forceinline__ int l0_src_group(int dg) {
    const int pnD = dg >> 3, gi = dg & 7, bj = gi >> 2, wc = gi & 3;
    if (pnD >= 8 && pnD < 12) return (bj ? 80 : 64) + 4 * (pnD - 8) + wc;
    return 8 * pnD + 2 * wc + bj;
}


__device__ __forceinline__ void conv_phase(LAS unsigned char* lds, int vcu, int G, const bf16* U, const bf16* GCs, const float* state_conv,
                                           const float* cw, const float* cb, const float* lng, const float* lnb, bf16* M0) {
    const int tid = threadIdx.x, c = tid, wave = tid >> 6, lane = tid & 63;
    LAS float* Y = (LAS float*)lds;
    LAS float* ST = (LAS float*)(lds + 32768);
    float w[31];
#pragma unroll
    for (int i = 0; i < 31; ++i) w[i] = cw[i * 512 + c];
    const float bias = cb[c], gg = lng[c], be = lnb[c];
    for (int unit = vcu; unit < 1056; unit += G) {
        float y[16];
        if (unit < 1024) {
            const int r0 = unit * 16, tok0 = r0 & 4095;
            float uw[46];
#pragma unroll
            for (int i = 0; i < 46; ++i) { const int tt = tok0 - 30 + i; uw[i] = tt >= 0 ? bf2f(U[(size_t)(r0 - 30 + i) * 512 + c]) : 0.f; }
#pragma unroll
            for (int t = 0; t < 16; ++t) { float a = bias;
#pragma unroll
                for (int i = 0; i < 31; ++i) a += w[i] * uw[t + i];
                y[t] = a; }
        } else {
            const int s0 = (unit - 1024) * 4;
#pragma unroll
            for (int sq = 0; sq < 4; ++sq) { const int n = s0 + sq; float uw[34];
#pragma unroll
                for (int i = 0; i < 30; ++i) uw[i] = state_conv[((size_t)n * 30 + i) * 512 + c];
#pragma unroll
                for (int i = 0; i < 4; ++i) uw[30 + i] = bf2f(U[(size_t)(MPROMPT + n * 4 + i) * 512 + c]);
#pragma unroll
                for (int t = 0; t < 4; ++t) { float a = bias;
#pragma unroll
                    for (int i = 0; i < 31; ++i) a += w[i] * uw[t + i];
                    y[sq * 4 + t] = a; } }
        }
#pragma unroll
        for (int t = 0; t < 16; ++t) Y[t * 512 + c] = y[t];
        __syncthreads();
#pragma unroll
        for (int k = 0; k < 2; ++k) { const int t = 2 * wave + k; float v[8]; float s = 0.f;
#pragma unroll
            for (int j = 0; j < 8; ++j) { v[j] = Y[t * 512 + lane + 64 * j]; s += v[j]; }
            const float mean = wave_sum(s) * (1.0f / 512.0f); float q = 0.f;
#pragma unroll
            for (int j = 0; j < 8; ++j) { const float d = v[j] - mean; q += d * d; }
            const float var = wave_sum(q) * (1.0f / 512.0f);
            if (lane == 0) { ST[2 * t] = mean; ST[2 * t + 1] = 1.0f / sqrtf(var + 1e-6f); } }
        __syncthreads();
        const int rbase = unit < 1024 ? unit * 16 : MPROMPT + (unit - 1024) * 16;
#pragma unroll
        for (int t = 0; t < 16; ++t) { const float ln = (y[t] - ST[2 * t]) * ST[2 * t + 1] * gg + be; const float oc = pg8::fsilu(ln); const size_t r = (size_t)(rbase + t);
            M0[r * 1024 + 512 + c] = (bf16)f2bf(oc * bf2f(GCs[r * 512 + c])); }
        __syncthreads();
    }
}


typedef unsigned u32x4_t __attribute__((ext_vector_type(4)));
typedef unsigned u32x2_t __attribute__((ext_vector_type(2)));
__device__ __forceinline__ float fexp(float x) { return __builtin_amdgcn_exp2f(x * 1.4426950408889634f); }
__device__ __forceinline__ bf16x8 mk_frag(u32x2_t a, u32x2_t b) { u32x4_t w; w.x = a.x; w.y = a.y; w.z = b.x; w.w = b.y; return __builtin_bit_cast(bf16x8, w); }
__device__ __forceinline__ unsigned cvtpk(float lo, float hi) { return pg8::cvt_pk_bf16(lo, hi); }
typedef float f32x2_t __attribute__((ext_vector_type(2))); typedef __bf16 bf16x2_t __attribute__((ext_vector_type(2)));
__device__ __forceinline__ unsigned cvtpk_nv(float lo, float hi) { f32x2_t v = {lo, hi}; bf16x2_t b = __builtin_convertvector(v, bf16x2_t); return __builtin_bit_cast(unsigned, b); }
constexpr int P1_QB = 0, P1_QT = 17408, P1_QTS = 34816, P1_KD = 47872, P1_KE = 65280, P1_KLT = 78336, P1_VT = 96768, P1_AB = 115200, P1_TOT = 124416, P1_DV = 126464;
constexpr int RP = 272, RS = 144;

__device__ __forceinline__ void scan_a_block(LAS unsigned char* lds, int aoff, int boff, int I, int J, bool diag, int lane) {
    const int l15 = lane & 15, g4 = lane >> 4;
    f32x4 acc = (f32x4){0.f, 0.f, 0.f, 0.f};
#pragma unroll
    for (int ks = 0; ks < 4; ++ks) {
        const bf16x8 a = *(const LAS bf16x8*)(lds + aoff + l15 * RP + (32 * ks + 8 * g4) * 2);
        const bf16x8 b = *(const LAS bf16x8*)(lds + boff + l15 * RP + (32 * ks + 8 * g4) * 2);
        acc = __builtin_amdgcn_mfma_f32_16x16x32_bf16(a, b, acc, 0, 0, 0);
    }
#pragma unroll
    for (int r = 0; r < 4; ++r) { const int t = 4 * g4 + r; const float v = (diag && l15 > t) ? 0.f : acc[r];
        *(LAS unsigned short*)(lds + P1_AB + (16 * I + t) * RS + (16 * J + l15) * 2) = (unsigned short)f2bf(v); }
}

__device__ __forceinline__ void scan_pass1(LAS unsigned char* lds, int vcu, int G, const bf16* QQ, const float* LOGF, const bf16* VV, float* OLOC, bf16* QBS, float* USEG, float* DSEG) {
    const int tid = threadIdx.x, lane = tid & 63, wave = __builtin_amdgcn_readfirstlane(tid >> 6), l15 = lane & 15, g4 = lane >> 4;
    const int k = tid & 127, I = __builtin_amdgcn_readfirstlane(tid >> 7);
    LAS float* TOT = (LAS float*)(lds + P1_TOT); LAS float* DV = (LAS float*)(lds + P1_DV);
    for (int unit = vcu; unit < 256; unit += G) {
        const int b = unit >> 6, h = (unit >> 3) & 7, g = unit & 7;
        for (int i = tid; i < 64 * RS / 4; i += 512) ((LAS unsigned*)(lds + P1_AB))[i] = 0u;
        f32x4 S[8];
#pragma unroll
        for (int kt = 0; kt < 8; ++kt) S[kt] = (f32x4){0.f, 0.f, 0.f, 0.f};
        float Bprev = 0.f;
        __syncthreads();
        for (int ch = 0; ch < 8; ++ch) {
            const size_t row0 = (size_t)b * 4096 + g * 512 + ch * 64;
            float lf[16], c[16]; unsigned short qv[16], vvv[16];
#pragma unroll
            for (int i = 0; i < 16; ++i) { const size_t o = (row0 + 16 * I + i) * 1024 + h * 128 + k; lf[i] = LOGF[o]; qv[i] = QQ[o]; vvv[i] = VV[o]; }
            { u32x4_t w0, w1;
              w0.x = vvv[0] | ((unsigned)vvv[1] << 16); w0.y = vvv[2] | ((unsigned)vvv[3] << 16); w0.z = vvv[4] | ((unsigned)vvv[5] << 16); w0.w = vvv[6] | ((unsigned)vvv[7] << 16);
              w1.x = vvv[8] | ((unsigned)vvv[9] << 16); w1.y = vvv[10] | ((unsigned)vvv[11] << 16); w1.z = vvv[12] | ((unsigned)vvv[13] << 16); w1.w = vvv[14] | ((unsigned)vvv[15] << 16);
              *(LAS u32x4_t*)(lds + P1_VT + k * RS + I * 32) = w0; *(LAS u32x4_t*)(lds + P1_VT + k * RS + I * 32 + 16) = w1; }
            c[0] = lf[0];
#pragma unroll
            for (int i = 1; i < 16; ++i) c[i] = c[i - 1] + lf[i];
            TOT[I * 128 + k] = c[15];
            __syncthreads();
            const float t0 = TOT[k], t1 = TOT[128 + k], t2 = TOT[256 + k], t3 = TOT[384 + k];
            const float rI = I == 0 ? 0.f : (I == 1 ? t0 : (I == 2 ? t0 + t1 : (t0 + t1) + t2));
            const float totI = I == 0 ? t0 : (I == 1 ? t1 : (I == 2 ? t2 : t3));
            const float btot = (t0 + t1) + (t2 + t3);
            const float e_rI = fexp(rI), e_prev = fexp(Bprev), e_klt = fexp(btot - rI - totI);
            const float sc1 = I == 2 ? fexp(t1) : fexp(t2), sc2 = fexp(t2 + t1);
            unsigned kl2[8];
#pragma unroll
            for (int i = 0; i < 16; ++i) {
                const int t = 16 * I + i;
                const float q = bf2f(qv[i]);
                const float qt = q * fexp(c[i]), qb = qt * e_rI;
                const float kk = 1.0f - fexp(lf[i]);
                const float kd = kk * fexp(fminf(-c[i], 80.f)), ke = kk * fexp(totI - c[i]), kl = ke * e_klt;
                *(LAS unsigned short*)(lds + P1_QB + t * RP + k * 2) = (unsigned short)f2bf(qb);
                *(LAS unsigned short*)(lds + P1_QT + t * RP + k * 2) = (unsigned short)f2bf(qt);
                *(LAS unsigned short*)(lds + P1_KD + t * RP + k * 2) = (unsigned short)f2bf(kd);
                if (I < 3) *(LAS unsigned short*)(lds + P1_KE + t * RP + k * 2) = (unsigned short)f2bf(ke);
                if (I == 2) *(LAS unsigned short*)(lds + P1_QTS + i * RP + k * 2) = (unsigned short)f2bf(qt * sc1);
                if (I == 3) { *(LAS unsigned short*)(lds + P1_QTS + (16 + i) * RP + k * 2) = (unsigned short)f2bf(qt * sc1); *(LAS unsigned short*)(lds + P1_QTS + (32 + i) * RP + k * 2) = (unsigned short)f2bf(qt * sc2); }
                QBS[(row0 + t) * 1024 + h * 128 + k] = (bf16)f2bf(qb * e_prev);
                if (i & 1) kl2[i >> 1] |= f2bf(kl) << 16; else kl2[i >> 1] = f2bf(kl);
            }
            { u32x4_t w0, w1; w0.x = kl2[0]; w0.y = kl2[1]; w0.z = kl2[2]; w0.w = kl2[3]; w1.x = kl2[4]; w1.y = kl2[5]; w1.z = kl2[6]; w1.w = kl2[7];
              *(LAS u32x4_t*)(lds + P1_KLT + k * RS + I * 32) = w0; *(LAS u32x4_t*)(lds + P1_KLT + k * RS + I * 32 + 16) = w1; }
            if (I == 0) DV[k] = fexp(btot);
            Bprev += btot;
            __syncthreads();
            if (wave < 4) scan_a_block(lds, P1_QT + 16 * wave * RP, P1_KD + 16 * wave * RP, wave, wave, true, lane);
            else if (wave < 7) scan_a_block(lds, P1_QT + 16 * (wave - 3) * RP, P1_KE + 16 * (wave - 4) * RP, wave - 3, wave - 4, false, lane);
            else scan_a_block(lds, P1_QTS, P1_KE, 2, 0, false, lane);
            if (wave == 0) scan_a_block(lds, P1_QTS + 16 * RP, P1_KE + 16 * RP, 3, 1, false, lane);
            if (wave == 1) scan_a_block(lds, P1_QTS + 32 * RP, P1_KE, 3, 0, false, lane);
            __syncthreads();
            {
                bf16x8 vfr[2];
#pragma unroll
                for (int ss = 0; ss < 2; ++ss) vfr[ss] = *(const LAS bf16x8*)(lds + P1_VT + (16 * wave + l15) * RS + (32 * ss + 8 * g4) * 2);
                bf16x8 sfr[4];
#pragma unroll
                for (int ks = 0; ks < 4; ++ks) { u32x4_t w; w.x = cvtpk(S[2 * ks][0], S[2 * ks][1]); w.y = cvtpk(S[2 * ks][2], S[2 * ks][3]); w.z = cvtpk(S[2 * ks + 1][0], S[2 * ks + 1][1]); w.w = cvtpk(S[2 * ks + 1][2], S[2 * ks + 1][3]); sfr[ks] = __builtin_bit_cast(bf16x8, w); }
#pragma unroll
                for (int ti = 0; ti < 4; ++ti) {
                    f32x4 o = (f32x4){0.f, 0.f, 0.f, 0.f};
#pragma unroll
                    for (int ks = 0; ks < 4; ++ks) {
                        const u32x2_t a0 = *(const LAS u32x2_t*)(lds + P1_QB + (16 * ti + l15) * RP + (32 * ks + 4 * g4) * 2);
                        const u32x2_t a1 = *(const LAS u32x2_t*)(lds + P1_QB + (16 * ti + l15) * RP + (32 * ks + 16 + 4 * g4) * 2);
                        o = __builtin_amdgcn_mfma_f32_16x16x32_bf16(sfr[ks], mk_frag(a0, a1), o, 0, 0, 0);
                    }
#pragma unroll
                    for (int ss = 0; ss < 2; ++ss) {
                        const bf16x8 a = *(const LAS bf16x8*)(lds + P1_AB + (16 * ti + l15) * RS + (32 * ss + 8 * g4) * 2);
                        o = __builtin_amdgcn_mfma_f32_16x16x32_bf16(vfr[ss], a, o, 0, 0, 0);
                    }
                    *(f32x4*)(OLOC + (row0 + 16 * ti + l15) * 1024 + h * 128 + 16 * wave + 4 * g4) = o;
                }
#pragma unroll
                for (int kt = 0; kt < 8; ++kt) {
                    const f32x4 dv = *(const LAS f32x4*)(lds + P1_DV + (16 * kt + 4 * g4) * 4);
                    S[kt] = S[kt] * dv;
#pragma unroll
                    for (int ss = 0; ss < 2; ++ss) {
                        const bf16x8 a = *(const LAS bf16x8*)(lds + P1_KLT + (16 * kt + l15) * RS + (32 * ss + 8 * g4) * 2);
                        S[kt] = __builtin_amdgcn_mfma_f32_16x16x32_bf16(a, vfr[ss], S[kt], 0, 0, 0);
                    }
                }
            }
            __syncthreads();
        }
#pragma unroll
        for (int kt = 0; kt < 8; ++kt)
#pragma unroll
            for (int r = 0; r < 4; ++r) USEG[((size_t)unit * 128 + 16 * kt + 4 * g4 + r) * 128 + 16 * wave + l15] = S[kt][r];
        if (I == 0) DSEG[unit * 128 + k] = fexp(Bprev);
    }
}

__device__ __forceinline__ void scan_sample(LAS unsigned char* lds, int vcu, int G, const bf16* QQ, const float* LOGF, const bf16* VV, const bf16* GS, const float* og,
                                            const float* S0, float* Sout, bf16* M1) {
    const int tid = threadIdx.x, lane = tid & 63, wave = tid >> 6, v = tid & 127, kq = tid >> 7;
    LAS float* FS = (LAS float*)lds; LAS float* QS = FS + 512; LAS float* VS = QS + 512; LAS float* PART = VS + 512; LAS float* RED = PART + 2048;
    for (int su = vcu; su < 1024; su += G) {
        const int n = su >> 3, h = su & 7;
        float S[32];
        const float* s0 = S0 + (((size_t)(n * 8 + h)) * 128 + kq * 32) * 128 + v;
#pragma unroll
        for (int i = 0; i < 32; ++i) S[i] = s0[(size_t)i * 128];
        { const size_t o = (size_t)(MPROMPT + n * 4 + kq) * 1024 + h * 128 + v; FS[kq * 128 + v] = fexp(LOGF[o]); QS[kq * 128 + v] = bf2f(QQ[o]); VS[kq * 128 + v] = bf2f(VV[o]); }
        __syncthreads();
        float po[4];
#pragma unroll
        for (int t = 0; t < 4; ++t) { const float vv = VS[t * 128 + v]; float p = 0.f;
#pragma unroll
            for (int i = 0; i < 32; ++i) { const int kk = kq * 32 + i; const float f = FS[t * 128 + kk]; S[i] = f * S[i] + (1.0f - f) * vv; p += QS[t * 128 + kk] * S[i]; }
            po[t] = p; }
#pragma unroll
        for (int t = 0; t < 4; ++t) PART[(kq * 4 + t) * 128 + v] = po[t];
        float* so = Sout + (((size_t)(n * 8 + h)) * 128 + kq * 32) * 128 + v;
#pragma unroll
        for (int i = 0; i < 32; ++i) so[(size_t)i * 128] = S[i];
        __syncthreads();
        const int t = kq;
        const float o = (PART[(0 * 4 + t) * 128 + v] + PART[(1 * 4 + t) * 128 + v]) + (PART[(2 * 4 + t) * 128 + v] + PART[(3 * 4 + t) * 128 + v]);
        const float ss = wave_sum(o * o);
        if (lane == 0) RED[wave] = ss;
        __syncthreads();
        const float rs = __builtin_amdgcn_rsqf((RED[2 * t] + RED[2 * t + 1]) * (1.0f / 128.0f) + 1e-6f);
        const size_t ro = (size_t)(MPROMPT + n * 4 + t) * 1024 + h * 128 + v;
        M1[ro] = (bf16)f2bf(o * rs * og[v] * bf2f(GS[ro]));
        __syncthreads();
    }
}

constexpr int P3_SIN = 0;
__device__ __forceinline__ void scan_pass3(LAS unsigned char* lds, int vcu, int G, const bf16* QBS, const float* OLOC, const float* USEG, const float* DSEG, const bf16* GS, const float* og,
                                           bf16* M1, float* hgrn_prompt) {
    const int tid = threadIdx.x, lane = tid & 63, wave = __builtin_amdgcn_readfirstlane(tid >> 6), l15 = lane & 15, g4 = lane >> 4, v = tid & 127, kq = tid >> 7;
    for (int u3 = vcu; u3 < 512; u3 += G) {
        const int half = u3 & 1, g = (u3 >> 1) & 7, h = (u3 >> 4) & 7, b = u3 >> 7, bh = b * 8 + h;
        float S[32];
#pragma unroll
        for (int i = 0; i < 32; ++i) S[i] = 0.f;
        for (int gp = 0; gp < g; ++gp) {
            const float* U = USEG + (((size_t)(bh * 8 + gp)) * 128 + kq * 32) * 128 + v; const float* Dg = DSEG + (bh * 8 + gp) * 128 + kq * 32;
#pragma unroll
            for (int i = 0; i < 32; ++i) S[i] = Dg[i] * S[i] + U[(size_t)i * 128];
        }
        if (g == 7 && half == 0) {
            const float* U = USEG + (((size_t)(bh * 8 + 7)) * 128 + kq * 32) * 128 + v; const float* Dg = DSEG + (bh * 8 + 7) * 128 + kq * 32;
            float* hp = hgrn_prompt + (((size_t)bh) * 128 + kq * 32) * 128 + v;
#pragma unroll
            for (int i = 0; i < 32; ++i) hp[(size_t)i * 128] = Dg[i] * S[i] + U[(size_t)i * 128];
        }
#pragma unroll
        for (int j = 0; j < 4; ++j) { u32x4_t w; w.x = cvtpk(S[8 * j], S[8 * j + 1]); w.y = cvtpk(S[8 * j + 2], S[8 * j + 3]); w.z = cvtpk(S[8 * j + 4], S[8 * j + 5]); w.w = cvtpk(S[8 * j + 6], S[8 * j + 7]);
            *(LAS u32x4_t*)(lds + P3_SIN + v * RP + (kq * 32 + 8 * j) * 2) = w; }
        __syncthreads();
        const size_t rbase = (size_t)b * 4096 + g * 512 + half * 256 + 32 * wave;
        f32x4 acc[2][8];
#pragma unroll
        for (int ti = 0; ti < 2; ++ti)
#pragma unroll
            for (int vt = 0; vt < 8; ++vt) acc[ti][vt] = (f32x4){0.f, 0.f, 0.f, 0.f};
        if (g > 0) {
#pragma unroll
            for (int ks = 0; ks < 4; ++ks) {
                bf16x8 afr[2];
#pragma unroll
                for (int ti = 0; ti < 2; ++ti) afr[ti] = *(const bf16x8*)(QBS + (rbase + 16 * ti + l15) * 1024 + h * 128 + 32 * ks + 8 * g4);
#pragma unroll
                for (int vt = 0; vt < 8; ++vt) { const bf16x8 bfr = *(const LAS bf16x8*)(lds + P3_SIN + (16 * vt + l15) * RP + (32 * ks + 8 * g4) * 2);
#pragma unroll
                    for (int ti = 0; ti < 2; ++ti) acc[ti][vt] = __builtin_amdgcn_mfma_f32_16x16x32_bf16(bfr, afr[ti], acc[ti][vt], 0, 0, 0); }
            }
        }
        f32x4 ogv[8];
#pragma unroll
        for (int vt = 0; vt < 8; ++vt) ogv[vt] = *(const f32x4*)(og + 16 * vt + 4 * g4);
#pragma unroll
        for (int ti = 0; ti < 2; ++ti) {
            const size_t ro = (rbase + 16 * ti + l15) * 1024 + h * 128 + 4 * g4;
            float ss = 0.f;
#pragma unroll
            for (int vt = 0; vt < 8; ++vt) { acc[ti][vt] += *(const f32x4*)(OLOC + ro + 16 * vt); ss += pg8::dot4(acc[ti][vt]); }
            ss += __shfl_xor(ss, 16); ss += __shfl_xor(ss, 32);
            const float rs = __builtin_amdgcn_rsqf(ss * (1.0f / 128.0f) + 1e-6f);
#pragma unroll
            for (int vt = 0; vt < 8; ++vt) {
                const u32x2_t gw = *(const u32x2_t*)(GS + ro + 16 * vt);
                const f32x4 gsv = (f32x4){__builtin_bit_cast(float, gw.x << 16), __builtin_bit_cast(float, gw.x & 0xffff0000u), __builtin_bit_cast(float, gw.y << 16), __builtin_bit_cast(float, gw.y & 0xffff0000u)};
                const f32x4 r4 = acc[ti][vt] * rs * ogv[vt] * gsv;
                u32x2_t w; w.x = cvtpk_nv(r4[0], r4[1]); w.y = cvtpk_nv(r4[2], r4[3]);
                *(u32x2_t*)(M1 + ro + 16 * vt) = w;
            }
        }
        __syncthreads();
    }
}


typedef float f32x16 __attribute__((ext_vector_type(16)));
typedef short v4i16_t __attribute__((ext_vector_type(4)));
constexpr int AT_KV = 0;
constexpr int AT_PITCH = 144, AT_TILE = 64 * AT_PITCH, AT_BUF = 2 * AT_TILE;
constexpr int AT_KM = 2 * AT_BUF;
constexpr int AT_WS = AT_KM + 4096;
constexpr float SM_C = 0.125f * 1.4426950408889634f;
__device__ __forceinline__ int crow(int r, int hi) { return (r & 3) + 8 * (r >> 2) + 4 * hi; }

__device__ __forceinline__ void attn_prompt_unit(LAS unsigned char* lds, int b, int h, int j, const bf16* Qb, const bf16* Kb, const bf16* Vb, const bf16* GAs, const float* KMP,
                                                 const float* qg, const float* kg, bf16* M0) {
    const int tid = threadIdx.x, lane = tid & 63, wave = __builtin_amdgcn_readfirstlane(tid >> 6), l31 = lane & 31, hh = lane >> 5;
    LAS float* KM = (LAS float*)(lds + AT_KM); LAS float* WSF = (LAS float*)(lds + AT_WS) + wave * 32;
    for (int i = tid; i < j * 64; i += 512) { const int n = i >> 6, d = i & 63; const float* p = KMP + ((size_t)(b * 16 + n) * 4) * 512 + h * 64 + d; KM[i] = ((p[0] + p[512]) + (p[1024] + p[1536])) * (1.0f / 256.0f); }
    float gq = fabsf(qg[lane]), gk = fabsf(kg[lane]);
#pragma unroll
    for (int o = 1; o < 64; o <<= 1) { gq = fmaxf(gq, __shfl_xor(gq, o)); gk = fmaxf(gk, __shfl_xor(gk, o)); }
    const float m0c = 8.0f * gq * gk * 1.4426950408889634f;
    const size_t qrow = (size_t)b * 4096 + 256 * j + 32 * wave + l31;
    bf16x8 qf[4];
#pragma unroll
    for (int ds = 0; ds < 4; ++ds) qf[ds] = *(const bf16x8*)(Qb + qrow * 512 + h * 64 + 16 * ds + 8 * hh);
    const int srow = tid >> 3, sch = tid & 7;
    const size_t kvbase = (size_t)b * 4096 * 512 + h * 64 + sch * 8;
    const int sdst = srow * AT_PITCH + sch * 16;
    const int T = 4 * (j + 1);
    u32x4_t kreg, vreg;
    { const size_t r0 = (size_t)(256 * j + srow) * 512; kreg = *(const u32x4_t*)(Kb + kvbase + r0); vreg = *(const u32x4_t*)(Vb + kvbase + r0); }
    __syncthreads();
    unsigned selmask;
    if (j <= 3) selmask = (1u << j) - 1u;
    else {
        float g0 = -INFINITY, g1 = -INFINITY, g2 = -INFINITY; int s0 = 0, s1 = 0, s2 = 0;
        for (int n = 0; n < j; ++n) {
            float part = 0.f;
#pragma unroll
            for (int ds = 0; ds < 4; ++ds)
#pragma unroll
                for (int e = 0; e < 8; ++e) part += bf2f((unsigned short)qf[ds][e]) * KM[n * 64 + 16 * ds + 8 * hh + e];
            const float g = part + __shfl_xor(part, 32);
            if (g > g0) { g2 = g1; s2 = s1; g1 = g0; s1 = s0; g0 = g; s0 = n; }
            else if (g > g1) { g2 = g1; s2 = s1; g1 = g; s1 = n; }
            else if (g > g2) { g2 = g; s2 = n; }
        }
        selmask = (1u << s0) | (1u << s1) | (1u << s2);
    }
    *(LAS u32x4_t*)(lds + AT_KV + sdst) = kreg; *(LAS u32x4_t*)(lds + AT_KV + AT_TILE + sdst) = vreg;
    __syncthreads();
    f32x16 o0, o1;
#pragma unroll
    for (int r = 0; r < 16; ++r) { o0[r] = 0.f; o1[r] = 0.f; }
    float lsum = 0.f;
    const int qp = 32 * wave + l31;
    const int koff = l31 * AT_PITCH + hh * 16;
    const int voff = (4 * hh + ((lane & 15) >> 2)) * AT_PITCH + (16 * ((lane >> 4) & 1) + 4 * (lane & 3)) * 2;
    for (int t = 0; t < T; ++t) {
        const bool more = (t + 1 < T);
        if (more) { const int t1 = t + 1; const int nb = t1 < 4 ? j : (t1 >> 2) - 1; const size_t r0 = (size_t)(256 * nb + 64 * (t1 & 3) + srow) * 512; kreg = *(const u32x4_t*)(Kb + kvbase + r0); vreg = *(const u32x4_t*)(Vb + kvbase + r0); }
        const int buf = (t & 1) * AT_BUF;
        const bool own = t < 4; const int nbk = own ? j : (t >> 2) - 1;
        const bool act = own || ((selmask >> nbk) & 1u);
        f32x16 p0, p1;
#pragma unroll
        for (int r = 0; r < 16; ++r) { p0[r] = 0.f; p1[r] = 0.f; }
#pragma unroll
        for (int ds = 0; ds < 4; ++ds) {
            const bf16x8 ka0 = *(const LAS bf16x8*)(lds + AT_KV + buf + koff + ds * 32);
            const bf16x8 ka1 = *(const LAS bf16x8*)(lds + AT_KV + buf + koff + 32 * AT_PITCH + ds * 32);
            p0 = __builtin_amdgcn_mfma_f32_32x32x16_bf16(ka0, qf[ds], p0, 0, 0, 0);
            p1 = __builtin_amdgcn_mfma_f32_32x32x16_bf16(ka1, qf[ds], p1, 0, 0, 0);
        }
        const int kp0 = 64 * (t & 3);
        float ls = 0.f;
#pragma unroll
        for (int r = 0; r < 16; ++r) {
            const int kp = kp0 + crow(r, hh);
            const bool v0 = own ? (kp <= qp) : act, v1 = own ? (kp + 32 <= qp) : act;
            const float e0 = v0 ? __builtin_amdgcn_exp2f(p0[r] * SM_C - m0c) : 0.f, e1 = v1 ? __builtin_amdgcn_exp2f(p1[r] * SM_C - m0c) : 0.f;
            p0[r] = e0; p1[r] = e1; ls += e0 + e1;
        }
        lsum += ls;
        bf16x8 pa[4];
        { u32x4_t w;
          w.x = cvtpk(p0[0], p0[1]); w.y = cvtpk(p0[2], p0[3]); w.z = cvtpk(p0[4], p0[5]); w.w = cvtpk(p0[6], p0[7]); pa[0] = __builtin_bit_cast(bf16x8, w);
          w.x = cvtpk(p0[8], p0[9]); w.y = cvtpk(p0[10], p0[11]); w.z = cvtpk(p0[12], p0[13]); w.w = cvtpk(p0[14], p0[15]); pa[1] = __builtin_bit_cast(bf16x8, w);
          w.x = cvtpk(p1[0], p1[1]); w.y = cvtpk(p1[2], p1[3]); w.z = cvtpk(p1[4], p1[5]); w.w = cvtpk(p1[6], p1[7]); pa[2] = __builtin_bit_cast(bf16x8, w);
          w.x = cvtpk(p1[8], p1[9]); w.y = cvtpk(p1[10], p1[11]); w.z = cvtpk(p1[12], p1[13]); w.w = cvtpk(p1[14], p1[15]); pa[3] = __builtin_bit_cast(bf16x8, w); }
#pragma unroll
        for (int ks = 0; ks < 4; ++ks) {
            const LAS unsigned char* vb = lds + AT_KV + buf + AT_TILE + voff + 16 * ks * AT_PITCH;
            const v4i16_t a0 = __builtin_amdgcn_ds_read_tr16_b64_v4i16((LAS v4i16_t*)(vb));
            const v4i16_t a1 = __builtin_amdgcn_ds_read_tr16_b64_v4i16((LAS v4i16_t*)(vb + 8 * AT_PITCH));
            const v4i16_t c0 = __builtin_amdgcn_ds_read_tr16_b64_v4i16((LAS v4i16_t*)(vb + 64));
            const v4i16_t c1 = __builtin_amdgcn_ds_read_tr16_b64_v4i16((LAS v4i16_t*)(vb + 8 * AT_PITCH + 64));
            const bf16x8 vf0 = (bf16x8){a0[0], a0[1], a0[2], a0[3], a1[0], a1[1], a1[2], a1[3]};
            const bf16x8 vf1 = (bf16x8){c0[0], c0[1], c0[2], c0[3], c1[0], c1[1], c1[2], c1[3]};
            o0 = __builtin_amdgcn_mfma_f32_32x32x16_bf16(pa[ks], vf0, o0, 0, 0, 0);
            o1 = __builtin_amdgcn_mfma_f32_32x32x16_bf16(pa[ks], vf1, o1, 0, 0, 0);
        }
        if (more) { const int nbuf = ((t + 1) & 1) * AT_BUF; *(LAS u32x4_t*)(lds + AT_KV + nbuf + sdst) = kreg; *(LAS u32x4_t*)(lds + AT_KV + nbuf + AT_TILE + sdst) = vreg; }
        __syncthreads();
    }
    lsum += __shfl_xor(lsum, 32);
    if (hh == 0) WSF[l31] = 1.0f / lsum;
    asm volatile("s_waitcnt lgkmcnt(0)" ::: "memory");
    const size_t orow0 = (size_t)b * 4096 + 256 * j + 32 * wave;
#pragma unroll
    for (int r = 0; r < 16; ++r) {
        const int q = crow(r, hh); const float li = WSF[q]; const size_t ro = orow0 + q;
        const float ga0 = bf2f(GAs[ro * 512 + h * 64 + l31]), ga1 = bf2f(GAs[ro * 512 + h * 64 + 32 + l31]);
        M0[ro * 1024 + h * 64 + l31] = (bf16)f2bf(o0[r] * li * ga0);
        M0[ro * 1024 + h * 64 + 32 + l31] = (bf16)f2bf(o1[r] * li * ga1);
    }
}
__device__ __forceinline__ void attn_prompt_phase(LAS unsigned char* lds, int vcu, int G, const bf16* Qb, const bf16* Kb, const bf16* Vb, const bf16* GAs, const float* KMP, const float* qg, const float* kg, bf16* M0) {
    for (int u = vcu; u < 256; u += G) {
        const int b = u >> 6, h = (u >> 3) & 7, jj = u & 7;
        attn_prompt_unit(lds, b, h, 15 - jj, Qb, Kb, Vb, GAs, KMP, qg, kg, M0);
        attn_prompt_unit(lds, b, h, jj, Qb, Kb, Vb, GAs, KMP, qg, kg, M0);
    }
}


__device__ __forceinline__ void attn_sample_passA(LAS unsigned char* lds, int vcu, int G, const bf16* Qb, const float* cache_k, const int* pt, float* SC, float* KMS) {
    const int tid = threadIdx.x, lane = tid & 63, h = __builtin_amdgcn_readfirstlane(tid >> 6), rowi = lane & 15, kq = lane >> 4;
    for (int unit = vcu; unit < 1024; unit += G) {
        const int n = unit >> 3, blk = unit & 7;
        bf16x8 qfr[2];
#pragma unroll
        for (int s = 0; s < 2; ++s) { u32x4_t w = (u32x4_t){0u, 0u, 0u, 0u}; if (rowi < 4) w = *(const u32x4_t*)(Qb + (size_t)(MPROMPT + n * 4 + rowi) * 512 + h * 64 + 32 * s + 8 * kq); qfr[s] = __builtin_bit_cast(bf16x8, w); }
        const int pg0 = pt[n * 16 + blk * 2], pg1 = pt[n * 16 + blk * 2 + 1];
        f32x4 ks[2][2];
#pragma unroll
        for (int s = 0; s < 2; ++s) { ks[s][0] = (f32x4){0.f, 0.f, 0.f, 0.f}; ks[s][1] = (f32x4){0.f, 0.f, 0.f, 0.f}; }
        float* scb = SC + (((size_t)n * 8 + h) * 4 + rowi) * 2048 + blk * 256 + 4 * kq;
#pragma unroll 1
        for (int rq = 0; rq < 4; ++rq) {
            const int page = rq < 2 ? pg0 : pg1;
            const float* base = cache_k + (((size_t)page * 128 + ((64 * rq + rowi) & 127)) * 8 + h) * 64 + 8 * kq;
            f32x4 ld[4][4];
#pragma unroll
            for (int g = 0; g < 4; ++g) { const float* bg = base + (size_t)g * 16 * 512;
                ld[g][0] = __builtin_nontemporal_load((const f32x4*)(bg)); ld[g][1] = __builtin_nontemporal_load((const f32x4*)(bg + 4));
                ld[g][2] = __builtin_nontemporal_load((const f32x4*)(bg + 32)); ld[g][3] = __builtin_nontemporal_load((const f32x4*)(bg + 36)); }
#pragma unroll
            for (int g = 0; g < 4; ++g) {
                ks[0][0] += ld[g][0]; ks[0][1] += ld[g][1]; ks[1][0] += ld[g][2]; ks[1][1] += ld[g][3];
                u32x4_t wa, wb;
                wa.x = cvtpk_nv(ld[g][0][0], ld[g][0][1]); wa.y = cvtpk_nv(ld[g][0][2], ld[g][0][3]); wa.z = cvtpk_nv(ld[g][1][0], ld[g][1][1]); wa.w = cvtpk_nv(ld[g][1][2], ld[g][1][3]);
                wb.x = cvtpk_nv(ld[g][2][0], ld[g][2][1]); wb.y = cvtpk_nv(ld[g][2][2], ld[g][2][3]); wb.z = cvtpk_nv(ld[g][3][0], ld[g][3][1]); wb.w = cvtpk_nv(ld[g][3][2], ld[g][3][3]);
                f32x4 acc = (f32x4){0.f, 0.f, 0.f, 0.f};
                acc = __builtin_amdgcn_mfma_f32_16x16x32_bf16(__builtin_bit_cast(bf16x8, wa), qfr[0], acc, 0, 0, 0);
                acc = __builtin_amdgcn_mfma_f32_16x16x32_bf16(__builtin_bit_cast(bf16x8, wb), qfr[1], acc, 0, 0, 0);
                if (rowi < 4) *(f32x4*)(scb + 16 * (4 * rq + g)) = acc;
            }
        }
#pragma unroll
        for (int s = 0; s < 2; ++s)
#pragma unroll
            for (int e = 0; e < 2; ++e) {
                f32x4 v = ks[s][e];
#pragma unroll
                for (int o = 1; o < 16; o <<= 1) { v[0] += __shfl_xor(v[0], o); v[1] += __shfl_xor(v[1], o); v[2] += __shfl_xor(v[2], o); v[3] += __shfl_xor(v[3], o); }
                if (rowi == 0) *(f32x4*)(KMS + ((size_t)n * 8 + blk) * 512 + h * 64 + 32 * s + 8 * kq + 4 * e) = v * (1.0f / 256.0f);
            }
    }
}
__device__ __forceinline__ void attn_sample_passB(LAS unsigned char* lds, int vcu, int G, const bf16* Qb, const bf16* Kb, const bf16* Vb, const bf16* GAs, const float* cache_v, const int* pt,
                                                  const float* SC, const float* KMS, const float* qg, const float* kg, bf16* M0) {
    const int tid = threadIdx.x, lane = tid & 63, wave = __builtin_amdgcn_readfirstlane(tid >> 6);
    LAS float* PL = (LAS float*)lds;
    LAS float* OP = (LAS float*)(lds + 32768);
    LAS unsigned* SEL = (LAS unsigned*)(lds + 65536);
    LAS float* POWN = (LAS float*)(lds + 65536 + 64);
    LAS float* REDL = (LAS float*)(lds + 65536 + 128);
    float gq = fabsf(qg[lane]), gk = fabsf(kg[lane]);
#pragma unroll
    for (int o = 1; o < 64; o <<= 1) { gq = fmaxf(gq, __shfl_xor(gq, o)); gk = fmaxf(gk, __shfl_xor(gk, o)); }
    const float m0c = 8.0f * gq * gk * 1.4426950408889634f;
    for (int unit = vcu; unit < 1024; unit += G) {
        const int n = unit >> 3, h = unit & 7;
        if (wave < 4) {
            const int t = wave; const size_t qrow = (size_t)(MPROMPT + n * 4 + t);
            const float q = bf2f(Qb[qrow * 512 + h * 64 + lane]);
            float g0 = -INFINITY, g1 = -INFINITY, g2 = -INFINITY; int s0 = 0, s1 = 0, s2 = 0;
            for (int blk = 0; blk < 8; ++blk) {
                const float g = wave_sum(q * KMS[((size_t)n * 8 + blk) * 512 + h * 64 + lane]);
                if (g > g0) { g2 = g1; s2 = s1; g1 = g0; s1 = s0; g0 = g; s0 = blk; }
                else if (g > g1) { g2 = g1; s2 = s1; g1 = g; s1 = blk; }
                else if (g > g2) { g2 = g; s2 = blk; }
            }
            if (lane == 0) SEL[t] = (1u << s0) | (1u << s1) | (1u << s2);
#pragma unroll
            for (int tp = 0; tp < 4; ++tp) {
                const float s = wave_sum(q * bf2f(Kb[(size_t)(MPROMPT + n * 4 + tp) * 512 + h * 64 + lane]));
                if (lane == 0) POWN[t * 4 + tp] = tp <= t ? __builtin_amdgcn_exp2f(s * SM_C - m0c) : 0.f;
            }
        }
        __syncthreads();
        const unsigned sel0 = SEL[0], sel1 = SEL[1], sel2 = SEL[2], sel3 = SEL[3], anym = sel0 | sel1 | sel2 | sel3;
        {
            float lp[4] = {0.f, 0.f, 0.f, 0.f};
#pragma unroll
            for (int k = 0; k < 16; ++k) {
                const int i = tid + 512 * k, t = k >> 2, idx = i & 2047, blk = idx >> 8;
                const unsigned sm = t == 0 ? sel0 : (t == 1 ? sel1 : (t == 2 ? sel2 : sel3));
                const float p = ((sm >> blk) & 1u) ? __builtin_amdgcn_exp2f(SC[(((size_t)n * 8 + h) * 4 + t) * 2048 + idx] * SM_C - m0c) : 0.f;
                PL[i] = p; lp[t] += p;
            }
#pragma unroll
            for (int t = 0; t < 4; ++t) { const float s = wave_sum(lp[t]); if (lane == 0) REDL[wave * 4 + t] = s; }
        }
        __syncthreads();
        {
            const int d4 = tid & 15, rl = tid >> 4;
            f32x4 acc[4];
#pragma unroll
            for (int t = 0; t < 4; ++t) acc[t] = (f32x4){0.f, 0.f, 0.f, 0.f};
            const float* cvb = cache_v + (size_t)h * 64 + 4 * d4;
            f32x4 cur[8], nxt[8];
            unsigned rem = anym & 0xffu;
            int blk = rem ? __builtin_ctz(rem) : 8;
            if (blk < 8) { const int pg0 = pt[n * 16 + blk * 2], pg1 = pt[n * 16 + blk * 2 + 1];
#pragma unroll
                for (int rr = 0; rr < 8; ++rr) { const int r = rl + 32 * rr; cur[rr] = __builtin_nontemporal_load((const f32x4*)(cvb + ((size_t)(rr < 4 ? pg0 : pg1) * 128 + (r & 127)) * 512)); } }
            while (blk < 8) {
                rem &= rem - 1u;
                const int nb = rem ? __builtin_ctz(rem) : 8;
                if (nb < 8) { const int pg0 = pt[n * 16 + nb * 2], pg1 = pt[n * 16 + nb * 2 + 1];
#pragma unroll
                    for (int rr = 0; rr < 8; ++rr) { const int r = rl + 32 * rr; nxt[rr] = __builtin_nontemporal_load((const f32x4*)(cvb + ((size_t)(rr < 4 ? pg0 : pg1) * 128 + (r & 127)) * 512)); } }
#pragma unroll
                for (int rr = 0; rr < 8; ++rr) { const int r = rl + 32 * rr;
#pragma unroll
                    for (int t = 0; t < 4; ++t) acc[t] += PL[t * 2048 + blk * 256 + r] * cur[rr]; }
#pragma unroll
                for (int rr = 0; rr < 8; ++rr) cur[rr] = nxt[rr];
                blk = nb;
            }
#pragma unroll
            for (int t = 0; t < 4; ++t) *(LAS f32x4*)(lds + 32768 + ((rl * 4 + t) * 64 + 4 * d4) * 4) = acc[t];
        }
        __syncthreads();
        if (tid < 256) {
            const int t = tid >> 6, d = tid & 63; float o = 0.f;
#pragma unroll 8
            for (int rl = 0; rl < 32; ++rl) o += OP[(rl * 4 + t) * 64 + d];
            float l = 0.f;
#pragma unroll
            for (int w = 0; w < 8; ++w) l += REDL[w * 4 + t];
#pragma unroll
            for (int tp = 0; tp < 4; ++tp) { const float p = POWN[t * 4 + tp]; l += p; o += p * bf2f(Vb[(size_t)(MPROMPT + n * 4 + tp) * 512 + h * 64 + d]); }
            const size_t ro = (size_t)(MPROMPT + n * 4 + t);
            M0[ro * 1024 + h * 64 + d] = (bf16)f2bf(o / l * bf2f(GAs[ro * 512 + h * 64 + d]));
        }
        __syncthreads();
    }
}

__global__ void __launch_bounds__(NWAVES * 64, 2) fwd(Args args) {
    extern __shared__ __attribute__((aligned(16))) unsigned char lds_raw[];
    LAS unsigned char* lds = (LAS unsigned char*)lds_raw;
    volatile LAS unsigned* MISC = (volatile LAS unsigned*)(lds + MISC_OFF);
    const int tid = threadIdx.x, lane = tid & 63, wave = __builtin_amdgcn_readfirstlane(tid >> 6);
    const int G = gridDim.x; const int bx = blockIdx.x; const int vcu = (G % 8 == 0) ? (bx % 8) * (G / 8) + bx / 8 : bx;
    unsigned char* ws = args.ws;
    for (int u = tid; u < (LDS_BYTES - LDSCTL_OFF) / 4; u += NWAVES * 64) ((LAS unsigned*)(lds + LDSCTL_OFF))[u] = 0u;
    __syncthreads();
    XcdBarrier bar = xcd_barrier_post((unsigned*)(ws + WS_CTL) + CW_BAR, MISC + 8);
#ifdef FWD_STAMPS
    unsigned long long* stamps_ = (unsigned long long*)(ws + WS_STAMP);
#define STAMP(k) do { if (bx == 0 && tid == 0) stamps_[k] = __builtin_amdgcn_s_memrealtime(); } while (0)
#else
#define STAMP(k) do {} while (0)
#endif
    STAMP(0);

    const float* x_prompt = (const float*)args.in[I_XP]; const float* x_sample = (const float*)args.in[I_XS];
    float* out = args.out;
    bf16* W0T = (bf16*)(ws + WS_W0T); bf16* WO0T = (bf16*)(ws + WS_WO0T); bf16* W1T = (bf16*)(ws + WS_W1T); bf16* WO1T = (bf16*)(ws + WS_WO1T);
    float* RSTD0 = (float*)(ws + WS_RSTD0); float* LB = (float*)(ws + WS_LB); float* KMP = (float*)(ws + WS_KMP); float* SSQ = (float*)(ws + WS_SSQ);
    bf16* XB = (bf16*)(ws + WS_XB); bf16* Qb = (bf16*)(ws + WS_Q); bf16* Kb = (bf16*)(ws + WS_K); bf16* Vb = (bf16*)(ws + WS_V);
    bf16* GA = (bf16*)(ws + WS_GA); bf16* Ub = (bf16*)(ws + WS_U); bf16* GC = (bf16*)(ws + WS_GC);
    bf16* M0 = (bf16*)(ws + WS_M0); float* X1 = (float*)(ws + WS_X1); bf16* XB1 = (bf16*)(ws + WS_XB1); bf16* QQ = (bf16*)(ws + WS_QQ); float* LOGF = (float*)(ws + WS_LOGF);
    bf16* VV = (bf16*)(ws + WS_VV); bf16* GS = (bf16*)(ws + WS_GS); bf16* M1 = (bf16*)(ws + WS_M1);
    float* SCb = (float*)(ws + WS_SC); float* KMS = (float*)(ws + WS_KMS);
    float* OLOC = (float*)(ws + WS_OLOC); bf16* QBS = (bf16*)(ws + WS_QBS); float* USEG = (float*)(ws + WS_USEG); float* DSEG = (float*)(ws + WS_DSEG);

    {
        LAS float* scr = (LAS float*)(lds + wave * 16384);
        const int gw = vcu * NWAVES + wave, NGW = G * NWAVES;
        constexpr int I0 = 16 * (N0 / 32), IO = 16 * 32, I1 = 16 * (N1 / 32);
        constexpr int NITEMS = I0 + IO + I1 + IO;
        for (int it = gw; it < NITEMS; it += NGW) {
            int r = it;
            if (r < I0) { const int kb = r / (N0 / 32), dg = r % (N0 / 32); p0_transpose_item((const float*)args.in[I_WIN0], D, N0, W0T, 64 * kb, 32 * l0_src_group(dg), 32 * dg, (const float*)args.in[I_NORM0], scr, lane); continue; } r -= I0;
            if (r < IO) { const int kb = r / 32, dg = r % 32; p0_transpose_item((const float*)args.in[I_WOUT0], D, D, WO0T, 64 * kb, 32 * dg, 32 * dg, nullptr, scr, lane); continue; } r -= IO;
            if (r < I1) { const int kb = r / (N1 / 32), dg = r % (N1 / 32); p0_transpose_item((const float*)args.in[I_WIN1], D, N1, W1T, 64 * kb, 32 * dg, 32 * dg, (const float*)args.in[I_NORM1], scr, lane); continue; } r -= I1;
            { const int kb = r / 32, dg = r % 32; p0_transpose_item((const float*)args.in[I_WOUT1], D, D, WO1T, 64 * kb, 32 * dg, 32 * dg, nullptr, scr, lane); }
        }
        for (int m0 = gw; m0 < MTOT; m0 += 2 * NGW) {
            const int m1 = m0 + NGW; const bool has1 = m1 < MTOT; const int m1c = has1 ? m1 : m0;
            const float* xr0 = m0 < MPROMPT ? x_prompt + (size_t)m0 * D : x_sample + (size_t)(m0 - MPROMPT) * D;
            const float* xr1 = m1c < MPROMPT ? x_prompt + (size_t)m1c * D : x_sample + (size_t)(m1c - MPROMPT) * D;
            f32x4 v0[4], v1[4];
#pragma unroll
            for (int j = 0; j < 4; ++j) { v0[j] = ((const GAS f32x4*)xr0)[lane + 64 * j]; v1[j] = ((const GAS f32x4*)xr1)[lane + 64 * j]; }
            float s0 = 0.f, s1 = 0.f;
#pragma unroll
            for (int j = 0; j < 4; ++j) { s0 += pg8::dot4(v0[j]); s1 += pg8::dot4(v1[j]); }
            s0 = wave_sum(s0); s1 = wave_sum(s1);
            if (lane == 0) { RSTD0[m0] = __builtin_amdgcn_rsqf(s0 * (1.0f / D) + 1e-6f); if (has1) RSTD0[m1] = __builtin_amdgcn_rsqf(s1 * (1.0f / D) + 1e-6f); }
            GAS unsigned long long* o0 = (GAS unsigned long long*)(XB + (size_t)m0 * D) + lane;
#pragma unroll
            for (int j = 0; j < 4; ++j) o0[64 * j] = (unsigned long long)pk2(v0[j].x, v0[j].y) | ((unsigned long long)pk2(v0[j].z, v0[j].w) << 32);
            if (has1) { GAS unsigned long long* o1 = (GAS unsigned long long*)(XB + (size_t)m1 * D) + lane;
#pragma unroll
                for (int j = 0; j < 4; ++j) o1[64 * j] = (unsigned long long)pk2(v1[j].x, v1[j].y) | ((unsigned long long)pk2(v1[j].z, v1[j].w) << 32); }
        }
        { const int gt = vcu * (NWAVES * 64) + tid; if (gt < 1024) { const float* l = (const float*)args.in[I_LBL]; LB[gt] = 1.0f / (1.0f + __expf(l[gt] - l[1024 + gt])); } }
        { const f32x4* sc = (const f32x4*)args.in[I_SCONV]; f32x4* cs = (f32x4*)(out + O_CS);
          for (int i = vcu * (NWAVES * 64) + tid; i < NDEC * 26 * 128; i += G * NWAVES * 64) { const int n = i / (26 * 128), rem = i % (26 * 128); cs[(size_t)n * 30 * 128 + rem] = sc[(size_t)n * 30 * 128 + 4 * 128 + rem]; } }
    }
    xcd_barrier(bar); STAMP(1);

    {
        pg8::Gemm g{XB, W0T, MTOT, N0, D}; pg8::StaticOrder S; S.init(MTOT, N0, G, bx);
        pg8::EpiIn0 E{RSTD0, (const float*)args.in[I_QN], (const float*)args.in[I_KN], Qb, Kb, Vb, GA, Ub, GC,
                      out + O_KP, out + O_VP, out + O_KS, out + O_VS, out + O_CP, out + O_CS, KMP};
        pg8::gemm_phase<pg8::EpiIn0, pg8::StaticOrder, true, true>(lds, g, S, E);
    }
    xcd_barrier(bar); STAMP(2);

    if (bx & 1) attn_sample_passA(lds, vcu, G, Qb, (const float*)args.in[I_CK], (const int*)args.in[I_PT], SCb, KMS);
    attn_prompt_phase(lds, vcu, G, Qb, Kb, Vb, GA, KMP, (const float*)args.in[I_QN], (const float*)args.in[I_KN], M0); STAMP(3);
    if (!(bx & 1)) attn_sample_passA(lds, vcu, G, Qb, (const float*)args.in[I_CK], (const int*)args.in[I_PT], SCb, KMS);
    xcd_barrier(bar); STAMP(4);

    if (bx & 1) attn_sample_passB(lds, vcu, G, Qb, Kb, Vb, GA, (const float*)args.in[I_CV], (const int*)args.in[I_PT], SCb, KMS, (const float*)args.in[I_QN], (const float*)args.in[I_KN], M0);
    conv_phase(lds, vcu, G, Ub, GC, (const float*)args.in[I_SCONV], (const float*)args.in[I_CW], (const float*)args.in[I_CB], (const float*)args.in[I_LNG], (const float*)args.in[I_LNB], M0); STAMP(5);
    if (!(bx & 1)) attn_sample_passB(lds, vcu, G, Qb, Kb, Vb, GA, (const float*)args.in[I_CV], (const int*)args.in[I_PT], SCb, KMS, (const float*)args.in[I_QN], (const float*)args.in[I_KN], M0);
    xcd_barrier(bar); STAMP(6);

    {
        pg8::Gemm g{M0, WO0T, MTOT, D, D}; pg8::StaticOrder S; S.init(MTOT, D, G, bx);
        pg8::EpiOut0 E{x_prompt, x_sample, X1, XB1, SSQ};
        pg8::gemm_phase<pg8::EpiOut0, pg8::StaticOrder, true, true>(lds, g, S, E);
    }
    xcd_barrier(bar); STAMP(7);

    {
        pg8::Gemm g{XB1, W1T, MTOT, N1, D}; pg8::StaticOrder S; S.init(MTOT, N1, G, bx);
        pg8::EpiIn1 E{SSQ, LB, QQ, VV, GS, LOGF};
        pg8::gemm_phase<pg8::EpiIn1, pg8::StaticOrder, true, true>(lds, g, S, E);
    }
    xcd_barrier(bar); STAMP(8);

    scan_pass1(lds, vcu, G, QQ, LOGF, VV, OLOC, QBS, USEG, DSEG); STAMP(9);
    scan_sample(lds, vcu, G, QQ, LOGF, VV, GS, (const float*)args.in[I_ONORM], (const float*)args.in[I_SHGRN], out + O_HS, M1);
    xcd_barrier(bar); STAMP(10);

    scan_pass3(lds, vcu, G, QBS, OLOC, USEG, DSEG, GS, (const float*)args.in[I_ONORM], M1, out + O_HP);
    xcd_barrier(bar); STAMP(11);

    {
        pg8::Gemm g{M1, WO1T, MTOT, D, D}; pg8::StaticOrder S; S.init(MTOT, D, G, bx);
        pg8::EpiOut1 E{X1, out + O_Y};
        pg8::gemm_phase<pg8::EpiOut1, pg8::StaticOrder, true, true>(lds, g, S, E);
    }
    STAMP(12);
}
extern "C" void kernel_launch(void* const* d_in, const int* in_sizes, int n_in, void* d_out, int out_size, void* d_ws, size_t ws_size, hipStream_t stream) {
    static int grid = 0;
    if (grid == 0) {
        if (n_in != N_IN || (size_t)out_size != O_END || ws_size < WS_END) { fprintf(stderr, "kernel_launch: unexpected shapes (n_in %d out %d ws %zu)\n", n_in, out_size, ws_size); grid = -1; return; }
        int dev = 0, cus = 0, per_cu = 0;
        if (hipGetDevice(&dev) != hipSuccess || hipDeviceGetAttribute(&cus, hipDeviceAttributeMultiprocessorCount, dev) != hipSuccess) { grid = -1; return; }
        if (hipFuncSetAttribute((const void*)fwd, hipFuncAttributeMaxDynamicSharedMemorySize, LDS_BYTES) != hipSuccess) { fprintf(stderr, "kernel_launch: hipFuncSetAttribute failed\n"); grid = -1; return; }
        if (hipOccupancyMaxActiveBlocksPerMultiprocessor(&per_cu, (const void*)fwd, NWAVES * 64, LDS_BYTES) != hipSuccess || per_cu < 1) fprintf(stderr, "kernel_launch: occupancy query reports %d\n", per_cu);
        (void)hipGetLastError();
        grid = cus;
    }
    if (grid < 0) return;
    if (hipMemsetAsync((char*)d_ws + WS_CTL, 0, CTL_ZERO_BYTES, stream) != hipSuccess) return;
    Args a{};
    for (int i = 0; i < N_IN; ++i) a.in[i] = d_in[i];
    a.out = (float*)d_out; a.ws = (unsigned char*)d_ws;
    hipLaunchKernelGGL(fwd, dim3(grid), dim3(NWAVES * 64), LDS_BYTES, stream, a);
}
```

```cpp
#include <hip/hip_runtime.h>
#include <cstdio>
#include <cstdint>
namespace pg8 {
#define PG8_LAS __attribute__((address_space(3)))
typedef unsigned short bf16_t;
typedef short bf16x8 __attribute__((ext_vector_type(8)));
typedef float f32x4 __attribute__((ext_vector_type(4)));
typedef unsigned u32x4 __attribute__((ext_vector_type(4)));
constexpr int BM = 256, BK = 64, HALF = 128, HTB = HALF * BK * 2  , STAGE_BYTES = 8 * HTB, NXCD = 8, WGM = 8;

__host__ __device__ __forceinline__ int lds_byte(int r, int c) { const int st = (r >> 4) * 2 + (c >> 5), rr = r & 15, cc = c & 31, ob = rr * 64 + cc * 2; return st * 1024 + (ob ^ (((ob >> 9) & 1) << 5)); }
__host__ __device__ __forceinline__ void stage_rc(int b, int& R, int& C) { const int st = b / 1024, sb = b % 1024, swz = sb ^ (((sb >> 9) & 1) << 5); R = (st >> 1) * 16 + swz / 64; C = (st & 1) * 32 + (swz % 64) / 2; }
__host__ __device__ __forceinline__ int perm32(int rho) { const int n = rho >> 4, i = rho & 15; return 8 * (i >> 2) + 4 * n + (i & 3); }

struct Unit { int pm, pn; };
struct Gemm { const bf16_t* A; const bf16_t* Bt; int M, N, K; };

struct StaticOrder {
    int nM, nN, nwg, G, c;
    __host__ __device__ void init(int M, int N, int G_, int c_) { nM = M / BM; nN = N / BM; nwg = nM * nN; G = G_; c = c_; }
    __host__ __device__ bool next(int i, Unit& u) const {
        const long L = (long)i * G + c; if (L >= nwg) return false;
        int wgid = (int)L; { const int q = nwg / NXCD, r = nwg % NXCD, xcd = wgid % NXCD, off = wgid / NXCD; wgid = (xcd < r ? xcd * (q + 1) : r * (q + 1) + (xcd - r) * q) + off; }
        const int nig = WGM * nN, gid = wgid / nig, fm = gid * WGM, gsz = (nM - fm) < WGM ? (nM - fm) : WGM;
        u.pm = fm + ((wgid % nig) % gsz); u.pn = (wgid % nig) / gsz; return true;
    }
    __device__ __forceinline__ void a_ready(const Unit&) const {}
    __device__ __forceinline__ void done(const Unit&) const {}
};
__device__ __forceinline__ unsigned cvt_pk_bf16(float lo, float hi) { unsigned r; asm volatile("v_cvt_pk_bf16_f32 %0, %1, %2" : "=v"(r) : "v"(lo), "v"(hi)); return r; }
typedef float f32x2 __attribute__((ext_vector_type(2)));
typedef unsigned u32x2 __attribute__((ext_vector_type(2)));
__device__ __forceinline__ float fsigmoid(float x) { return __builtin_amdgcn_rcpf(1.0f + __builtin_amdgcn_exp2f(-1.4426950408889634f * x)); }
__device__ __forceinline__ float fsilu(float x) { return x * fsigmoid(x); }
__device__ __forceinline__ f32x4 silu4(f32x4 v) { return (f32x4){fsilu(v[0]), fsilu(v[1]), fsilu(v[2]), fsilu(v[3])}; }
__device__ __forceinline__ f32x4 sigm4(f32x4 v) { return (f32x4){fsigmoid(v[0]), fsigmoid(v[1]), fsigmoid(v[2]), fsigmoid(v[3])}; }
__device__ __forceinline__ u32x4 pack8(f32x4 a, f32x4 b) { u32x4 w; w.x = cvt_pk_bf16(a[0], a[1]); w.y = cvt_pk_bf16(a[2], a[3]); w.z = cvt_pk_bf16(b[0], b[1]); w.w = cvt_pk_bf16(b[2], b[3]); return w; }
__device__ __forceinline__ float dot4(f32x4 a) { return (a[0] * a[0] + a[1] * a[1]) + (a[2] * a[2] + a[3] * a[3]); }

constexpr int MP = 16384;
constexpr float RMS_EPS = 1e-6f;

struct EpiIn0 {
    static constexpr bool PERM = true, AFTER_DRAIN = false;
    const float* rstd; const float* qg; const float* kg;
    bf16_t *Q, *Kb, *Vb, *GA, *U, *GC;
    float *k_prompt, *v_prompt, *k_sample, *v_sample, *conv_prompt, *conv_sample;
    float* kmp;
    __device__ __forceinline__ void operator()(const f32x4 (&acc)[2][2][4][2], const Unit& u, int wr, int wc, int fr, int fq) const {
        const int pn = u.pn;
        const int rowb = u.pm * BM + wr * 64 + fr;
        const bool sample = u.pm >= 64;
        if (pn < 4) {
            const bool isk = pn >= 2;
            const float* g = isk ? kg : qg;
            f32x4 gv[2][2];
#pragma unroll
            for (int bj = 0; bj < 2; ++bj)
#pragma unroll
                for (int n = 0; n < 2; ++n) gv[bj][n] = *(const f32x4*)(g + 32 * bj + 8 * fq + 4 * n);
            const int colb = 256 * (pn & 1) + 64 * wc + 8 * fq;
            bf16_t* ob = isk ? Kb : Q;
            float* of = sample ? (k_sample - (size_t)MP * 512) : k_prompt;
#pragma unroll
            for (int ai = 0; ai < 2; ++ai) {
                f32x4 ks[2][2];
#pragma unroll
                for (int bj = 0; bj < 2; ++bj)
#pragma unroll
                    for (int n = 0; n < 2; ++n) ks[bj][n] = (f32x4){0.f, 0.f, 0.f, 0.f};
#pragma unroll
                for (int m = 0; m < 4; ++m) {
                    const int r = rowb + ai * HALF + m * 16;
                    const float rs = rstd[r];
                    f32x4 v[2][2]; float ss = 0.f;
#pragma unroll
                    for (int bj = 0; bj < 2; ++bj)
#pragma unroll
                        for (int n = 0; n < 2; ++n) { v[bj][n] = acc[ai][bj][m][n] * rs; ss += dot4(v[bj][n]); }
                    ss += __shfl_xor(ss, 16); ss += __shfl_xor(ss, 32);
                    const float inv = __builtin_amdgcn_rsqf(ss * (1.0f / 64.0f) + RMS_EPS);
#pragma unroll
                    for (int bj = 0; bj < 2; ++bj) {
                        const f32x4 o0 = v[bj][0] * inv * gv[bj][0], o1 = v[bj][1] * inv * gv[bj][1];
                        const size_t off = (size_t)r * 512 + colb + 32 * bj;
                        *(u32x4*)(ob + off) = pack8(o0, o1);
                        if (isk) { *(f32x4*)(of + off) = o0; *(f32x4*)(of + off + 4) = o1; ks[bj][0] += o0; ks[bj][1] += o1; }
                    }
                }
                if (isk && !sample) {
#pragma unroll
                    for (int bj = 0; bj < 2; ++bj)
#pragma unroll
                        for (int n = 0; n < 2; ++n) {
                            f32x4 s = ks[bj][n];
#pragma unroll
                            for (int o = 1; o < 16; o <<= 1) { s[0] += __shfl_xor(s[0], o); s[1] += __shfl_xor(s[1], o); s[2] += __shfl_xor(s[2], o); s[3] += __shfl_xor(s[3], o); }
                            if (fr == 0) *(f32x4*)(kmp + ((size_t)(u.pm * 4 + ai * 2 + wr)) * 512 + colb + 32 * bj + 4 * n) = s;
                        }
                }
            }
        } else if (pn < 6) {
            const int colb = 256 * (pn & 1) + 64 * wc + 8 * fq;
            float* of = sample ? (v_sample - (size_t)MP * 512) : v_prompt;
#pragma unroll
            for (int ai = 0; ai < 2; ++ai)
#pragma unroll
                for (int m = 0; m < 4; ++m) {
                    const int r = rowb + ai * HALF + m * 16;
                    const float rs = rstd[r];
#pragma unroll
                    for (int bj = 0; bj < 2; ++bj) {
                        const f32x4 o0 = acc[ai][bj][m][0] * rs, o1 = acc[ai][bj][m][1] * rs;
                        const size_t off = (size_t)r * 512 + colb + 32 * bj;
                        *(u32x4*)(Vb + off) = pack8(o0, o1);
                        *(f32x4*)(of + off) = o0; *(f32x4*)(of + off + 4) = o1;
                    }
                }
        } else if (pn < 8 || pn >= 12) {
            const int colb = 256 * (pn & 1) + 64 * wc + 8 * fq;
            bf16_t* ob = pn < 8 ? GA : GC;
#pragma unroll
            for (int ai = 0; ai < 2; ++ai)
#pragma unroll
                for (int m = 0; m < 4; ++m) {
                    const int r = rowb + ai * HALF + m * 16;
                    const float rs = rstd[r];
#pragma unroll
                    for (int bj = 0; bj < 2; ++bj) {
                        const f32x4 o0 = silu4(acc[ai][bj][m][0] * rs), o1 = silu4(acc[ai][bj][m][1] * rs);
                        *(u32x4*)(ob + (size_t)r * 512 + colb + 32 * bj) = pack8(o0, o1);
                    }
                }
        } else {
            const int ch0 = 128 * (pn - 8) + 32 * wc + 8 * fq;
            const bool tailp = !sample && ((u.pm & 15) == 15);
#pragma unroll
            for (int ai = 0; ai < 2; ++ai)
#pragma unroll
                for (int m = 0; m < 4; ++m) {
                    const int r = rowb + ai * HALF + m * 16;
                    const float rs = rstd[r];
                    const f32x4 o0 = (acc[ai][0][m][0] * rs) * sigm4(acc[ai][1][m][0] * rs), o1 = (acc[ai][0][m][1] * rs) * sigm4(acc[ai][1][m][1] * rs);
                    *(u32x4*)(U + (size_t)r * 512 + ch0) = pack8(o0, o1);
                    if (tailp) { const int tok = r & 4095; if (tok >= 4066) { float* d = conv_prompt + ((size_t)((r >> 12) * 30 + (tok - 4066))) * 512 + ch0; *(f32x4*)d = o0; *(f32x4*)(d + 4) = o1; } }
                    if (sample) { const int rr = r - MP; float* d = conv_sample + ((size_t)((rr >> 2) * 30 + 26 + (rr & 3))) * 512 + ch0; *(f32x4*)d = o0; *(f32x4*)(d + 4) = o1; }
                }
        }
    }
};

struct EpiOut0 {
    static constexpr bool PERM = false, AFTER_DRAIN = false;
    const float* xp; const float* xs; float* X1; bf16_t* XB1; float* SSQ;
    __device__ __forceinline__ void operator()(const f32x4 (&acc)[2][2][4][2], const Unit& u, int wr, int wc, int fr, int fq) const {
        const int rowb = u.pm * BM + wr * 64 + fr, col0 = u.pn * BM + wc * 32 + 4 * fq;
        const float* xb = u.pm >= 64 ? xs - (size_t)MP * 1024 : xp;
#pragma unroll
        for (int ai = 0; ai < 2; ++ai)
#pragma unroll
            for (int m = 0; m < 4; ++m) {
                const int r = rowb + ai * HALF + m * 16; const size_t ro = (size_t)r * 1024 + col0; float ss = 0.f;
#pragma unroll
                for (int bj = 0; bj < 2; ++bj)
#pragma unroll
                    for (int n = 0; n < 2; ++n) {
                        const size_t o_ = ro + bj * HALF + n * 16;
                        const f32x4 o = *(const f32x4*)(xb + o_) + acc[ai][bj][m][n];
                        *(f32x4*)(X1 + o_) = o; u32x2 w; w.x = cvt_pk_bf16(o[0], o[1]); w.y = cvt_pk_bf16(o[2], o[3]); *(u32x2*)(XB1 + o_) = w; ss += dot4(o);
                    }
                ss += __shfl_xor(ss, 16); ss += __shfl_xor(ss, 32);
                if (fq == 0) SSQ[(size_t)r * 16 + u.pn * 4 + wc] = ss;
            }
    }
};
struct EpiIn1 {
    static constexpr bool PERM = true, AFTER_DRAIN = false;
    const float* SSQ; const float* LB; bf16_t *QQ, *VV, *GS; float* LOGF;
    __device__ __forceinline__ void operator()(const f32x4 (&acc)[2][2][4][2], const Unit& u, int wr, int wc, int fr, int fq) const {
        const int rowb = u.pm * BM + wr * 64 + fr, type = u.pn >> 2, cl0 = (u.pn & 3) * BM + wc * 32 + 8 * fq;
#pragma unroll
        for (int ai = 0; ai < 2; ++ai)
#pragma unroll
            for (int m = 0; m < 4; ++m) {
                const int r = rowb + ai * HALF + m * 16;
                const f32x4* sp = (const f32x4*)(SSQ + (size_t)r * 16);
                const f32x4 s0 = sp[0], s1 = sp[1], s2 = sp[2], s3 = sp[3];
                const float tot = (((s0[0] + s0[1]) + (s0[2] + s0[3])) + ((s1[0] + s1[1]) + (s1[2] + s1[3]))) + (((s2[0] + s2[1]) + (s2[2] + s2[3])) + ((s3[0] + s3[1]) + (s3[2] + s3[3])));
                const float rs = __builtin_amdgcn_rsqf(tot * (1.0f / 1024.0f) + RMS_EPS);
#pragma unroll
                for (int bj = 0; bj < 2; ++bj) {
                    const f32x4 v0 = acc[ai][bj][m][0] * rs, v1 = acc[ai][bj][m][1] * rs;
                    const int c = cl0 + bj * HALF; const size_t off = (size_t)r * 1024 + c;
                    if (type == 0) *(u32x4*)(QQ + off) = pack8(silu4(v0), silu4(v1));
                    else if (type == 1) {
                        const f32x4 l0 = *(const f32x4*)(LB + c), l1 = *(const f32x4*)(LB + c + 4);
                        const f32x4 f0 = l0 + (1.0f - l0) * sigm4(v0), f1 = l1 + (1.0f - l1) * sigm4(v1);
                        *(f32x4*)(LOGF + off) = (f32x4){__logf(f0[0]), __logf(f0[1]), __logf(f0[2]), __logf(f0[3])};
                        *(f32x4*)(LOGF + off + 4) = (f32x4){__logf(f1[0]), __logf(f1[1]), __logf(f1[2]), __logf(f1[3])};
                    }
                    else if (type == 2) *(u32x4*)(VV + off) = pack8(v0, v1);
                    else *(u32x4*)(GS + off) = pack8(silu4(v0), silu4(v1));
                }
            }
    }
};
struct EpiOut1 {
    static constexpr bool PERM = false, AFTER_DRAIN = false;
    const float* X1; float* Y;
    __device__ __forceinline__ void operator()(const f32x4 (&acc)[2][2][4][2], const Unit& u, int wr, int wc, int fr, int fq) const {
        const int rowb = u.pm * BM + wr * 64 + fr, col0 = u.pn * BM + wc * 32 + 4 * fq;
#pragma unroll
        for (int ai = 0; ai < 2; ++ai)
#pragma unroll
            for (int m = 0; m < 4; ++m) {
                const size_t ro = (size_t)(rowb + ai * HALF + m * 16) * 1024 + col0;
#pragma unroll
                for (int bj = 0; bj < 2; ++bj)
#pragma unroll
                    for (int n = 0; n < 2; ++n) { const size_t o_ = ro + bj * HALF + n * 16; *(f32x4*)(Y + o_) = *(const f32x4*)(X1 + o_) + acc[ai][bj][m][n]; }
            }
    }
};
template <class Epi, class Sched, bool ALIGN_EPI = false, bool SP2 = false>
__device__ __forceinline__ void gemm_phase(PG8_LAS unsigned char* lds, const Gemm g, const Sched& S, const Epi& E) {
    const int tid = threadIdx.x, wid = __builtin_amdgcn_readfirstlane(tid >> 6), lane = tid & 63, wr = wid >> 2, wc = wid & 3, fr = lane & 15, fq = lane >> 4;
    const int K = g.K, nt = K / BK;
    unsigned voffA[2], voffB[2];
#pragma unroll
    for (int i = 0; i < 2; ++i) { int R, C; stage_rc(tid * 16 + i * 8192, R, C); const int Rb = Epi::PERM ? ((R & ~31) + perm32(R & 31)) : R;
        voffA[i] = (unsigned)(R * K + C) * 2u; voffB[i] = (unsigned)(Rb * K + C) * 2u; }
    const size_t kstep = (size_t)(BK * 2);
    const size_t hstep = (size_t)HALF * K * 2;
    const size_t tstep = 2 * hstep;
    const unsigned ldsw = (unsigned)wid * 1024u;
    const int aoff = lds_byte(wr * 64 + fr, fq * 8), boff = lds_byte(wc * 32 + fr, fq * 8);
#define PG8_SA(b, h) (((b) * 2 + (h)) * HTB)
#define PG8_SB(b, h) ((4 + (b) * 2 + (h)) * HTB)
#define PG8_STAGE(bufoff, gbase, voff) do { _Pragma("unroll") for (int _i = 0; _i < 2; ++_i) \
        __builtin_amdgcn_global_load_lds((const unsigned*)((const char*)(gbase) + (voff)[_i]), (PG8_LAS unsigned*)(lds + (bufoff) + ldsw + _i * 8192), 16, 0, 0); } while (0)
#define PG8_LDA(dst, b, h) do { _Pragma("unroll") for (int m = 0; m < 4; ++m) _Pragma("unroll") for (int k = 0; k < 2; ++k) dst[m][k] = *(const PG8_LAS bf16x8*)(lds + PG8_SA(b, h) + aoff + m * 2048 + k * 1024); } while (0)
#define PG8_LDB(dst, b, h) do { _Pragma("unroll") for (int n = 0; n < 2; ++n) _Pragma("unroll") for (int k = 0; k < 2; ++k) dst[n][k] = *(const PG8_LAS bf16x8*)(lds + PG8_SB(b, h) + boff + n * 2048 + k * 1024); } while (0)
#define PG8_MMA(ai, bj, At, Bt) do { __builtin_amdgcn_s_setprio(1); _Pragma("unroll") for (int m = 0; m < 4; ++m) _Pragma("unroll") for (int n = 0; n < 2; ++n) _Pragma("unroll") for (int k = 0; k < 2; ++k) \
        acc[ai][bj][m][n] = __builtin_amdgcn_mfma_f32_16x16x32_bf16(Bt[n][k], At[m][k], acc[ai][bj][m][n], 0, 0, 0); __builtin_amdgcn_s_setprio(0); } while (0)
#define PG8_WAIT_V(n) asm volatile("s_waitcnt vmcnt(" #n ")" ::: "memory")
#define PG8_WAIT_L(n) asm volatile("s_waitcnt lgkmcnt(" #n ")" ::: "memory")
#define PG8_BAR __builtin_amdgcn_s_barrier()
#define PG8_SCHED __builtin_amdgcn_sched_barrier(0)
    Unit cur, nxt; int ui = 0;
    if (!S.next(0, cur)) return;
    f32x4 acc[2][2][4][2];
#pragma unroll
    for (int a = 0; a < 2; ++a)
#pragma unroll
        for (int b = 0; b < 2; ++b)
#pragma unroll
            for (int m = 0; m < 4; ++m)
#pragma unroll
                for (int n = 0; n < 2; ++n) acc[a][b][m][n] = (f32x4){0.f, 0.f, 0.f, 0.f};
    bf16x8 At[4][2], B0[2][2], B1[2][2];
    const char* cA = (const char*)g.A + (size_t)cur.pm * tstep; const char* cB = (const char*)g.Bt + (size_t)cur.pn * tstep;
    S.a_ready(cur);
    if constexpr (SP2) {
        PG8_STAGE(PG8_SB(0, 0), cB, voffB); PG8_STAGE(PG8_SB(0, 1), cB + hstep, voffB); PG8_STAGE(PG8_SA(0, 0), cA, voffA); PG8_STAGE(PG8_SA(0, 1), cA + hstep, voffA);
        if (wr == 1) PG8_BAR;
        PG8_WAIT_V(2); PG8_BAR;
        PG8_STAGE(PG8_SB(1, 0), cB + kstep, voffB); PG8_STAGE(PG8_SA(1, 0), cA + kstep, voffA); PG8_STAGE(PG8_SB(1, 1), cB + hstep + kstep, voffB);
        PG8_WAIT_V(6); PG8_BAR;
    } else {
        PG8_STAGE(PG8_SB(0, 0), cB, voffB); PG8_STAGE(PG8_SA(0, 0), cA, voffA); PG8_STAGE(PG8_SB(0, 1), cB + hstep, voffB); PG8_STAGE(PG8_SA(0, 1), cA + hstep, voffA);
        if (wr == 1) PG8_BAR;
        PG8_WAIT_V(4); PG8_BAR;
        PG8_STAGE(PG8_SB(1, 0), cB + kstep, voffB); PG8_STAGE(PG8_SA(1, 0), cA + kstep, voffA); PG8_STAGE(PG8_SB(1, 1), cB + hstep + kstep, voffB);
        PG8_WAIT_V(6); PG8_BAR;
    }
    for (;;) {
        const bool has_next = S.next(ui + 1, nxt);
        const char* nA = has_next ? (const char*)g.A + (size_t)nxt.pm * tstep : cA; const char* nB = has_next ? (const char*)g.Bt + (size_t)nxt.pn * tstep : cB;
        for (int t = 0; t < nt; t += 2) {
            const bool last = (t == nt - 2);
            const char* a1 = cA + (size_t)(t + 1) * kstep;
            const char* a2 = last ? nA : cA + (size_t)(t + 2) * kstep; const char* b2 = last ? nB : cB + (size_t)(t + 2) * kstep;
            const char* a3 = a2 + kstep; const char* b3 = b2 + kstep;
            if (last && has_next) S.a_ready(nxt);
            if constexpr (SP2) {
            PG8_LDB(B0, 0, 0); PG8_LDB(B1, 0, 1); PG8_SCHED; PG8_LDA(At, 0, 0); PG8_STAGE(PG8_SA(1, 1), a1 + hstep, voffA);
            PG8_WAIT_V(8); PG8_WAIT_L(0); PG8_BAR; PG8_MMA(0, 0, At, B0); PG8_MMA(0, 1, At, B1); PG8_BAR; PG8_SCHED;
            PG8_LDA(At, 0, 1); PG8_STAGE(PG8_SB(0, 0), b2, voffB); PG8_STAGE(PG8_SB(0, 1), b2 + hstep, voffB); PG8_STAGE(PG8_SA(0, 0), a2, voffA);
            PG8_WAIT_V(8); PG8_WAIT_L(0); PG8_BAR; PG8_MMA(1, 0, At, B0); PG8_MMA(1, 1, At, B1); PG8_BAR; PG8_SCHED;
            PG8_LDB(B0, 1, 0); PG8_LDB(B1, 1, 1); PG8_SCHED; PG8_LDA(At, 1, 0); PG8_STAGE(PG8_SA(0, 1), a2 + hstep, voffA);
            PG8_WAIT_V(8); PG8_WAIT_L(0); PG8_BAR; PG8_MMA(0, 0, At, B0); PG8_MMA(0, 1, At, B1); PG8_BAR; PG8_SCHED;
            PG8_LDA(At, 1, 1); PG8_STAGE(PG8_SB(1, 0), b3, voffB); PG8_STAGE(PG8_SB(1, 1), b3 + hstep, voffB); PG8_STAGE(PG8_SA(1, 0), a3, voffA);
            PG8_WAIT_V(8); PG8_WAIT_L(0); PG8_BAR; PG8_MMA(1, 0, At, B0); PG8_MMA(1, 1, At, B1); PG8_BAR; PG8_SCHED;
            } else {
            PG8_LDB(B0, 0, 0); PG8_SCHED; PG8_LDA(At, 0, 0); PG8_STAGE(PG8_SA(1, 1), a1 + hstep, voffA);
            PG8_WAIT_L(8); PG8_BAR; PG8_WAIT_L(0); PG8_MMA(0, 0, At, B0); PG8_BAR; PG8_SCHED;
            PG8_LDB(B1, 0, 1); PG8_STAGE(PG8_SB(0, 0), b2, voffB);
            PG8_BAR; PG8_WAIT_L(0); PG8_MMA(0, 1, At, B1); PG8_BAR;
            PG8_LDA(At, 0, 1); PG8_STAGE(PG8_SA(0, 0), a2, voffA);
            PG8_BAR; PG8_WAIT_L(0); PG8_MMA(1, 0, At, B0); PG8_BAR; PG8_SCHED;
            PG8_STAGE(PG8_SB(0, 1), b2 + hstep, voffB);
            PG8_WAIT_V(6); PG8_BAR; PG8_MMA(1, 1, At, B1); PG8_BAR;
            PG8_LDB(B0, 1, 0); PG8_SCHED; PG8_LDA(At, 1, 0); PG8_STAGE(PG8_SA(0, 1), a2 + hstep, voffA);
            PG8_WAIT_L(8); PG8_BAR; PG8_WAIT_L(0); PG8_MMA(0, 0, At, B0); PG8_BAR; PG8_SCHED;
            PG8_LDB(B1, 1, 1); PG8_STAGE(PG8_SB(1, 0), b3, voffB);
            PG8_BAR; PG8_WAIT_L(0); PG8_MMA(0, 1, At, B1); PG8_BAR;
            PG8_LDA(At, 1, 1); PG8_STAGE(PG8_SA(1, 0), a3, voffA);
            PG8_BAR; PG8_WAIT_L(0); PG8_MMA(1, 0, At, B0); PG8_BAR; PG8_SCHED;
            PG8_STAGE(PG8_SB(1, 1), b3 + hstep, voffB);
            PG8_WAIT_V(6); PG8_BAR; PG8_MMA(1, 1, At, B1); PG8_BAR;
            }
        }
        if constexpr (ALIGN_EPI) { if (wr == 0) PG8_BAR; }
        if constexpr (!Epi::AFTER_DRAIN) { E(acc, cur, wr, wc, fr, fq); S.done(cur); }
        if (!has_next) break;
#pragma unroll
        for (int a = 0; a < 2; ++a)
#pragma unroll
            for (int b = 0; b < 2; ++b)
#pragma unroll
                for (int m = 0; m < 4; ++m)
#pragma unroll
                    for (int n = 0; n < 2; ++n) acc[a][b][m][n] = (f32x4){0.f, 0.f, 0.f, 0.f};
        cur = nxt; cA = nA; cB = nB; ++ui;
        if constexpr (ALIGN_EPI) { if (wr == 1) PG8_BAR; }
    }
    PG8_WAIT_V(0);
    if constexpr (!ALIGN_EPI) { if (wr == 0) PG8_BAR; }
    PG8_BAR;
    if constexpr (Epi::AFTER_DRAIN) { E.fused(acc, cur, wr, wc, fr, fq, lds, wid, lane); S.done(cur); }
#undef PG8_SA
#undef PG8_SB
#undef PG8_STAGE
#undef PG8_LDA
#undef PG8_LDB
#undef PG8_MMA
#undef PG8_WAIT_V
#undef PG8_WAIT_L
#undef PG8_BAR
#undef PG8_SCHED
}
}

constexpr int NWAVES = 8;
constexpr int D = 1024, MPROMPT = 16384, MSAMPLE = 512, MTOT = MPROMPT + MSAMPLE;
constexpr int SEQ = 4096, NB = 4, NDEC = 128, TDEC = 4;
constexpr int N0 = 3584, N1 = 4096;
constexpr size_t MiB = 1u << 20;
constexpr size_t WS_CTL = 0, CTL_ZERO_BYTES = 1 * MiB;
constexpr size_t WS_W0T = 2 * MiB, WS_WO0T = 10 * MiB, WS_W1T = 12 * MiB, WS_WO1T = 20 * MiB;
constexpr size_t WS_RSTD0 = 22 * MiB, WS_LB = 23 * MiB, WS_KMP = 24 * MiB, WS_SSQ = 26 * MiB;
constexpr size_t WS_XB = 64 * MiB, WS_Q = 128 * MiB, WS_K = 160 * MiB, WS_V = 192 * MiB, WS_GA = 224 * MiB, WS_U = 256 * MiB, WS_GC = 288 * MiB;
constexpr size_t WS_M0 = 320 * MiB, WS_X1 = 384 * MiB, WS_XB1 = 464 * MiB, WS_QQ = 512 * MiB, WS_LOGF = 576 * MiB, WS_VV = 656 * MiB, WS_GS = 704 * MiB;
constexpr size_t WS_M1 = 752 * MiB, WS_OLOC = 800 * MiB, WS_QBS = 880 * MiB, WS_USEG = 928 * MiB, WS_DSEG = 952 * MiB, WS_SC = 960 * MiB, WS_KMS = 1000 * MiB, WS_END = 1024 * MiB;
constexpr size_t WS_STAMP = 1010 * MiB;
constexpr int CW_BAR = 4096, CW_RDY = 16384;
constexpr int RING_BYTES = 131072, LDSCTL_OFF = RING_BYTES, MISC_OFF = LDSCTL_OFF + 320, LDS_BYTES = 147456;

#define GAS __attribute__((address_space(1)))
#define LAS __attribute__((address_space(3)))
typedef unsigned short bf16;
typedef unsigned v4u __attribute__((ext_vector_type(4)));
typedef float f32x4 __attribute__((ext_vector_type(4)));
typedef short bf16x8 __attribute__((ext_vector_type(8)));
#define LDS_WAIT() asm volatile("s_waitcnt lgkmcnt(0)" ::: "memory")
#define VM_WAIT() asm volatile("s_waitcnt vmcnt(0)" ::: "memory")
__device__ __forceinline__ unsigned f2bf(float f) { unsigned u = __builtin_bit_cast(unsigned, f); return (u + 0x7fffu + ((u >> 16) & 1u)) >> 16; }
__device__ __forceinline__ unsigned pk2(float lo, float hi) { return f2bf(lo) | (f2bf(hi) << 16); }
__device__ __forceinline__ float bf2f(unsigned short b) { return __builtin_bit_cast(float, ((unsigned)b) << 16); }
__device__ __forceinline__ float wave_sum(float v) {
#pragma unroll
    for (int o = 1; o < 64; o <<= 1) v += __shfl_xor(v, o);
    return v;
}
#define XB_TMO      128
#define XB_XCNT(j)  (256  + 64 * (j))
#define XB_XSUB(j)  (1280 + 64 * (j))
#define XB_XGEN(j)  (2304 + 64 * (j))
#define XB_TOP      3328
#define XB_TOPGEN   3392
#define XCD_BAR_WORDS 3456
#define XB_SPIN_CAP (1u << 18)
#define LAS __attribute__((address_space(3)))

__device__ __forceinline__ unsigned xb_ld(unsigned* p)              { return __hip_atomic_load(p, __ATOMIC_RELAXED, __HIP_MEMORY_SCOPE_AGENT); }
__device__ __forceinline__ unsigned xb_add(unsigned* p, unsigned v) { return __hip_atomic_fetch_add(p, v, __ATOMIC_RELAXED, __HIP_MEMORY_SCOPE_AGENT); }
__device__ __forceinline__ unsigned xb_xcc_id() { return (unsigned)__builtin_amdgcn_s_getreg((3 << 11) | 20) & 0xFu; }
#define XB_SPIN(cond, bar) do { unsigned _sp = 0; while (cond) { __builtin_amdgcn_s_sleep(1); \
    if ((++_sp & 255u) == 0u) { if (xb_ld(&(bar)[XB_TMO])) break; if (_sp > XB_SPIN_CAP) { atomicAdd(&(bar)[XB_TMO], 1u); break; } } } } while (0)

struct XcdBarrier {
    unsigned* bar; unsigned x;
    volatile LAS unsigned* st;
};

__device__ __forceinline__ XcdBarrier xcd_barrier_post(unsigned* bar, volatile LAS unsigned* st) {
    XcdBarrier b; b.bar = bar; b.x = xb_xcc_id(); b.st = st;
    if (threadIdx.x == 0) (void)xb_add(&bar[XB_XCNT(b.x)], 1u);
    return b;
}
__device__ __forceinline__ void xcd_barrier_complete(unsigned* bar, unsigned x, unsigned& nloc, unsigned& nx) {
    const unsigned G = gridDim.x * gridDim.y * gridDim.z;
    unsigned sum, cnt, mine, sp = 0u;
    for (;;) {
        sum = 0u; cnt = 0u; mine = 0u;
#pragma unroll
        for (unsigned j = 0; j < 16; ++j) { const unsigned c = xb_ld(&bar[XB_XCNT(j)]); sum += c; cnt += (c > 0u) ? 1u : 0u; mine = (j == x) ? c : mine; }
        if (sum == G) break;
        __builtin_amdgcn_s_sleep(1);
        if ((++sp & 255u) == 0u) { if (xb_ld(&bar[XB_TMO])) break; if (sp > XB_SPIN_CAP) { atomicAdd(&bar[XB_TMO], 1u); break; } }
    }
    nloc = mine > 0u ? mine : 1u; nx = cnt > 0u ? cnt : 1u;
}

__device__ __forceinline__ void xcd_barrier(const XcdBarrier& b) {
    asm volatile("s_waitcnt vmcnt(0)" ::: "memory");
    __syncthreads();
    if (threadIdx.x == 0) {
        unsigned* bar = b.bar;
        __builtin_amdgcn_s_waitcnt(0);
        unsigned nloc = b.st[0], nx = b.st[1];
        if (nloc == 0u) { xcd_barrier_complete(bar, b.x, nloc, nx); b.st[0] = nloc; b.st[1] = nx; }
        const unsigned old = xb_add(&bar[XB_XSUB(b.x)], 1u);
        const unsigned gen = old / nloc;
        if (old + 1u == (gen + 1u) * nloc) {
            __builtin_amdgcn_fence(__ATOMIC_RELEASE, "agent");
            asm volatile("s_waitcnt vmcnt(0)" ::: "memory");
            const unsigned og = xb_add(&bar[XB_TOP], 1u);
            const unsigned tg = og / nx;
            if (og + 1u == (tg + 1u) * nx) xb_add(&bar[XB_TOPGEN], 1u);
            else XB_SPIN(xb_ld(&bar[XB_TOPGEN]) == tg, bar);
            __builtin_amdgcn_fence(__ATOMIC_ACQUIRE, "agent");
            xb_add(&bar[XB_XGEN(b.x)], 1u);
            asm volatile("s_waitcnt vmcnt(0)" ::: "memory");
        } else {
            XB_SPIN(xb_ld(&bar[XB_XGEN(b.x)]) == gen, bar);
            __builtin_amdgcn_fence(__ATOMIC_ACQUIRE, "agent");
            asm volatile("s_waitcnt vmcnt(0)" ::: "memory");
        }
    }
    __syncthreads();
}

constexpr size_t O_Y = 0, O_KP = 17301504, O_VP = O_KP + 8388608, O_KS = O_VP + 8388608, O_VS = O_KS + 262144, O_CP = O_VS + 262144, O_CS = O_CP + 61440, O_HP = O_CS + 1966080, O_HS = O_HP + 524288, O_END = O_HS + 16777216;
enum { I_XP = 0, I_XS, I_CK, I_CV, I_SCONV, I_SHGRN, I_PT, I_NORM0, I_WIN0, I_QN, I_KN, I_CW, I_CB, I_LNG, I_LNB, I_WOUT0, I_NORM1, I_WIN1, I_LBL, I_ONORM, I_WOUT1, N_IN };
struct Args { const void* in[N_IN]; float* out; unsigned char* ws; };

__device__ __forceinline__ void p0_transpose_item(const float* W, int K, int N, bf16* WT, int k0, int n0, int drow0, const float* gain, LAS float* scr, int lane) {
#pragma unroll
    for (int i = 0; i < 8; ++i) { const int kk = (lane >> 3) + 8 * i, n4 = (lane & 7) * 4; const float gsc = gain ? gain[k0 + kk] : 1.0f;
        const f32x4 w = *(const f32x4*)(W + (size_t)(k0 + kk) * N + n0 + n4);
        scr[kk * 33 + n4] = w[0] * gsc; scr[kk * 33 + n4 + 1] = w[1] * gsc; scr[kk * 33 + n4 + 2] = w[2] * gsc; scr[kk * 33 + n4 + 3] = w[3] * gsc; }
    LDS_WAIT(); asm volatile("" ::: "memory");
    const int c = lane & 7;
#pragma unroll
    for (int j = 0; j < 4; ++j) { const int n = (lane >> 3) + 8 * j; const LAS float* s = scr + (8 * c) * 33 + n;
        v4u o; o.x = pk2(s[0 * 33], s[1 * 33]); o.y = pk2(s[2 * 33], s[3 * 33]); o.z = pk2(s[4 * 33], s[5 * 33]); o.w = pk2(s[6 * 33], s[7 * 33]);
        *(GAS v4u*)(WT + (size_t)(drow0 + n) * K + k0 + 8 * c) = o; }
    LDS_WAIT(); asm volatile("" ::: "memory");
}
__device__ __forceinline__ int l0_src_group(int dg) {
    const int pnD = dg >> 3, gi = dg & 7, bj = gi >> 2, wc = gi & 3;
    if (pnD >= 8 && pnD < 12) return (bj ? 80 : 64) + 4 * (pnD - 8) + wc;
    return 8 * pnD + 2 * wc + bj;
}


__device__ __forceinline__ void conv_phase(LAS unsigned char* lds, int vcu, int G, const bf16* U, const bf16* GCs, const float* state_conv,
                                           const float* cw, const float* cb, const float* lng, const float* lnb, bf16* M0) {
    const int tid = threadIdx.x, c = tid, wave = tid >> 6, lane = tid & 63;
    LAS float* Y = (LAS float*)lds;
    LAS float* ST = (LAS float*)(lds + 32768);
    float w[31];
#pragma unroll
    for (int i = 0; i < 31; ++i) w[i] = cw[i * 512 + c];
    const float bias = cb[c], gg = lng[c], be = lnb[c];
    for (int unit = vcu; unit < 1056; unit += G) {
        float y[16];
        if (unit < 1024) {
            const int r0 = unit * 16, tok0 = r0 & 4095;
            float uw[46];
#pragma unroll
            for (int i = 0; i < 46; ++i) { const int tt = tok0 - 30 + i; uw[i] = tt >= 0 ? bf2f(U[(size_t)(r0 - 30 + i) * 512 + c]) : 0.f; }
#pragma unroll
            for (int t = 0; t < 16; ++t) { float a = bias;
#pragma unroll
                for (int i = 0; i < 31; ++i) a += w[i] * uw[t + i];
                y[t] = a; }
        } else {
            const int s0 = (unit - 1024) * 4;
#pragma unroll
            for (int sq = 0; sq < 4; ++sq) { const int n = s0 + sq; float uw[34];
#pragma unroll
                for (int i = 0; i < 30; ++i) uw[i] = state_conv[((size_t)n * 30 + i) * 512 + c];
#pragma unroll
                for (int i = 0; i < 4; ++i) uw[30 + i] = bf2f(U[(size_t)(MPROMPT + n * 4 + i) * 512 + c]);
#pragma unroll
                for (int t = 0; t < 4; ++t) { float a = bias;
#pragma unroll
                    for (int i = 0; i < 31; ++i) a += w[i] * uw[t + i];
                    y[sq * 4 + t] = a; } }
        }
#pragma unroll
        for (int t = 0; t < 16; ++t) Y[t * 512 + c] = y[t];
        __syncthreads();
#pragma unroll
        for (int k = 0; k < 2; ++k) { const int t = 2 * wave + k; float v[8]; float s = 0.f;
#pragma unroll
            for (int j = 0; j < 8; ++j) { v[j] = Y[t * 512 + lane + 64 * j]; s += v[j]; }
            const float mean = wave_sum(s) * (1.0f / 512.0f); float q = 0.f;
#pragma unroll
            for (int j = 0; j < 8; ++j) { const float d = v[j] - mean; q += d * d; }
            const float var = wave_sum(q) * (1.0f / 512.0f);
            if (lane == 0) { ST[2 * t] = mean; ST[2 * t + 1] = 1.0f / sqrtf(var + 1e-6f); } }
        __syncthreads();
        const int rbase = unit < 1024 ? unit * 16 : MPROMPT + (unit - 1024) * 16;
#pragma unroll
        for (int t = 0; t < 16; ++t) { const float ln = (y[t] - ST[2 * t]) * ST[2 * t + 1] * gg + be; const float oc = pg8::fsilu(ln); const size_t r = (size_t)(rbase + t);
            M0[r * 1024 + 512 + c] = (bf16)f2bf(oc * bf2f(GCs[r * 512 + c])); }
        __syncthreads();
    }
}


typedef unsigned u32x4_t __attribute__((ext_vector_type(4)));
typedef unsigned u32x2_t __attribute__((ext_vector_type(2)));
__device__ __forceinline__ float fexp(float x) { return __builtin_amdgcn_exp2f(x * 1.4426950408889634f); }
__device__ __forceinline__ bf16x8 mk_frag(u32x2_t a, u32x2_t b) { u32x4_t w; w.x = a.x; w.y = a.y; w.z = b.x; w.w = b.y; return __builtin_bit_cast(bf16x8, w); }
__device__ __forceinline__ unsigned cvtpk(float lo, float hi) { return pg8::cvt_pk_bf16(lo, hi); }
typedef float f32x2_t __attribute__((ext_vector_type(2))); typedef __bf16 bf16x2_t __attribute__((ext_vector_type(2)));
__device__ __forceinline__ unsigned cvtpk_nv(float lo, float hi) { f32x2_t v = {lo, hi}; bf16x2_t b = __builtin_convertvector(v, bf16x2_t); return __builtin_bit_cast(unsigned, b); }
constexpr int P1_QB = 0, P1_QT = 17408, P1_QTS = 34816, P1_KD = 47872, P1_KE = 65280, P1_KLT = 78336, P1_VT = 96768, P1_AB = 115200, P1_TOT = 124416, P1_DV = 126464;
constexpr int RP = 272, RS = 144;

__device__ __forceinline__ void scan_a_block(LAS unsigned char* lds, int aoff, int boff, int I, int J, bool diag, int lane) {
    const int l15 = lane & 15, g4 = lane >> 4;
    f32x4 acc = (f32x4){0.f, 0.f, 0.f, 0.f};
#pragma unroll
    for (int ks = 0; ks < 4; ++ks) {
        const bf16x8 a = *(const LAS bf16x8*)(lds + aoff + l15 * RP + (32 * ks + 8 * g4) * 2);
        const bf16x8 b = *(const LAS bf16x8*)(lds + boff + l15 * RP + (32 * ks + 8 * g4) * 2);
        acc = __builtin_amdgcn_mfma_f32_16x16x32_bf16(a, b, acc, 0, 0, 0);
    }
#pragma unroll
    for (int r = 0; r < 4; ++r) { const int t = 4 * g4 + r; const float v = (diag && l15 > t) ? 0.f : acc[r];
        *(LAS unsigned short*)(lds + P1_AB + (16 * I + t) * RS + (16 * J + l15) * 2) = (unsigned short)f2bf(v); }
}

__device__ __forceinline__ void scan_pass1(LAS unsigned char* lds, int vcu, int G, const bf16* QQ, const float* LOGF, const bf16* VV, float* OLOC, bf16* QBS, float* USEG, float* DSEG) {
    const int tid = threadIdx.x, lane = tid & 63, wave = __builtin_amdgcn_readfirstlane(tid >> 6), l15 = lane & 15, g4 = lane >> 4;
    const int k = tid & 127, I = __builtin_amdgcn_readfirstlane(tid >> 7);
    LAS float* TOT = (LAS float*)(lds + P1_TOT); LAS float* DV = (LAS float*)(lds + P1_DV);
    for (int unit = vcu; unit < 256; unit += G) {
        const int b = unit >> 6, h = (unit >> 3) & 7, g = unit & 7;
        for (int i = tid; i < 64 * RS / 4; i += 512) ((LAS unsigned*)(lds + P1_AB))[i] = 0u;
        f32x4 S[8];
#pragma unroll
        for (int kt = 0; kt < 8; ++kt) S[kt] = (f32x4){0.f, 0.f, 0.f, 0.f};
        float Bprev = 0.f;
        __syncthreads();
        for (int ch = 0; ch < 8; ++ch) {
            const size_t row0 = (size_t)b * 4096 + g * 512 + ch * 64;
            float lf[16], c[16]; unsigned short qv[16], vvv[16];
#pragma unroll
            for (int i = 0; i < 16; ++i) { const size_t o = (row0 + 16 * I + i) * 1024 + h * 128 + k; lf[i] = LOGF[o]; qv[i] = QQ[o]; vvv[i] = VV[o]; }
            { u32x4_t w0, w1;
              w0.x = vvv[0] | ((unsigned)vvv[1] << 16); w0.y = vvv[2] | ((unsigned)vvv[3] << 16); w0.z = vvv[4] | ((unsigned)vvv[5] << 16); w0.w = vvv[6] | ((unsigned)vvv[7] << 16);
              w1.x = vvv[8] | ((unsigned)vvv[9] << 16); w1.y = vvv[10] | ((unsigned)vvv[11] << 16); w1.z = vvv[12] | ((unsigned)vvv[13] << 16); w1.w = vvv[14] | ((unsigned)vvv[15] << 16);
              *(LAS u32x4_t*)(lds + P1_VT + k * RS + I * 32) = w0; *(LAS u32x4_t*)(lds + P1_VT + k * RS + I * 32 + 16) = w1; }
            c[0] = lf[0];
#pragma unroll
            for (int i = 1; i < 16; ++i) c[i] = c[i - 1] + lf[i];
            TOT[I * 128 + k] = c[15];
            __syncthreads();
            const float t0 = TOT[k], t1 = TOT[128 + k], t2 = TOT[256 + k], t3 = TOT[384 + k];
            const float rI = I == 0 ? 0.f : (I == 1 ? t0 : (I == 2 ? t0 + t1 : (t0 + t1) + t2));
            const float totI = I == 0 ? t0 : (I == 1 ? t1 : (I == 2 ? t2 : t3));
            const float btot = (t0 + t1) + (t2 + t3);
            const float e_rI = fexp(rI), e_prev = fexp(Bprev), e_klt = fexp(btot - rI - totI);
            const float sc1 = I == 2 ? fexp(t1) : fexp(t2), sc2 = fexp(t2 + t1);
            unsigned kl2[8];
#pragma unroll
            for (int i = 0; i < 16; ++i) {
                const int t = 16 * I + i;
                const float q = bf2f(qv[i]);
                const float qt = q * fexp(c[i]), qb = qt * e_rI;
                const float kk = 1.0f - fexp(lf[i]);
                const float kd = kk * fexp(fminf(-c[i], 80.f)), ke = kk * fexp(totI - c[i]), kl = ke * e_klt;
                *(LAS unsigned short*)(lds + P1_QB + t * RP + k * 2) = (unsigned short)f2bf(qb);
                *(LAS unsigned short*)(lds + P1_QT + t * RP + k * 2) = (unsigned short)f2bf(qt);
                *(LAS unsigned short*)(lds + P1_KD + t * RP + k * 2) = (unsigned short)f2bf(kd);
                if (I < 3) *(LAS unsigned short*)(lds + P1_KE + t * RP + k * 2) = (unsigned short)f2bf(ke);
                if (I == 2) *(LAS unsigned short*)(lds + P1_QTS + i * RP + k * 2) = (unsigned short)f2bf(qt * sc1);
                if (I == 3) { *(LAS unsigned short*)(lds + P1_QTS + (16 + i) * RP + k * 2) = (unsigned short)f2bf(qt * sc1); *(LAS unsigned short*)(lds + P1_QTS + (32 + i) * RP + k * 2) = (unsigned short)f2bf(qt * sc2); }
                QBS[(row0 + t) * 1024 + h * 128 + k] = (bf16)f2bf(qb * e_prev);
                if (i & 1) kl2[i >> 1] |= f2bf(kl) << 16; else kl2[i >> 1] = f2bf(kl);
            }
            { u32x4_t w0, w1; w0.x = kl2[0]; w0.y = kl2[1]; w0.z = kl2[2]; w0.w = kl2[3]; w1.x = kl2[4]; w1.y = kl2[5]; w1.z = kl2[6]; w1.w = kl2[7];
              *(LAS u32x4_t*)(lds + P1_KLT + k * RS + I * 32) = w0; *(LAS u32x4_t*)(lds + P1_KLT + k * RS + I * 32 + 16) = w1; }
            if (I == 0) DV[k] = fexp(btot);
            Bprev += btot;
            __syncthreads();
            if (wave < 4) scan_a_block(lds, P1_QT + 16 * wave * RP, P1_KD + 16 * wave * RP, wave, wave, true, lane);
            else if (wave < 7) scan_a_block(lds, P1_QT + 16 * (wave - 3) * RP, P1_KE + 16 * (wave - 4) * RP, wave - 3, wave - 4, false, lane);
            else scan_a_block(lds, P1_QTS, P1_KE, 2, 0, false, lane);
            if (wave == 0) scan_a_block(lds, P1_QTS + 16 * RP, P1_KE + 16 * RP, 3, 1, false, lane);
            if (wave == 1) scan_a_block(lds, P1_QTS + 32 * RP, P1_KE, 3, 0, false, lane);
            __syncthreads();
            {
                bf16x8 vfr[2];
#pragma unroll
                for (int ss = 0; ss < 2; ++ss) vfr[ss] = *(const LAS bf16x8*)(lds + P1_VT + (16 * wave + l15) * RS + (32 * ss + 8 * g4) * 2);
                bf16x8 sfr[4];
#pragma unroll
                for (int ks = 0; ks < 4; ++ks) { u32x4_t w; w.x = cvtpk(S[2 * ks][0], S[2 * ks][1]); w.y = cvtpk(S[2 * ks][2], S[2 * ks][3]); w.z = cvtpk(S[2 * ks + 1][0], S[2 * ks + 1][1]); w.w = cvtpk(S[2 * ks + 1][2], S[2 * ks + 1][3]); sfr[ks] = __builtin_bit_cast(bf16x8, w); }
#pragma unroll
                for (int ti = 0; ti < 4; ++ti) {
                    f32x4 o = (f32x4){0.f, 0.f, 0.f, 0.f};
#pragma unroll
                    for (int ks = 0; ks < 4; ++ks) {
                        const u32x2_t a0 = *(const LAS u32x2_t*)(lds + P1_QB + (16 * ti + l15) * RP + (32 * ks + 4 * g4) * 2);
                        const u32x2_t a1 = *(const LAS u32x2_t*)(lds + P1_QB + (16 * ti + l15) * RP + (32 * ks + 16 + 4 * g4) * 2);
                        o = __builtin_amdgcn_mfma_f32_16x16x32_bf16(sfr[ks], mk_frag(a0, a1), o, 0, 0, 0);
                    }
#pragma unroll
                    for (int ss = 0; ss < 2; ++ss) {
                        const bf16x8 a = *(const LAS bf16x8*)(lds + P1_AB + (16 * ti + l15) * RS + (32 * ss + 8 * g4) * 2);
                        o = __builtin_amdgcn_mfma_f32_16x16x32_bf16(vfr[ss], a, o, 0, 0, 0);
                    }
                    *(f32x4*)(OLOC + (row0 + 16 * ti + l15) * 1024 + h * 128 + 16 * wave + 4 * g4) = o;
                }
#pragma unroll
                for (int kt = 0; kt < 8; ++kt) {
                    const f32x4 dv = *(const LAS f32x4*)(lds + P1_DV + (16 * kt + 4 * g4) * 4);
                    S[kt] = S[kt] * dv;
#pragma unroll
                    for (int ss = 0; ss < 2; ++ss) {
                        const bf16x8 a = *(const LAS bf16x8*)(lds + P1_KLT + (16 * kt + l15) * RS + (32 * ss + 8 * g4) * 2);
                        S[kt] = __builtin_amdgcn_mfma_f32_16x16x32_bf16(a, vfr[ss], S[kt], 0, 0, 0);
                    }
                }
            }
            __syncthreads();
        }
#pragma unroll
        for (int kt = 0; kt < 8; ++kt)
#pragma unroll
            for (int r = 0; r < 4; ++r) USEG[((size_t)unit * 128 + 16 * kt + 4 * g4 + r) * 128 + 16 * wave + l15] = S[kt][r];
        if (I == 0) DSEG[unit * 128 + k] = fexp(Bprev);
    }
}

__device__ __forceinline__ void scan_sample(LAS unsigned char* lds, int vcu, int G, const bf16* QQ, const float* LOGF, const bf16* VV, const bf16* GS, const float* og,
                                            const float* S0, float* Sout, bf16* M1) {
    const int tid = threadIdx.x, lane = tid & 63, wave = tid >> 6, v = tid & 127, kq = tid >> 7;
    LAS float* FS = (LAS float*)lds; LAS float* QS = FS + 512; LAS float* VS = QS + 512; LAS float* PART = VS + 512; LAS float* RED = PART + 2048;
    for (int su = vcu; su < 1024; su += G) {
        const int n = su >> 3, h = su & 7;
        float S[32];
        const float* s0 = S0 + (((size_t)(n * 8 + h)) * 128 + kq * 32) * 128 + v;
#pragma unroll
        for (int i = 0; i < 32; ++i) S[i] = s0[(size_t)i * 128];
        { const size_t o = (size_t)(MPROMPT + n * 4 + kq) * 1024 + h * 128 + v; FS[kq * 128 + v] = fexp(LOGF[o]); QS[kq * 128 + v] = bf2f(QQ[o]); VS[kq * 128 + v] = bf2f(VV[o]); }
        __syncthreads();
        float po[4];
#pragma unroll
        for (int t = 0; t < 4; ++t) { const float vv = VS[t * 128 + v]; float p = 0.f;
#pragma unroll
            for (int i = 0; i < 32; ++i) { const int kk = kq * 32 + i; const float f = FS[t * 128 + kk]; S[i] = f * S[i] + (1.0f - f) * vv; p += QS[t * 128 + kk] * S[i]; }
            po[t] = p; }
#pragma unroll
        for (int t = 0; t < 4; ++t) PART[(kq * 4 + t) * 128 + v] = po[t];
        float* so = Sout + (((size_t)(n * 8 + h)) * 128 + kq * 32) * 128 + v;
#pragma unroll
        for (int i = 0; i < 32; ++i) so[(size_t)i * 128] = S[i];
        __syncthreads();
        const int t = kq;
        const float o = (PART[(0 * 4 + t) * 128 + v] + PART[(1 * 4 + t) * 128 + v]) + (PART[(2 * 4 + t) * 128 + v] + PART[(3 * 4 + t) * 128 + v]);
        const float ss = wave_sum(o * o);
        if (lane == 0) RED[wave] = ss;
        __syncthreads();
        const float rs = __builtin_amdgcn_rsqf((RED[2 * t] + RED[2 * t + 1]) * (1.0f / 128.0f) + 1e-6f);
        const size_t ro = (size_t)(MPROMPT + n * 4 + t) * 1024 + h * 128 + v;
        M1[ro] = (bf16)f2bf(o * rs * og[v] * bf2f(GS[ro]));
        __syncthreads();
    }
}

constexpr int P3_SIN = 0;
__device__ __forceinline__ void scan_pass3(LAS unsigned char* lds, int vcu, int G, const bf16* QBS, const float* OLOC, const float* USEG, const float* DSEG, const bf16* GS, const float* og,
                                           bf16* M1, float* hgrn_prompt) {
    const int tid = threadIdx.x, lane = tid & 63, wave = __builtin_amdgcn_readfirstlane(tid >> 6), l15 = lane & 15, g4 = lane >> 4, v = tid & 127, kq = tid >> 7;
    for (int u3 = vcu; u3 < 512; u3 += G) {
        const int half = u3 & 1, g = (u3 >> 1) & 7, h = (u3 >> 4) & 7, b = u3 >> 7, bh = b * 8 + h;
        float S[32];
#pragma unroll
        for (int i = 0; i < 32; ++i) S[i] = 0.f;
        for (int gp = 0; gp < g; ++gp) {
            const float* U = USEG + (((size_t)(bh * 8 + gp)) * 128 + kq * 32) * 128 + v; const float* Dg = DSEG + (bh * 8 + gp) * 128 + kq * 32;
#pragma unroll
            for (int i = 0; i < 32; ++i) S[i] = Dg[i] * S[i] + U[(size_t)i * 128];
        }
        if (g == 7 && half == 0) {
            const float* U = USEG + (((size_t)(bh * 8 + 7)) * 128 + kq * 32) * 128 + v; const float* Dg = DSEG + (bh * 8 + 7) * 128 + kq * 32;
            float* hp = hgrn_prompt + (((size_t)bh) * 128 + kq * 32) * 128 + v;
#pragma unroll
            for (int i = 0; i < 32; ++i) hp[(size_t)i * 128] = Dg[i] * S[i] + U[(size_t)i * 128];
        }
#pragma unroll
        for (int j = 0; j < 4; ++j) { u32x4_t w; w.x = cvtpk(S[8 * j], S[8 * j + 1]); w.y = cvtpk(S[8 * j + 2], S[8 * j + 3]); w.z = cvtpk(S[8 * j + 4], S[8 * j + 5]); w.w = cvtpk(S[8 * j + 6], S[8 * j + 7]);
            *(LAS u32x4_t*)(lds + P3_SIN + v * RP + (kq * 32 + 8 * j) * 2) = w; }
        __syncthreads();
        const size_t rbase = (size_t)b * 4096 + g * 512 + half * 256 + 32 * wave;
        f32x4 acc[2][8];
#pragma unroll
        for (int ti = 0; ti < 2; ++ti)
#pragma unroll
            for (int vt = 0; vt < 8; ++vt) acc[ti][vt] = (f32x4){0.f, 0.f, 0.f, 0.f};
        if (g > 0) {
#pragma unroll
            for (int ks = 0; ks < 4; ++ks) {
                bf16x8 afr[2];
#pragma unroll
                for (int ti = 0; ti < 2; ++ti) afr[ti] = *(const bf16x8*)(QBS + (rbase + 16 * ti + l15) * 1024 + h * 128 + 32 * ks + 8 * g4);
#pragma unroll
                for (int vt = 0; vt < 8; ++vt) { const bf16x8 bfr = *(const LAS bf16x8*)(lds + P3_SIN + (16 * vt + l15) * RP + (32 * ks + 8 * g4) * 2);
#pragma unroll
                    for (int ti = 0; ti < 2; ++ti) acc[ti][vt] = __builtin_amdgcn_mfma_f32_16x16x32_bf16(bfr, afr[ti], acc[ti][vt], 0, 0, 0); }
            }
        }
        f32x4 ogv[8];
#pragma unroll
        for (int vt = 0; vt < 8; ++vt) ogv[vt] = *(const f32x4*)(og + 16 * vt + 4 * g4);
#pragma unroll
        for (int ti = 0; ti < 2; ++ti) {
            const size_t ro = (rbase + 16 * ti + l15) * 1024 + h * 128 + 4 * g4;
            float ss = 0.f;
#pragma unroll
            for (int vt = 0; vt < 8; ++vt) { acc[ti][vt] += *(const f32x4*)(OLOC + ro + 16 * vt); ss += pg8::dot4(acc[ti][vt]); }
            ss += __shfl_xor(ss, 16); ss += __shfl_xor(ss, 32);
            const float rs = __builtin_amdgcn_rsqf(ss * (1.0f / 128.0f) + 1e-6f);
#pragma unroll
            for (int vt = 0; vt < 8; ++vt) {
                const u32x2_t gw = *(const u32x2_t*)(GS + ro + 16 * vt);
                const f32x4 gsv = (f32x4){__builtin_bit_cast(float, gw.x << 16), __builtin_bit_cast(float, gw.x & 0xffff0000u), __builtin_bit_cast(float, gw.y << 16), __builtin_bit_cast(float, gw.y & 0xffff0000u)};
                const f32x4 r4 = acc[ti][vt] * rs * ogv[vt] * gsv;
                u32x2_t w; w.x = cvtpk_nv(r4[0], r4[1]); w.y = cvtpk_nv(r4[2], r4[3]);
                *(u32x2_t*)(M1 + ro + 16 * vt) = w;
            }
        }
        __syncthreads();
    }
}


typedef float f32x16 __attribute__((ext_vector_type(16)));
typedef short v4i16_t __attribute__((ext_vector_type(4)));
constexpr int AT_KV = 0;
constexpr int AT_PITCH = 144, AT_TILE = 64 * AT_PITCH, AT_BUF = 2 * AT_TILE;
constexpr int AT_KM = 2 * AT_BUF;
constexpr int AT_WS = AT_KM + 4096;
constexpr float SM_C = 0.125f * 1.4426950408889634f;
__device__ __forceinline__ int crow(int r, int hi) { return (r & 3) + 8 * (r >> 2) + 4 * hi; }


struct StreamA {
    const bf16* Qb; const float* cache_k; const int* pt; float* SC; float* KMS;
    int vcu, G, h, rowi, kq;
    int s, nsteps;
    f32x4 ld[4]; f32x4 ks[2][2]; bf16x8 qfr[2]; int pg0, pg1; float* scb; int cn, cblk;
    __device__ __forceinline__ void init(const bf16* Qb_, const float* ck, const int* pt_, float* SC_, float* KMS_, int vcu_, int G_, int lane, int wave) {
        Qb = Qb_; cache_k = ck; pt = pt_; SC = SC_; KMS = KMS_; vcu = vcu_; G = G_; h = wave; rowi = lane & 15; kq = lane >> 4;
        s = 0; const int nun = vcu < 1024 ? (1024 - vcu + G - 1) / G : 0; nsteps = nun * 16;
        if (nsteps) { setup(); issue(); }
    }
    __device__ __forceinline__ void setup() {
        const int unit = vcu + (s >> 4) * G; cn = unit >> 3; cblk = unit & 7;
#pragma unroll
        for (int q = 0; q < 2; ++q) { u32x4_t w = (u32x4_t){0u, 0u, 0u, 0u}; if (rowi < 4) w = *(const u32x4_t*)(Qb + (size_t)(MPROMPT + cn * 4 + rowi) * 512 + h * 64 + 32 * q + 8 * kq); qfr[q] = __builtin_bit_cast(bf16x8, w); }
        pg0 = pt[cn * 16 + cblk * 2]; pg1 = pt[cn * 16 + cblk * 2 + 1];
#pragma unroll
        for (int q = 0; q < 2; ++q) { ks[q][0] = (f32x4){0.f, 0.f, 0.f, 0.f}; ks[q][1] = (f32x4){0.f, 0.f, 0.f, 0.f}; }
        scb = SC + (((size_t)cn * 8 + h) * 4 + rowi) * 2048 + cblk * 256 + 4 * kq;
    }
    __device__ __forceinline__ void issue() {
        const int rg = s & 15; const int page = rg < 8 ? pg0 : pg1;
        const float* base = cache_k + (((size_t)page * 128 + ((16 * rg + rowi) & 127)) * 8 + h) * 64 + 8 * kq;
        ld[0] = __builtin_nontemporal_load((const f32x4*)(base)); ld[1] = __builtin_nontemporal_load((const f32x4*)(base + 4));
        ld[2] = __builtin_nontemporal_load((const f32x4*)(base + 32)); ld[3] = __builtin_nontemporal_load((const f32x4*)(base + 36));
    }
    __device__ __forceinline__ void step() {
        if (s >= nsteps) return;
        const int rg = s & 15;
        ks[0][0] += ld[0]; ks[0][1] += ld[1]; ks[1][0] += ld[2]; ks[1][1] += ld[3];
        u32x4_t wa, wb;
        wa.x = cvtpk_nv(ld[0][0], ld[0][1]); wa.y = cvtpk_nv(ld[0][2], ld[0][3]); wa.z = cvtpk_nv(ld[1][0], ld[1][1]); wa.w = cvtpk_nv(ld[1][2], ld[1][3]);
        wb.x = cvtpk_nv(ld[2][0], ld[2][1]); wb.y = cvtpk_nv(ld[2][2], ld[2][3]); wb.z = cvtpk_nv(ld[3][0], ld[3][1]); wb.w = cvtpk_nv(ld[3][2], ld[3][3]);
        f32x4 acc = (f32x4){0.f, 0.f, 0.f, 0.f};
        acc = __builtin_amdgcn_mfma_f32_16x16x32_bf16(__builtin_bit_cast(bf16x8, wa), qfr[0], acc, 0, 0, 0);
        acc = __builtin_amdgcn_mfma_f32_16x16x32_bf16(__builtin_bit_cast(bf16x8, wb), qfr[1], acc, 0, 0, 0);
        if (rowi < 4) *(f32x4*)(scb + 16 * rg) = acc;
        if (rg == 15) {
#pragma unroll
            for (int q = 0; q < 2; ++q)
#pragma unroll
                for (int e = 0; e < 2; ++e) {
                    f32x4 v = ks[q][e];
#pragma unroll
                    for (int o = 1; o < 16; o <<= 1) { v[0] += __shfl_xor(v[0], o); v[1] += __shfl_xor(v[1], o); v[2] += __shfl_xor(v[2], o); v[3] += __shfl_xor(v[3], o); }
                    if (rowi == 0) *(f32x4*)(KMS + ((size_t)cn * 8 + cblk) * 512 + h * 64 + 32 * q + 8 * kq + 4 * e) = v * (1.0f / 256.0f);
                }
        }
        ++s;
        if (s < nsteps) { if ((s & 15) == 0) setup(); issue(); }
    }
    __device__ __forceinline__ void drain() { while (s < nsteps) step(); }
};

__device__ __forceinline__ void attn_prompt_unit(LAS unsigned char* lds, int b, int h, int j, const bf16* Qb, const bf16* Kb, const bf16* Vb, const bf16* GAs, const float* KMP,
                                                 const float* qg, const float* kg, bf16* M0, StreamA& st) {
    const int tid = threadIdx.x, lane = tid & 63, wave = __builtin_amdgcn_readfirstlane(tid >> 6), l31 = lane & 31, hh = lane >> 5;
    LAS float* KM = (LAS float*)(lds + AT_KM); LAS float* WSF = (LAS float*)(lds + AT_WS) + wave * 32;
    for (int i = tid; i < j * 64; i += 512) { const int n = i >> 6, d = i & 63; const float* p = KMP + ((size_t)(b * 16 + n) * 4) * 512 + h * 64 + d; KM[i] = ((p[0] + p[512]) + (p[1024] + p[1536])) * (1.0f / 256.0f); }
    float gq = fabsf(qg[lane]), gk = fabsf(kg[lane]);
#pragma unroll
    for (int o = 1; o < 64; o <<= 1) { gq = fmaxf(gq, __shfl_xor(gq, o)); gk = fmaxf(gk, __shfl_xor(gk, o)); }
    const float m0c = 8.0f * gq * gk * 1.4426950408889634f;
    const size_t qrow = (size_t)b * 4096 + 256 * j + 32 * wave + l31;
    bf16x8 qf[4];
#pragma unroll
    for (int ds = 0; ds < 4; ++ds) qf[ds] = *(const bf16x8*)(Qb + qrow * 512 + h * 64 + 16 * ds + 8 * hh);
    const int srow = tid >> 3, sch = tid & 7;
    const size_t kvbase = (size_t)b * 4096 * 512 + h * 64 + sch * 8;
    const int sdst = srow * AT_PITCH + sch * 16;
    const int T = 4 * (j + 1);
    u32x4_t kreg, vreg;
    { const size_t r0 = (size_t)(256 * j + srow) * 512; kreg = *(const u32x4_t*)(Kb + kvbase + r0); vreg = *(const u32x4_t*)(Vb + kvbase + r0); }
    __syncthreads();
    unsigned selmask;
    if (j <= 3) selmask = (1u << j) - 1u;
    else {
        float g0 = -INFINITY, g1 = -INFINITY, g2 = -INFINITY; int s0 = 0, s1 = 0, s2 = 0;
        for (int n = 0; n < j; ++n) {
            float part = 0.f;
#pragma unroll
            for (int ds = 0; ds < 4; ++ds)
#pragma unroll
                for (int e = 0; e < 8; ++e) part += bf2f((unsigned short)qf[ds][e]) * KM[n * 64 + 16 * ds + 8 * hh + e];
            const float g = part + __shfl_xor(part, 32);
            if (g > g0) { g2 = g1; s2 = s1; g1 = g0; s1 = s0; g0 = g; s0 = n; }
            else if (g > g1) { g2 = g1; s2 = s1; g1 = g; s1 = n; }
            else if (g > g2) { g2 = g; s2 = n; }
        }
        selmask = (1u << s0) | (1u << s1) | (1u << s2);
    }
    *(LAS u32x4_t*)(lds + AT_KV + sdst) = kreg; *(LAS u32x4_t*)(lds + AT_KV + AT_TILE + sdst) = vreg;
    __syncthreads();
    f32x16 o0, o1;
#pragma unroll
    for (int r = 0; r < 16; ++r) { o0[r] = 0.f; o1[r] = 0.f; }
    float lsum = 0.f;
    const int qp = 32 * wave + l31;
    const int koff = l31 * AT_PITCH + hh * 16;
    const int voff = (4 * hh + ((lane & 15) >> 2)) * AT_PITCH + (16 * ((lane >> 4) & 1) + 4 * (lane & 3)) * 2;
    for (int t = 0; t < T; ++t) {
        const bool more = (t + 1 < T);
        if (more) { const int t1 = t + 1; const int nb = t1 < 4 ? j : (t1 >> 2) - 1; const size_t r0 = (size_t)(256 * nb + 64 * (t1 & 3) + srow) * 512; kreg = *(const u32x4_t*)(Kb + kvbase + r0); vreg = *(const u32x4_t*)(Vb + kvbase + r0); }
        st.step();
        const int buf = (t & 1) * AT_BUF;
        const bool own = t < 4; const int nbk = own ? j : (t >> 2) - 1;
        const bool act = own || ((selmask >> nbk) & 1u);
        f32x16 p0, p1;
#pragma unroll
        for (int r = 0; r < 16; ++r) { p0[r] = 0.f; p1[r] = 0.f; }
#pragma unroll
        for (int ds = 0; ds < 4; ++ds) {
            const bf16x8 ka0 = *(const LAS bf16x8*)(lds + AT_KV + buf + koff + ds * 32);
            const bf16x8 ka1 = *(const LAS bf16x8*)(lds + AT_KV + buf + koff + 32 * AT_PITCH + ds * 32);
            p0 = __builtin_amdgcn_mfma_f32_32x32x16_bf16(ka0, qf[ds], p0, 0, 0, 0);
            p1 = __builtin_amdgcn_mfma_f32_32x32x16_bf16(ka1, qf[ds], p1, 0, 0, 0);
        }
        const int kp0 = 64 * (t & 3);
        float ls = 0.f;
#pragma unroll
        for (int r = 0; r < 16; ++r) {
            const int kp = kp0 + crow(r, hh);
            const bool v0 = own ? (kp <= qp) : act, v1 = own ? (kp + 32 <= qp) : act;
            const float e0 = v0 ? __builtin_amdgcn_exp2f(p0[r] * SM_C - m0c) : 0.f, e1 = v1 ? __builtin_amdgcn_exp2f(p1[r] * SM_C - m0c) : 0.f;
            p0[r] = e0; p1[r] = e1; ls += e0 + e1;
        }
        lsum += ls;
        bf16x8 pa[4];
        { u32x4_t w;
          w.x = cvtpk(p0[0], p0[1]); w.y = cvtpk(p0[2], p0[3]); w.z = cvtpk(p0[4], p0[5]); w.w = cvtpk(p0[6], p0[7]); pa[0] = __builtin_bit_cast(bf16x8, w);
          w.x = cvtpk(p0[8], p0[9]); w.y = cvtpk(p0[10], p0[11]); w.z = cvtpk(p0[12], p0[13]); w.w = cvtpk(p0[14], p0[15]); pa[1] = __builtin_bit_cast(bf16x8, w);
          w.x = cvtpk(p1[0], p1[1]); w.y = cvtpk(p1[2], p1[3]); w.z = cvtpk(p1[4], p1[5]); w.w = cvtpk(p1[6], p1[7]); pa[2] = __builtin_bit_cast(bf16x8, w);
          w.x = cvtpk(p1[8], p1[9]); w.y = cvtpk(p1[10], p1[11]); w.z = cvtpk(p1[12], p1[13]); w.w = cvtpk(p1[14], p1[15]); pa[3] = __builtin_bit_cast(bf16x8, w); }
#pragma unroll
        for (int ks = 0; ks < 4; ++ks) {
            const LAS unsigned char* vb = lds + AT_KV + buf + AT_TILE + voff + 16 * ks * AT_PITCH;
            const v4i16_t a0 = __builtin_amdgcn_ds_read_tr16_b64_v4i16((LAS v4i16_t*)(vb));
            const v4i16_t a1 = __builtin_amdgcn_ds_read_tr16_b64_v4i16((LAS v4i16_t*)(vb + 8 * AT_PITCH));
            const v4i16_t c0 = __builtin_amdgcn_ds_read_tr16_b64_v4i16((LAS v4i16_t*)(vb + 64));
            const v4i16_t c1 = __builtin_amdgcn_ds_read_tr16_b64_v4i16((LAS v4i16_t*)(vb + 8 * AT_PITCH + 64));
            const bf16x8 vf0 = (bf16x8){a0[0], a0[1], a0[2], a0[3], a1[0], a1[1], a1[2], a1[3]};
            const bf16x8 vf1 = (bf16x8){c0[0], c0[1], c0[2], c0[3], c1[0], c1[1], c1[2], c1[3]};
            o0 = __builtin_amdgcn_mfma_f32_32x32x16_bf16(pa[ks], vf0, o0, 0, 0, 0);
            o1 = __builtin_amdgcn_mfma_f32_32x32x16_bf16(pa[ks], vf1, o1, 0, 0, 0);
        }
        if (more) { const int nbuf = ((t + 1) & 1) * AT_BUF; *(LAS u32x4_t*)(lds + AT_KV + nbuf + sdst) = kreg; *(LAS u32x4_t*)(lds + AT_KV + nbuf + AT_TILE + sdst) = vreg; }
        __syncthreads();
    }
    lsum += __shfl_xor(lsum, 32);
    if (hh == 0) WSF[l31] = 1.0f / lsum;
    asm volatile("s_waitcnt lgkmcnt(0)" ::: "memory");
    const size_t orow0 = (size_t)b * 4096 + 256 * j + 32 * wave;
#pragma unroll
    for (int r = 0; r < 16; ++r) {
        const int q = crow(r, hh); const float li = WSF[q]; const size_t ro = orow0 + q;
        const float ga0 = bf2f(GAs[ro * 512 + h * 64 + l31]), ga1 = bf2f(GAs[ro * 512 + h * 64 + 32 + l31]);
        M0[ro * 1024 + h * 64 + l31] = (bf16)f2bf(o0[r] * li * ga0);
        M0[ro * 1024 + h * 64 + 32 + l31] = (bf16)f2bf(o1[r] * li * ga1);
    }
}
__device__ __forceinline__ void attn_prompt_phase(LAS unsigned char* lds, int vcu, int G, const bf16* Qb, const bf16* Kb, const bf16* Vb, const bf16* GAs, const float* KMP, const float* qg, const float* kg, bf16* M0,
                                                  const float* cache_k, const int* pt, float* SC, float* KMS) {
    const int lane = threadIdx.x & 63, wave = __builtin_amdgcn_readfirstlane(threadIdx.x >> 6);
    StreamA st; st.init(Qb, cache_k, pt, SC, KMS, vcu, G, lane, wave);
    for (int u = vcu; u < 256; u += G) {
        const int b = u >> 6, h = (u >> 3) & 7, jj = u & 7;
        attn_prompt_unit(lds, b, h, 15 - jj, Qb, Kb, Vb, GAs, KMP, qg, kg, M0, st);
        attn_prompt_unit(lds, b, h, jj, Qb, Kb, Vb, GAs, KMP, qg, kg, M0, st);
    }
    st.drain();
}

__device__ __forceinline__ void attn_sample_passA(LAS unsigned char* lds, int vcu, int G, const bf16* Qb, const float* cache_k, const int* pt, float* SC, float* KMS) {
    const int tid = threadIdx.x, lane = tid & 63, h = __builtin_amdgcn_readfirstlane(tid >> 6), rowi = lane & 15, kq = lane >> 4;
    for (int unit = vcu; unit < 1024; unit += G) {
        const int n = unit >> 3, blk = unit & 7;
        bf16x8 qfr[2];
#pragma unroll
        for (int s = 0; s < 2; ++s) { u32x4_t w = (u32x4_t){0u, 0u, 0u, 0u}; if (rowi < 4) w = *(const u32x4_t*)(Qb + (size_t)(MPROMPT + n * 4 + rowi) * 512 + h * 64 + 32 * s + 8 * kq); qfr[s] = __builtin_bit_cast(bf16x8, w); }
        const int pg0 = pt[n * 16 + blk * 2], pg1 = pt[n * 16 + blk * 2 + 1];
        f32x4 ks[2][2];
#pragma unroll
        for (int s = 0; s < 2; ++s) { ks[s][0] = (f32x4){0.f, 0.f, 0.f, 0.f}; ks[s][1] = (f32x4){0.f, 0.f, 0.f, 0.f}; }
        float* scb = SC + (((size_t)n * 8 + h) * 4 + rowi) * 2048 + blk * 256 + 4 * kq;
#pragma unroll 1
        for (int rq = 0; rq < 4; ++rq) {
            const int page = rq < 2 ? pg0 : pg1;
            const float* base = cache_k + (((size_t)page * 128 + ((64 * rq + rowi) & 127)) * 8 + h) * 64 + 8 * kq;
            f32x4 ld[4][4];
#pragma unroll
            for (int g = 0; g < 4; ++g) { const float* bg = base + (size_t)g * 16 * 512;
                ld[g][0] = __builtin_nontemporal_load((const f32x4*)(bg)); ld[g][1] = __builtin_nontemporal_load((const f32x4*)(bg + 4));
                ld[g][2] = __builtin_nontemporal_load((const f32x4*)(bg + 32)); ld[g][3] = __builtin_nontemporal_load((const f32x4*)(bg + 36)); }
#pragma unroll
            for (int g = 0; g < 4; ++g) {
                ks[0][0] += ld[g][0]; ks[0][1] += ld[g][1]; ks[1][0] += ld[g][2]; ks[1][1] += ld[g][3];
                u32x4_t wa, wb;
                wa.x = cvtpk_nv(ld[g][0][0], ld[g][0][1]); wa.y = cvtpk_nv(ld[g][0][2], ld[g][0][3]); wa.z = cvtpk_nv(ld[g][1][0], ld[g][1][1]); wa.w = cvtpk_nv(ld[g][1][2], ld[g][1][3]);
                wb.x = cvtpk_nv(ld[g][2][0], ld[g][2][1]); wb.y = cvtpk_nv(ld[g][2][2], ld[g][2][3]); wb.z = cvtpk_nv(ld[g][3][0], ld[g][3][1]); wb.w = cvtpk_nv(ld[g][3][2], ld[g][3][3]);
                f32x4 acc = (f32x4){0.f, 0.f, 0.f, 0.f};
                acc = __builtin_amdgcn_mfma_f32_16x16x32_bf16(__builtin_bit_cast(bf16x8, wa), qfr[0], acc, 0, 0, 0);
                acc = __builtin_amdgcn_mfma_f32_16x16x32_bf16(__builtin_bit_cast(bf16x8, wb), qfr[1], acc, 0, 0, 0);
                if (rowi < 4) *(f32x4*)(scb + 16 * (4 * rq + g)) = acc;
            }
        }
#pragma unroll
        for (int s = 0; s < 2; ++s)
#pragma unroll
            for (int e = 0; e < 2; ++e) {
                f32x4 v = ks[s][e];
#pragma unroll
                for (int o = 1; o < 16; o <<= 1) { v[0] += __shfl_xor(v[0], o); v[1] += __shfl_xor(v[1], o); v[2] += __shfl_xor(v[2], o); v[3] += __shfl_xor(v[3], o); }
                if (rowi == 0) *(f32x4*)(KMS + ((size_t)n * 8 + blk) * 512 + h * 64 + 32 * s + 8 * kq + 4 * e) = v * (1.0f / 256.0f);
            }
    }
}
__device__ __forceinline__ void attn_sample_passB(LAS unsigned char* lds, int vcu, int G, const bf16* Qb, const bf16* Kb, const bf16* Vb, const bf16* GAs, const float* cache_v, const int* pt,
                                                  const float* SC, const float* KMS, const float* qg, const float* kg, bf16* M0) {
    const int tid = threadIdx.x, lane = tid & 63, wave = __builtin_amdgcn_readfirstlane(tid >> 6);
    LAS float* PL = (LAS float*)lds;
    LAS float* OP = (LAS float*)(lds + 32768);
    LAS unsigned* SEL = (LAS unsigned*)(lds + 65536);
    LAS float* POWN = (LAS float*)(lds + 65536 + 64);
    LAS float* REDL = (LAS float*)(lds + 65536 + 128);
    float gq = fabsf(qg[lane]), gk = fabsf(kg[lane]);
#pragma unroll
    for (int o = 1; o < 64; o <<= 1) { gq = fmaxf(gq, __shfl_xor(gq, o)); gk = fmaxf(gk, __shfl_xor(gk, o)); }
    const float m0c = 8.0f * gq * gk * 1.4426950408889634f;
    for (int unit = vcu; unit < 1024; unit += G) {
        const int n = unit >> 3, h = unit & 7;
        if (wave < 4) {
            const int t = wave; const size_t qrow = (size_t)(MPROMPT + n * 4 + t);
            const float q = bf2f(Qb[qrow * 512 + h * 64 + lane]);
            float g0 = -INFINITY, g1 = -INFINITY, g2 = -INFINITY; int s0 = 0, s1 = 0, s2 = 0;
            for (int blk = 0; blk < 8; ++blk) {
                const float g = wave_sum(q * KMS[((size_t)n * 8 + blk) * 512 + h * 64 + lane]);
                if (g > g0) { g2 = g1; s2 = s1; g1 = g0; s1 = s0; g0 = g; s0 = blk; }
                else if (g > g1) { g2 = g1; s2 = s1; g1 = g; s1 = blk; }
                else if (g > g2) { g2 = g; s2 = blk; }
            }
            if (lane == 0) SEL[t] = (1u << s0) | (1u << s1) | (1u << s2);
#pragma unroll
            for (int tp = 0; tp < 4; ++tp) {
                const float s = wave_sum(q * bf2f(Kb[(size_t)(MPROMPT + n * 4 + tp) * 512 + h * 64 + lane]));
                if (lane == 0) POWN[t * 4 + tp] = tp <= t ? __builtin_amdgcn_exp2f(s * SM_C - m0c) : 0.f;
            }
        }
        __syncthreads();
        const unsigned sel0 = SEL[0], sel1 = SEL[1], sel2 = SEL[2], sel3 = SEL[3], anym = sel0 | sel1 | sel2 | sel3;
        {
            float lp[4] = {0.f, 0.f, 0.f, 0.f};
#pragma unroll
            for (int k = 0; k < 16; ++k) {
                const int i = tid + 512 * k, t = k >> 2, idx = i & 2047, blk = idx >> 8;
                const unsigned sm = t == 0 ? sel0 : (t == 1 ? sel1 : (t == 2 ? sel2 : sel3));
                const float p = ((sm >> blk) & 1u) ? __builtin_amdgcn_exp2f(SC[(((size_t)n * 8 + h) * 4 + t) * 2048 + idx] * SM_C - m0c) : 0.f;
                PL[i] = p; lp[t] += p;
            }
#pragma unroll
            for (int t = 0; t < 4; ++t) { const float s = wave_sum(lp[t]); if (lane == 0) REDL[wave * 4 + t] = s; }
        }
        __syncthreads();
        {
            const int d4 = tid & 15, rl = tid >> 4;
            f32x4 acc[4];
#pragma unroll
            for (int t = 0; t < 4; ++t) acc[t] = (f32x4){0.f, 0.f, 0.f, 0.f};
            const float* cvb = cache_v + (size_t)h * 64 + 4 * d4;
            f32x4 cur[8], nxt[8];
            unsigned rem = anym & 0xffu;
            int blk = rem ? __builtin_ctz(rem) : 8;
            if (blk < 8) { const int pg0 = pt[n * 16 + blk * 2], pg1 = pt[n * 16 + blk * 2 + 1];
#pragma unroll
                for (int rr = 0; rr < 8; ++rr) { const int r = rl + 32 * rr; cur[rr] = __builtin_nontemporal_load((const f32x4*)(cvb + ((size_t)(rr < 4 ? pg0 : pg1) * 128 + (r & 127)) * 512)); } }
            while (blk < 8) {
                rem &= rem - 1u;
                const int nb = rem ? __builtin_ctz(rem) : 8;
                if (nb < 8) { const int pg0 = pt[n * 16 + nb * 2], pg1 = pt[n * 16 + nb * 2 + 1];
#pragma unroll
                    for (int rr = 0; rr < 8; ++rr) { const int r = rl + 32 * rr; nxt[rr] = __builtin_nontemporal_load((const f32x4*)(cvb + ((size_t)(rr < 4 ? pg0 : pg1) * 128 + (r & 127)) * 512)); } }
#pragma unroll
                for (int rr = 0; rr < 8; ++rr) { const int r = rl + 32 * rr;
#pragma unroll
                    for (int t = 0; t < 4; ++t) acc[t] += PL[t * 2048 + blk * 256 + r] * cur[rr]; }
#pragma unroll
                for (int rr = 0; rr < 8; ++rr) cur[rr] = nxt[rr];
                blk = nb;
            }
#pragma unroll
            for (int t = 0; t < 4; ++t) *(LAS f32x4*)(lds + 32768 + ((rl * 4 + t) * 64 + 4 * d4) * 4) = acc[t];
        }
        __syncthreads();
        if (tid < 256) {
            const int t = tid >> 6, d = tid & 63; float o = 0.f;
#pragma unroll 8
            for (int rl = 0; rl < 32; ++rl) o += OP[(rl * 4 + t) * 64 + d];
            float l = 0.f;
#pragma unroll
            for (int w = 0; w < 8; ++w) l += REDL[w * 4 + t];
#pragma unroll
            for (int tp = 0; tp < 4; ++tp) { const float p = POWN[t * 4 + tp]; l += p; o += p * bf2f(Vb[(size_t)(MPROMPT + n * 4 + tp) * 512 + h * 64 + d]); }
            const size_t ro = (size_t)(MPROMPT + n * 4 + t);
            M0[ro * 1024 + h * 64 + d] = (bf16)f2bf(o / l * bf2f(GAs[ro * 512 + h * 64 + d]));
        }
        __syncthreads();
    }
}

__global__ void __launch_bounds__(NWAVES * 64, 2) fwd(Args args) {
    extern __shared__ __attribute__((aligned(16))) unsigned char lds_raw[];
    LAS unsigned char* lds = (LAS unsigned char*)lds_raw;
    volatile LAS unsigned* MISC = (volatile LAS unsigned*)(lds + MISC_OFF);
    const int tid = threadIdx.x, lane = tid & 63, wave = __builtin_amdgcn_readfirstlane(tid >> 6);
    const int G = gridDim.x; const int bx = blockIdx.x; const int vcu = (G % 8 == 0) ? (bx % 8) * (G / 8) + bx / 8 : bx;
    unsigned char* ws = args.ws;
    for (int u = tid; u < (LDS_BYTES - LDSCTL_OFF) / 4; u += NWAVES * 64) ((LAS unsigned*)(lds + LDSCTL_OFF))[u] = 0u;
    __syncthreads();
    XcdBarrier bar = xcd_barrier_post((unsigned*)(ws + WS_CTL) + CW_BAR, MISC + 8);
#ifdef FWD_STAMPS
    unsigned long long* stamps_ = (unsigned long long*)(ws + WS_STAMP);
#define STAMP(k) do { if (bx == 0 && tid == 0) stamps_[k] = __builtin_amdgcn_s_memrealtime(); } while (0)
#else
#define STAMP(k) do {} while (0)
#endif
    STAMP(0);

    const float* x_prompt = (const float*)args.in[I_XP]; const float* x_sample = (const float*)args.in[I_XS];
    float* out = args.out;
    bf16* W0T = (bf16*)(ws + WS_W0T); bf16* WO0T = (bf16*)(ws + WS_WO0T); bf16* W1T = (bf16*)(ws + WS_W1T); bf16* WO1T = (bf16*)(ws + WS_WO1T);
    float* RSTD0 = (float*)(ws + WS_RSTD0); float* LB = (float*)(ws + WS_LB); float* KMP = (float*)(ws + WS_KMP); float* SSQ = (float*)(ws + WS_SSQ);
    bf16* XB = (bf16*)(ws + WS_XB); bf16* Qb = (bf16*)(ws + WS_Q); bf16* Kb = (bf16*)(ws + WS_K); bf16* Vb = (bf16*)(ws + WS_V);
    bf16* GA = (bf16*)(ws + WS_GA); bf16* Ub = (bf16*)(ws + WS_U); bf16* GC = (bf16*)(ws + WS_GC);
    bf16* M0 = (bf16*)(ws + WS_M0); float* X1 = (float*)(ws + WS_X1); bf16* XB1 = (bf16*)(ws + WS_XB1); bf16* QQ = (bf16*)(ws + WS_QQ); float* LOGF = (float*)(ws + WS_LOGF);
    bf16* VV = (bf16*)(ws + WS_VV); bf16* GS = (bf16*)(ws + WS_GS); bf16* M1 = (bf16*)(ws + WS_M1);
    float* SCb = (float*)(ws + WS_SC); float* KMS = (float*)(ws + WS_KMS);
    float* OLOC = (float*)(ws + WS_OLOC); bf16* QBS = (bf16*)(ws + WS_QBS); float* USEG = (float*)(ws + WS_USEG); float* DSEG = (float*)(ws + WS_DSEG);

    {
        LAS float* scr = (LAS float*)(lds + wave * 16384);
        const int gw = vcu * NWAVES + wave, NGW = G * NWAVES;
        constexpr int I0 = 16 * (N0 / 32), IO = 16 * 32, I1 = 16 * (N1 / 32);
        constexpr int NITEMS = I0 + IO + I1 + IO;
        for (int it = gw; it < NITEMS; it += NGW) {
            int r = it;
            if (r < I0) { const int kb = r / (N0 / 32), dg = r % (N0 / 32); p0_transpose_item((const float*)args.in[I_WIN0], D, N0, W0T, 64 * kb, 32 * l0_src_group(dg), 32 * dg, (const float*)args.in[I_NORM0], scr, lane); continue; } r -= I0;
            if (r < IO) { const int kb = r / 32, dg = r % 32; p0_transpose_item((const float*)args.in[I_WOUT0], D, D, WO0T, 64 * kb, 32 * dg, 32 * dg, nullptr, scr, lane); continue; } r -= IO;
            if (r < I1) { const int kb = r / (N1 / 32), dg = r % (N1 / 32); p0_transpose_item((const float*)args.in[I_WIN1], D, N1, W1T, 64 * kb, 32 * dg, 32 * dg, (const float*)args.in[I_NORM1], scr, lane); continue; } r -= I1;
            { const int kb = r / 32, dg = r % 32; p0_transpose_item((const float*)args.in[I_WOUT1], D, D, WO1T, 64 * kb, 32 * dg, 32 * dg, nullptr, scr, lane); }
        }
        for (int m0 = gw; m0 < MTOT; m0 += 2 * NGW) {
            const int m1 = m0 + NGW; const bool has1 = m1 < MTOT; const int m1c = has1 ? m1 : m0;
            const float* xr0 = m0 < MPROMPT ? x_prompt + (size_t)m0 * D : x_sample + (size_t)(m0 - MPROMPT) * D;
            const float* xr1 = m1c < MPROMPT ? x_prompt + (size_t)m1c * D : x_sample + (size_t)(m1c - MPROMPT) * D;
            f32x4 v0[4], v1[4];
#pragma unroll
            for (int j = 0; j < 4; ++j) { v0[j] = ((const GAS f32x4*)xr0)[lane + 64 * j]; v1[j] = ((const GAS f32x4*)xr1)[lane + 64 * j]; }
            float s0 = 0.f, s1 = 0.f;
#pragma unroll
            for (int j = 0; j < 4; ++j) { s0 += pg8::dot4(v0[j]); s1 += pg8::dot4(v1[j]); }
            s0 = wave_sum(s0); s1 = wave_sum(s1);
            if (lane == 0) { RSTD0[m0] = __builtin_amdgcn_rsqf(s0 * (1.0f / D) + 1e-6f); if (has1) RSTD0[m1] = __builtin_amdgcn_rsqf(s1 * (1.0f / D) + 1e-6f); }
            GAS unsigned long long* o0 = (GAS unsigned long long*)(XB + (size_t)m0 * D) + lane;
#pragma unroll
            for (int j = 0; j < 4; ++j) o0[64 * j] = (unsigned long long)pk2(v0[j].x, v0[j].y) | ((unsigned long long)pk2(v0[j].z, v0[j].w) << 32);
            if (has1) { GAS unsigned long long* o1 = (GAS unsigned long long*)(XB + (size_t)m1 * D) + lane;
#pragma unroll
                for (int j = 0; j < 4; ++j) o1[64 * j] = (unsigned long long)pk2(v1[j].x, v1[j].y) | ((unsigned long long)pk2(v1[j].z, v1[j].w) << 32); }
        }
        { const int gt = vcu * (NWAVES * 64) + tid; if (gt < 1024) { const float* l = (const float*)args.in[I_LBL]; LB[gt] = 1.0f / (1.0f + __expf(l[gt] - l[1024 + gt])); } }
        { const f32x4* sc = (const f32x4*)args.in[I_SCONV]; f32x4* cs = (f32x4*)(out + O_CS);
          for (int i = vcu * (NWAVES * 64) + tid; i < NDEC * 26 * 128; i += G * NWAVES * 64) { const int n = i / (26 * 128), rem = i % (26 * 128); cs[(size_t)n * 30 * 128 + rem] = sc[(size_t)n * 30 * 128 + 4 * 128 + rem]; } }
    }
    xcd_barrier(bar); STAMP(1);

    {
        pg8::Gemm g{XB, W0T, MTOT, N0, D}; pg8::StaticOrder S; S.init(MTOT, N0, G, bx);
        pg8::EpiIn0 E{RSTD0, (const float*)args.in[I_QN], (const float*)args.in[I_KN], Qb, Kb, Vb, GA, Ub, GC,
                      out + O_KP, out + O_VP, out + O_KS, out + O_VS, out + O_CP, out + O_CS, KMP};
        pg8::gemm_phase<pg8::EpiIn0, pg8::StaticOrder, true, true>(lds, g, S, E);
    }
    xcd_barrier(bar); STAMP(2);

    attn_prompt_phase(lds, vcu, G, Qb, Kb, Vb, GA, KMP, (const float*)args.in[I_QN], (const float*)args.in[I_KN], M0, (const float*)args.in[I_CK], (const int*)args.in[I_PT], SCb, KMS); STAMP(3);
    xcd_barrier(bar); STAMP(4);

    if (bx & 1) attn_sample_passB(lds, vcu, G, Qb, Kb, Vb, GA, (const float*)args.in[I_CV], (const int*)args.in[I_PT], SCb, KMS, (const float*)args.in[I_QN], (const float*)args.in[I_KN], M0);
    conv_phase(lds, vcu, G, Ub, GC, (const float*)args.in[I_SCONV], (const float*)args.in[I_CW], (const float*)args.in[I_CB], (const float*)args.in[I_LNG], (const float*)args.in[I_LNB], M0); STAMP(5);
    if (!(bx & 1)) attn_sample_passB(lds, vcu, G, Qb, Kb, Vb, GA, (const float*)args.in[I_CV], (const int*)args.in[I_PT], SCb, KMS, (const float*)args.in[I_QN], (const float*)args.in[I_KN], M0);
    xcd_barrier(bar); STAMP(6);

    {
        pg8::Gemm g{M0, WO0T, MTOT, D, D}; pg8::StaticOrder S; S.init(MTOT, D, G, bx);
        pg8::EpiOut0 E{x_prompt, x_sample, X1, XB1, SSQ};
        pg8::gemm_phase<pg8::EpiOut0, pg8::StaticOrder, true, true>(lds, g, S, E);
    }
    xcd_barrier(bar); STAMP(7);

    {
        pg8::Gemm g{XB1, W1T, MTOT, N1, D}; pg8::StaticOrder S; S.init(MTOT, N1, G, bx);
        pg8::EpiIn1 E{SSQ, LB, QQ, VV, GS, LOGF};
        pg8::gemm_phase<pg8::EpiIn1, pg8::StaticOrder, true, true>(lds, g, S, E);
    }
    xcd_barrier(bar); STAMP(8);

    scan_pass1(lds, vcu, G, QQ, LOGF, VV, OLOC, QBS, USEG, DSEG); STAMP(9);
    scan_sample(lds, vcu, G, QQ, LOGF, VV, GS, (const float*)args.in[I_ONORM], (const float*)args.in[I_SHGRN], out + O_HS, M1);
    xcd_barrier(bar); STAMP(10);

    scan_pass3(lds, vcu, G, QBS, OLOC, USEG, DSEG, GS, (const float*)args.in[I_ONORM], M1, out + O_HP);
    xcd_barrier(bar); STAMP(11);

    {
        pg8::Gemm g{M1, WO1T, MTOT, D, D}; pg8::StaticOrder S; S.init(MTOT, D, G, bx);
        pg8::EpiOut1 E{X1, out + O_Y};
        pg8::gemm_phase<pg8::EpiOut1, pg8::StaticOrder, true, true>(lds, g, S, E);
    }
    STAMP(12);
}
extern "C" void kernel_launch(void* const* d_in, const int* in_sizes, int n_in, void* d_out, int out_size, void* d_ws, size_t ws_size, hipStream_t stream) {
    static int grid = 0;
    if (grid == 0) {
        if (n_in != N_IN || (size_t)out_size != O_END || ws_size < WS_END) { fprintf(stderr, "kernel_launch: unexpected shapes (n_in %d out %d ws %zu)\n", n_in, out_size, ws_size); grid = -1; return; }
        int dev = 0, cus = 0, per_cu = 0;
        if (hipGetDevice(&dev) != hipSuccess || hipDeviceGetAttribute(&cus, hipDeviceAttributeMultiprocessorCount, dev) != hipSuccess) { grid = -1; return; }
        if (hipFuncSetAttribute((const void*)fwd, hipFuncAttributeMaxDynamicSharedMemorySize, LDS_BYTES) != hipSuccess) { fprintf(stderr, "kernel_launch: hipFuncSetAttribute failed\n"); grid = -1; return; }
        if (hipOccupancyMaxActiveBlocksPerMultiprocessor(&per_cu, (const void*)fwd, NWAVES * 64, LDS_BYTES) != hipSuccess || per_cu < 1) fprintf(stderr, "kernel_launch: occupancy query reports %d\n", per_cu);
        (void)hipGetLastError();
        grid = cus;
    }
    if (grid < 0) return;
    if (hipMemsetAsync((char*)d_ws + WS_CTL, 0, CTL_ZERO_BYTES, stream) != hipSuccess) return;
    Args a{};
    for (int i = 0; i < N_IN; ++i) a.in[i] = d_in[i];
    a.out = (float*)d_out; a.ws = (unsigned char*)d_ws;
    hipLaunchKernelGGL(fwd, dim3(grid), dim3(NWAVES * 64), LDS_BYTES, stream, a);
}
```

```cpp
#include <hip/hip_runtime.h>
#include <cstdio>
#include <cstdint>
namespace pg8 {
#define PG8_LAS __attribute__((address_space(3)))
typedef unsigned short bf16_t;
typedef short bf16x8 __attribute__((ext_vector_type(8)));
typedef float f32x4 __attribute__((ext_vector_type(4)));
typedef unsigned u32x4 __attribute__((ext_vector_type(4)));
constexpr int BM = 256, BK = 64, HALF = 128, HTB = HALF * BK * 2  , STAGE_BYTES = 8 * HTB, NXCD = 8, WGM = 8;

__host__ __device__ __forceinline__ int lds_byte(int r, int c) { const int st = (r >> 4) * 2 + (c >> 5), rr = r & 15, cc = c & 31, ob = rr * 64 + cc * 2; return st * 1024 + (ob ^ (((ob >> 9) & 1) << 5)); }
__host__ __device__ __forceinline__ void stage_rc(int b, int& R, int& C) { const int st = b / 1024, sb = b % 1024, swz = sb ^ (((sb >> 9) & 1) << 5); R = (st >> 1) * 16 + swz / 64; C = (st & 1) * 32 + (swz % 64) / 2; }
__host__ __device__ __forceinline__ int perm32(int rho) { const int n = rho >> 4, i = rho & 15; return 8 * (i >> 2) + 4 * n + (i & 3); }

struct Unit { int pm, pn; };
struct Gemm { const bf16_t* A; const bf16_t* Bt; int M, N, K; };

struct StaticOrder {
    int nM, nN, nwg, G, c;
    __host__ __device__ void init(int M, int N, int G_, int c_) { nM = M / BM; nN = N / BM; nwg = nM * nN; G = G_; c = c_; }
    __host__ __device__ bool next(int i, Unit& u) const {
        const long L = (long)i * G + c; if (L >= nwg) return false;
        int wgid = (int)L; { const int q = nwg / NXCD, r = nwg % NXCD, xcd = wgid % NXCD, off = wgid / NXCD; wgid = (xcd < r ? xcd * (q + 1) : r * (q + 1) + (xcd - r) * q) + off; }
        const int nig = WGM * nN, gid = wgid / nig, fm = gid * WGM, gsz = (nM - fm) < WGM ? (nM - fm) : WGM;
        u.pm = fm + ((wgid % nig) % gsz); u.pn = (wgid % nig) / gsz; return true;
    }
    __device__ __forceinline__ void a_ready(const Unit&) const {}
    __device__ __forceinline__ void done(const Unit&) const {}
};
struct FewOrder {
    int n, nN, pm0, c;
    __device__ __forceinline__ bool next(int i, Unit& u) const { if (i != 0 || c >= n) return false; u.pm = pm0 + c / nN; u.pn = c % nN; return true; }
    __device__ __forceinline__ void a_ready(const Unit&) const {}
    __device__ __forceinline__ void done(const Unit&) const {}
};
__device__ __forceinline__ unsigned cvt_pk_bf16(float lo, float hi) { unsigned r; asm volatile("v_cvt_pk_bf16_f32 %0, %1, %2" : "=v"(r) : "v"(lo), "v"(hi)); return r; }
typedef float f32x2 __attribute__((ext_vector_type(2)));
typedef unsigned u32x2 __attribute__((ext_vector_type(2)));
__device__ __forceinline__ float fsigmoid(float x) { return __builtin_amdgcn_rcpf(1.0f + __builtin_amdgcn_exp2f(-1.4426950408889634f * x)); }
__device__ __forceinline__ float fsilu(float x) { return x * fsigmoid(x); }
__device__ __forceinline__ f32x4 silu4(f32x4 v) { return (f32x4){fsilu(v[0]), fsilu(v[1]), fsilu(v[2]), fsilu(v[3])}; }
__device__ __forceinline__ f32x4 sigm4(f32x4 v) { return (f32x4){fsigmoid(v[0]), fsigmoid(v[1]), fsigmoid(v[2]), fsigmoid(v[3])}; }
__device__ __forceinline__ u32x4 pack8(f32x4 a, f32x4 b) { u32x4 w; w.x = cvt_pk_bf16(a[0], a[1]); w.y = cvt_pk_bf16(a[2], a[3]); w.z = cvt_pk_bf16(b[0], b[1]); w.w = cvt_pk_bf16(b[2], b[3]); return w; }
__device__ __forceinline__ float dot4(f32x4 a) { return (a[0] * a[0] + a[1] * a[1]) + (a[2] * a[2] + a[3] * a[3]); }

constexpr int MP = 16384;
constexpr float RMS_EPS = 1e-6f;

struct EpiIn0 {
    static constexpr bool PERM = true, AFTER_DRAIN = false;
    const float* rstd; const float* qg; const float* kg;
    bf16_t *Q, *Kb, *Vb, *GA, *U, *GC;
    float *k_prompt, *v_prompt, *k_sample, *v_sample, *conv_prompt, *conv_sample;
    float* kmp;
    __device__ __forceinline__ void operator()(const f32x4 (&acc)[2][2][4][2], const Unit& u, int wr, int wc, int fr, int fq) const {
        const int pn = u.pn;
        const int rowb = u.pm * BM + wr * 64 + fr;
        const bool sample = u.pm >= 64;
        if (pn < 4) {
            const bool isk = pn >= 2;
            const float* g = isk ? kg : qg;
            f32x4 gv[2][2];
#pragma unroll
            for (int bj = 0; bj < 2; ++bj)
#pragma unroll
                for (int n = 0; n < 2; ++n) gv[bj][n] = *(const f32x4*)(g + 32 * bj + 8 * fq + 4 * n);
            const int colb = 256 * (pn & 1) + 64 * wc + 8 * fq;
            bf16_t* ob = isk ? Kb : Q;
            float* of = sample ? (k_sample - (size_t)MP * 512) : k_prompt;
#pragma unroll
            for (int ai = 0; ai < 2; ++ai) {
                f32x4 ks[2][2];
#pragma unroll
                for (int bj = 0; bj < 2; ++bj)
#pragma unroll
                    for (int n = 0; n < 2; ++n) ks[bj][n] = (f32x4){0.f, 0.f, 0.f, 0.f};
#pragma unroll
                for (int m = 0; m < 4; ++m) {
                    const int r = rowb + ai * HALF + m * 16;
                    const float rs = rstd[r];
                    f32x4 v[2][2]; float ss = 0.f;
#pragma unroll
                    for (int bj = 0; bj < 2; ++bj)
#pragma unroll
                        for (int n = 0; n < 2; ++n) { v[bj][n] = acc[ai][bj][m][n] * rs; ss += dot4(v[bj][n]); }
                    ss += __shfl_xor(ss, 16); ss += __shfl_xor(ss, 32);
                    const float inv = __builtin_amdgcn_rsqf(ss * (1.0f / 64.0f) + RMS_EPS);
#pragma unroll
                    for (int bj = 0; bj < 2; ++bj) {
                        const f32x4 o0 = v[bj][0] * inv * gv[bj][0], o1 = v[bj][1] * inv * gv[bj][1];
                        const size_t off = (size_t)r * 512 + colb + 32 * bj;
                        *(u32x4*)(ob + off) = pack8(o0, o1);
                        if (isk) { *(f32x4*)(of + off) = o0; *(f32x4*)(of + off + 4) = o1; ks[bj][0] += o0; ks[bj][1] += o1; }
                    }
                }
                if (isk && !sample) {
#pragma unroll
                    for (int bj = 0; bj < 2; ++bj)
#pragma unroll
                        for (int n = 0; n < 2; ++n) {
                            f32x4 s = ks[bj][n];
#pragma unroll
                            for (int o = 1; o < 16; o <<= 1) { s[0] += __shfl_xor(s[0], o); s[1] += __shfl_xor(s[1], o); s[2] += __shfl_xor(s[2], o); s[3] += __shfl_xor(s[3], o); }
                            if (fr == 0) *(f32x4*)(kmp + ((size_t)(u.pm * 4 + ai * 2 + wr)) * 512 + colb + 32 * bj + 4 * n) = s;
                        }
                }
            }
        } else if (pn < 6) {
            const int colb = 256 * (pn & 1) + 64 * wc + 8 * fq;
            float* of = sample ? (v_sample - (size_t)MP * 512) : v_prompt;
#pragma unroll
            for (int ai = 0; ai < 2; ++ai)
#pragma unroll
                for (int m = 0; m < 4; ++m) {
                    const int r = rowb + ai * HALF + m * 16;
                    const float rs = rstd[r];
#pragma unroll
                    for (int bj = 0; bj < 2; ++bj) {
                        const f32x4 o0 = acc[ai][bj][m][0] * rs, o1 = acc[ai][bj][m][1] * rs;
                        const size_t off = (size_t)r * 512 + colb + 32 * bj;
                        *(u32x4*)(Vb + off) = pack8(o0, o1);
                        *(f32x4*)(of + off) = o0; *(f32x4*)(of + off + 4) = o1;
                    }
                }
        } else if (pn < 8 || pn >= 12) {
            const int colb = 256 * (pn & 1) + 64 * wc + 8 * fq;
            bf16_t* ob = pn < 8 ? GA : GC;
#pragma unroll
            for (int ai = 0; ai < 2; ++ai)
#pragma unroll
                for (int m = 0; m < 4; ++m) {
                    const int r = rowb + ai * HALF + m * 16;
                    const float rs = rstd[r];
#pragma unroll
                    for (int bj = 0; bj < 2; ++bj) {
                        const f32x4 o0 = silu4(acc[ai][bj][m][0] * rs), o1 = silu4(acc[ai][bj][m][1] * rs);
                        *(u32x4*)(ob + (size_t)r * 512 + colb + 32 * bj) = pack8(o0, o1);
                    }
                }
        } else {
            const int ch0 = 128 * (pn - 8) + 32 * wc + 8 * fq;
            const bool tailp = !sample && ((u.pm & 15) == 15);
#pragma unroll
            for (int ai = 0; ai < 2; ++ai)
#pragma unroll
                for (int m = 0; m < 4; ++m) {
                    const int r = rowb + ai * HALF + m * 16;
                    const float rs = rstd[r];
                    const f32x4 o0 = (acc[ai][0][m][0] * rs) * sigm4(acc[ai][1][m][0] * rs), o1 = (acc[ai][0][m][1] * rs) * sigm4(acc[ai][1][m][1] * rs);
                    *(u32x4*)(U + (size_t)r * 512 + ch0) = pack8(o0, o1);
                    if (tailp) { const int tok = r & 4095; if (tok >= 4066) { float* d = conv_prompt + ((size_t)((r >> 12) * 30 + (tok - 4066))) * 512 + ch0; *(f32x4*)d = o0; *(f32x4*)(d + 4) = o1; } }
                    if (sample) { const int rr = r - MP; float* d = conv_sample + ((size_t)((rr >> 2) * 30 + 26 + (rr & 3))) * 512 + ch0; *(f32x4*)d = o0; *(f32x4*)(d + 4) = o1; }
                }
        }
    }
};

struct EpiOut0 {
    static constexpr bool PERM = false, AFTER_DRAIN = false;
    const float* xp; const float* xs; float* X1; bf16_t* XB1; float* SSQ;
    __device__ __forceinline__ void operator()(const f32x4 (&acc)[2][2][4][2], const Unit& u, int wr, int wc, int fr, int fq) const {
        const int rowb = u.pm * BM + wr * 64 + fr, col0 = u.pn * BM + wc * 32 + 4 * fq;
        const float* xb = u.pm >= 64 ? xs - (size_t)MP * 1024 : xp;
#pragma unroll
        for (int ai = 0; ai < 2; ++ai)
#pragma unroll
            for (int m = 0; m < 4; ++m) {
                const int r = rowb + ai * HALF + m * 16; const size_t ro = (size_t)r * 1024 + col0; float ss = 0.f;
#pragma unroll
                for (int bj = 0; bj < 2; ++bj)
#pragma unroll
                    for (int n = 0; n < 2; ++n) {
                        const size_t o_ = ro + bj * HALF + n * 16;
                        const f32x4 o = *(const f32x4*)(xb + o_) + acc[ai][bj][m][n];
                        *(f32x4*)(X1 + o_) = o; u32x2 w; w.x = cvt_pk_bf16(o[0], o[1]); w.y = cvt_pk_bf16(o[2], o[3]); *(u32x2*)(XB1 + o_) = w; ss += dot4(o);
                    }
                ss += __shfl_xor(ss, 16); ss += __shfl_xor(ss, 32);
                if (fq == 0) SSQ[(size_t)r * 16 + u.pn * 4 + wc] = ss;
            }
    }
};
struct EpiIn1 {
    static constexpr bool PERM = true, AFTER_DRAIN = false;
    const float* SSQ; const float* LB; bf16_t *QQ, *VV, *GS; float* LOGF;
    __device__ __forceinline__ void operator()(const f32x4 (&acc)[2][2][4][2], const Unit& u, int wr, int wc, int fr, int fq) const {
        const int rowb = u.pm * BM + wr * 64 + fr, type = u.pn >> 2, cl0 = (u.pn & 3) * BM + wc * 32 + 8 * fq;
#pragma unroll
        for (int ai = 0; ai < 2; ++ai)
#pragma unroll
            for (int m = 0; m < 4; ++m) {
                const int r = rowb + ai * HALF + m * 16;
                const f32x4* sp = (const f32x4*)(SSQ + (size_t)r * 16);
                const f32x4 s0 = sp[0], s1 = sp[1], s2 = sp[2], s3 = sp[3];
                const float tot = (((s0[0] + s0[1]) + (s0[2] + s0[3])) + ((s1[0] + s1[1]) + (s1[2] + s1[3]))) + (((s2[0] + s2[1]) + (s2[2] + s2[3])) + ((s3[0] + s3[1]) + (s3[2] + s3[3])));
                const float rs = __builtin_amdgcn_rsqf(tot * (1.0f / 1024.0f) + RMS_EPS);
#pragma unroll
                for (int bj = 0; bj < 2; ++bj) {
                    const f32x4 v0 = acc[ai][bj][m][0] * rs, v1 = acc[ai][bj][m][1] * rs;
                    const int c = cl0 + bj * HALF; const size_t off = (size_t)r * 1024 + c;
                    if (type == 0) *(u32x4*)(QQ + off) = pack8(silu4(v0), silu4(v1));
                    else if (type == 1) {
                        const f32x4 l0 = *(const f32x4*)(LB + c), l1 = *(const f32x4*)(LB + c + 4);
                        const f32x4 f0 = l0 + (1.0f - l0) * sigm4(v0), f1 = l1 + (1.0f - l1) * sigm4(v1);
                        *(f32x4*)(LOGF + off) = (f32x4){__logf(f0[0]), __logf(f0[1]), __logf(f0[2]), __logf(f0[3])};
                        *(f32x4*)(LOGF + off + 4) = (f32x4){__logf(f1[0]), __logf(f1[1]), __logf(f1[2]), __logf(f1[3])};
                    }
                    else if (type == 2) *(u32x4*)(VV + off) = pack8(v0, v1);
                    else *(u32x4*)(GS + off) = pack8(silu4(v0), silu4(v1));
                }
            }
    }
};
struct EpiOut1 {
    static constexpr bool PERM = false, AFTER_DRAIN = false;
    const float* X1; float* Y;
    __device__ __forceinline__ void operator()(const f32x4 (&acc)[2][2][4][2], const Unit& u, int wr, int wc, int fr, int fq) const {
        const int rowb = u.pm * BM + wr * 64 + fr, col0 = u.pn * BM + wc * 32 + 4 * fq;
#pragma unroll
        for (int ai = 0; ai < 2; ++ai)
#pragma unroll
            for (int m = 0; m < 4; ++m) {
                const size_t ro = (size_t)(rowb + ai * HALF + m * 16) * 1024 + col0;
#pragma unroll
                for (int bj = 0; bj < 2; ++bj)
#pragma unroll
                    for (int n = 0; n < 2; ++n) { const size_t o_ = ro + bj * HALF + n * 16; *(f32x4*)(Y + o_) = *(const f32x4*)(X1 + o_) + acc[ai][bj][m][n]; }
            }
    }
};
template <class Epi, class Sched, bool ALIGN_EPI = false, bool SP2 = false>
__device__ __forceinline__ void gemm_phase(PG8_LAS unsigned char* lds, const Gemm g, const Sched& S, const Epi& E) {
    const int tid = threadIdx.x, wid = __builtin_amdgcn_readfirstlane(tid >> 6), lane = tid & 63, wr = wid >> 2, wc = wid & 3, fr = lane & 15, fq = lane >> 4;
    const int K = g.K, nt = K / BK;
    unsigned voffA[2], voffB[2];
#pragma unroll
    for (int i = 0; i < 2; ++i) { int R, C; stage_rc(tid * 16 + i * 8192, R, C); const int Rb = Epi::PERM ? ((R & ~31) + perm32(R & 31)) : R;
        voffA[i] = (unsigned)(R * K + C) * 2u; voffB[i] = (unsigned)(Rb * K + C) * 2u; }
    const size_t kstep = (size_t)(BK * 2);
    const size_t hstep = (size_t)HALF * K * 2;
    const size_t tstep = 2 * hstep;
    const unsigned ldsw = (unsigned)wid * 1024u;
    const int aoff = lds_byte(wr * 64 + fr, fq * 8), boff = lds_byte(wc * 32 + fr, fq * 8);
#define PG8_SA(b, h) (((b) * 2 + (h)) * HTB)
#define PG8_SB(b, h) ((4 + (b) * 2 + (h)) * HTB)
#define PG8_STAGE(bufoff, gbase, voff) do { _Pragma("unroll") for (int _i = 0; _i < 2; ++_i) \
        __builtin_amdgcn_global_load_lds((const unsigned*)((const char*)(gbase) + (voff)[_i]), (PG8_LAS unsigned*)(lds + (bufoff) + ldsw + _i * 8192), 16, 0, 0); } while (0)
#define PG8_LDA(dst, b, h) do { _Pragma("unroll") for (int m = 0; m < 4; ++m) _Pragma("unroll") for (int k = 0; k < 2; ++k) dst[m][k] = *(const PG8_LAS bf16x8*)(lds + PG8_SA(b, h) + aoff + m * 2048 + k * 1024); } while (0)
#define PG8_LDB(dst, b, h) do { _Pragma("unroll") for (int n = 0; n < 2; ++n) _Pragma("unroll") for (int k = 0; k < 2; ++k) dst[n][k] = *(const PG8_LAS bf16x8*)(lds + PG8_SB(b, h) + boff + n * 2048 + k * 1024); } while (0)
#define PG8_MMA(ai, bj, At, Bt) do { __builtin_amdgcn_s_setprio(1); _Pragma("unroll") for (int m = 0; m < 4; ++m) _Pragma("unroll") for (int n = 0; n < 2; ++n) _Pragma("unroll") for (int k = 0; k < 2; ++k) \
        acc[ai][bj][m][n] = __builtin_amdgcn_mfma_f32_16x16x32_bf16(Bt[n][k], At[m][k], acc[ai][bj][m][n], 0, 0, 0); __builtin_amdgcn_s_setprio(0); } while (0)
#define PG8_WAIT_V(n) asm volatile("s_waitcnt vmcnt(" #n ")" ::: "memory")
#define PG8_WAIT_L(n) asm volatile("s_waitcnt lgkmcnt(" #n ")" ::: "memory")
#define PG8_BAR __builtin_amdgcn_s_barrier()
#define PG8_SCHED __builtin_amdgcn_sched_barrier(0)
    Unit cur, nxt; int ui = 0;
    if (!S.next(0, cur)) return;
    f32x4 acc[2][2][4][2];
#pragma unroll
    for (int a = 0; a < 2; ++a)
#pragma unroll
        for (int b = 0; b < 2; ++b)
#pragma unroll
            for (int m = 0; m < 4; ++m)
#pragma unroll
                for (int n = 0; n < 2; ++n) acc[a][b][m][n] = (f32x4){0.f, 0.f, 0.f, 0.f};
    bf16x8 At[4][2], B0[2][2], B1[2][2];
    const char* cA = (const char*)g.A + (size_t)cur.pm * tstep; const char* cB = (const char*)g.Bt + (size_t)cur.pn * tstep;
    S.a_ready(cur);
    if constexpr (SP2) {
        PG8_STAGE(PG8_SB(0, 0), cB, voffB); PG8_STAGE(PG8_SB(0, 1), cB + hstep, voffB); PG8_STAGE(PG8_SA(0, 0), cA, voffA); PG8_STAGE(PG8_SA(0, 1), cA + hstep, voffA);
        if (wr == 1) PG8_BAR;
        PG8_WAIT_V(2); PG8_BAR;
        PG8_STAGE(PG8_SB(1, 0), cB + kstep, voffB); PG8_STAGE(PG8_SA(1, 0), cA + kstep, voffA); PG8_STAGE(PG8_SB(1, 1), cB + hstep + kstep, voffB);
        PG8_WAIT_V(6); PG8_BAR;
    } else {
        PG8_STAGE(PG8_SB(0, 0), cB, voffB); PG8_STAGE(PG8_SA(0, 0), cA, voffA); PG8_STAGE(PG8_SB(0, 1), cB + hstep, voffB); PG8_STAGE(PG8_SA(0, 1), cA + hstep, voffA);
        if (wr == 1) PG8_BAR;
        PG8_WAIT_V(4); PG8_BAR;
        PG8_STAGE(PG8_SB(1, 0), cB + kstep, voffB); PG8_STAGE(PG8_SA(1, 0), cA + kstep, voffA); PG8_STAGE(PG8_SB(1, 1), cB + hstep + kstep, voffB);
        PG8_WAIT_V(6); PG8_BAR;
    }
    for (;;) {
        const bool has_next = S.next(ui + 1, nxt);
        const char* nA = has_next ? (const char*)g.A + (size_t)nxt.pm * tstep : cA; const char* nB = has_next ? (const char*)g.Bt + (size_t)nxt.pn * tstep : cB;
        for (int t = 0; t < nt; t += 2) {
            const bool last = (t == nt - 2);
            const char* a1 = cA + (size_t)(t + 1) * kstep;
            const char* a2 = last ? nA : cA + (size_t)(t + 2) * kstep; const char* b2 = last ? nB : cB + (size_t)(t + 2) * kstep;
            const char* a3 = a2 + kstep; const char* b3 = b2 + kstep;
            if (last && has_next) S.a_ready(nxt);
            if constexpr (SP2) {
            PG8_LDB(B0, 0, 0); PG8_LDB(B1, 0, 1); PG8_SCHED; PG8_LDA(At, 0, 0); PG8_STAGE(PG8_SA(1, 1), a1 + hstep, voffA);
            PG8_WAIT_V(8); PG8_WAIT_L(0); PG8_BAR; PG8_MMA(0, 0, At, B0); PG8_MMA(0, 1, At, B1); PG8_BAR; PG8_SCHED;
            PG8_LDA(At, 0, 1); PG8_STAGE(PG8_SB(0, 0), b2, voffB); PG8_STAGE(PG8_SB(0, 1), b2 + hstep, voffB); PG8_STAGE(PG8_SA(0, 0), a2, voffA);
            PG8_WAIT_V(8); PG8_WAIT_L(0); PG8_BAR; PG8_MMA(1, 0, At, B0); PG8_MMA(1, 1, At, B1); PG8_BAR; PG8_SCHED;
            PG8_LDB(B0, 1, 0); PG8_LDB(B1, 1, 1); PG8_SCHED; PG8_LDA(At, 1, 0); PG8_STAGE(PG8_SA(0, 1), a2 + hstep, voffA);
            PG8_WAIT_V(8); PG8_WAIT_L(0); PG8_BAR; PG8_MMA(0, 0, At, B0); PG8_MMA(0, 1, At, B1); PG8_BAR; PG8_SCHED;
            PG8_LDA(At, 1, 1); PG8_STAGE(PG8_SB(1, 0), b3, voffB); PG8_STAGE(PG8_SB(1, 1), b3 + hstep, voffB); PG8_STAGE(PG8_SA(1, 0), a3, voffA);
            PG8_WAIT_V(8); PG8_WAIT_L(0); PG8_BAR; PG8_MMA(1, 0, At, B0); PG8_MMA(1, 1, At, B1); PG8_BAR; PG8_SCHED;
            } else {
            PG8_LDB(B0, 0, 0); PG8_SCHED; PG8_LDA(At, 0, 0); PG8_STAGE(PG8_SA(1, 1), a1 + hstep, voffA);
            PG8_WAIT_L(8); PG8_BAR; PG8_WAIT_L(0); PG8_MMA(0, 0, At, B0); PG8_BAR; PG8_SCHED;
            PG8_LDB(B1, 0, 1); PG8_STAGE(PG8_SB(0, 0), b2, voffB);
            PG8_BAR; PG8_WAIT_L(0); PG8_MMA(0, 1, At, B1); PG8_BAR;
            PG8_LDA(At, 0, 1); PG8_STAGE(PG8_SA(0, 0), a2, voffA);
            PG8_BAR; PG8_WAIT_L(0); PG8_MMA(1, 0, At, B0); PG8_BAR; PG8_SCHED;
            PG8_STAGE(PG8_SB(0, 1), b2 + hstep, voffB);
            PG8_WAIT_V(6); PG8_BAR; PG8_MMA(1, 1, At, B1); PG8_BAR;
            PG8_LDB(B0, 1, 0); PG8_SCHED; PG8_LDA(At, 1, 0); PG8_STAGE(PG8_SA(0, 1), a2 + hstep, voffA);
            PG8_WAIT_L(8); PG8_BAR; PG8_WAIT_L(0); PG8_MMA(0, 0, At, B0); PG8_BAR; PG8_SCHED;
            PG8_LDB(B1, 1, 1); PG8_STAGE(PG8_SB(1, 0), b3, voffB);
            PG8_BAR; PG8_WAIT_L(0); PG8_MMA(0, 1, At, B1); PG8_BAR;
            PG8_LDA(At, 1, 1); PG8_STAGE(PG8_SA(1, 0), a3, voffA);
            PG8_BAR; PG8_WAIT_L(0); PG8_MMA(1, 0, At, B0); PG8_BAR; PG8_SCHED;
            PG8_STAGE(PG8_SB(1, 1), b3 + hstep, voffB);
            PG8_WAIT_V(6); PG8_BAR; PG8_MMA(1, 1, At, B1); PG8_BAR;
            }
        }
        if constexpr (ALIGN_EPI) { if (wr == 0) PG8_BAR; }
        if constexpr (!Epi::AFTER_DRAIN) { E(acc, cur, wr, wc, fr, fq); S.done(cur); }
        if (!has_next) break;
#pragma unroll
        for (int a = 0; a < 2; ++a)
#pragma unroll
            for (int b = 0; b < 2; ++b)
#pragma unroll
                for (int m = 0; m < 4; ++m)
#pragma unroll
                    for (int n = 0; n < 2; ++n) acc[a][b][m][n] = (f32x4){0.f, 0.f, 0.f, 0.f};
        cur = nxt; cA = nA; cB = nB; ++ui;
        if constexpr (ALIGN_EPI) { if (wr == 1) PG8_BAR; }
    }
    PG8_WAIT_V(0);
    if constexpr (!ALIGN_EPI) { if (wr == 0) PG8_BAR; }
    PG8_BAR;
    if constexpr (Epi::AFTER_DRAIN) { E.fused(acc, cur, wr, wc, fr, fq, lds, wid, lane); S.done(cur); }
#undef PG8_SA
#undef PG8_SB
#undef PG8_STAGE
#undef PG8_LDA
#undef PG8_LDB
#undef PG8_MMA
#undef PG8_WAIT_V
#undef PG8_WAIT_L
#undef PG8_BAR
#undef PG8_SCHED
}
}

constexpr int NWAVES = 8;
constexpr int D = 1024, MPROMPT = 16384, MSAMPLE = 512, MTOT = MPROMPT + MSAMPLE;
constexpr int SEQ = 4096, NB = 4, NDEC = 128, TDEC = 4;
constexpr int N0 = 3584, N1 = 4096;
constexpr size_t MiB = 1u << 20;
constexpr size_t WS_CTL = 0, CTL_ZERO_BYTES = 1 * MiB;
constexpr size_t WS_W0T = 2 * MiB, WS_WO0T = 10 * MiB, WS_W1T = 12 * MiB, WS_WO1T = 20 * MiB;
constexpr size_t WS_RSTD0 = 22 * MiB, WS_LB = 23 * MiB, WS_KMP = 24 * MiB, WS_SSQ = 26 * MiB;
constexpr size_t WS_XB = 64 * MiB, WS_Q = 128 * MiB, WS_K = 160 * MiB, WS_V = 192 * MiB, WS_GA = 224 * MiB, WS_U = 256 * MiB, WS_GC = 288 * MiB;
constexpr size_t WS_M0 = 320 * MiB, WS_X1 = 384 * MiB, WS_XB1 = 464 * MiB, WS_QQ = 512 * MiB, WS_LOGF = 576 * MiB, WS_VV = 656 * MiB, WS_GS = 704 * MiB;
constexpr size_t WS_M1 = 752 * MiB, WS_OLOC = 800 * MiB, WS_QBS = 880 * MiB, WS_USEG = 928 * MiB, WS_DSEG = 952 * MiB, WS_SC = 960 * MiB, WS_KMS = 1000 * MiB, WS_END = 1024 * MiB;
constexpr size_t WS_STAMP = 1010 * MiB, WS_OPART = 1004 * MiB, WS_LPART = 1007 * MiB;
constexpr int CW_BAR = 4096, CW_RDY = 16384;
constexpr int RING_BYTES = 131072, LDSCTL_OFF = RING_BYTES, MISC_OFF = LDSCTL_OFF + 320, LDS_BYTES = 147456;

#define GAS __attribute__((address_space(1)))
#define LAS __attribute__((address_space(3)))
typedef unsigned short bf16;
typedef unsigned v4u __attribute__((ext_vector_type(4)));
typedef float f32x4 __attribute__((ext_vector_type(4)));
typedef short bf16x8 __attribute__((ext_vector_type(8)));
#define LDS_WAIT() asm volatile("s_waitcnt lgkmcnt(0)" ::: "memory")
#define VM_WAIT() asm volatile("s_waitcnt vmcnt(0)" ::: "memory")
__device__ __forceinline__ unsigned f2bf(float f) { unsigned u = __builtin_bit_cast(unsigned, f); return (u + 0x7fffu + ((u >> 16) & 1u)) >> 16; }
__device__ __forceinline__ unsigned pk2(float lo, float hi) { return f2bf(lo) | (f2bf(hi) << 16); }
__device__ __forceinline__ float bf2f(unsigned short b) { return __builtin_bit_cast(float, ((unsigned)b) << 16); }
__device__ __forceinline__ float wave_sum(float v) {
#pragma unroll
    for (int o = 1; o < 64; o <<= 1) v += __shfl_xor(v, o);
    return v;
}
#define XB_TMO      128
#define XB_XCNT(j)  (256  + 64 * (j))
#define XB_XSUB(j)  (1280 + 64 * (j))
#define XB_XGEN(j)  (2304 + 64 * (j))
#define XB_TOP      3328
#define XB_TOPGEN   3392
#define XCD_BAR_WORDS 3456
#define XB_SPIN_CAP (1u << 18)
#define LAS __attribute__((address_space(3)))

__device__ __forceinline__ unsigned xb_ld(unsigned* p)              { return __hip_atomic_load(p, __ATOMIC_RELAXED, __HIP_MEMORY_SCOPE_AGENT); }
__device__ __forceinline__ unsigned xb_add(unsigned* p, unsigned v) { return __hip_atomic_fetch_add(p, v, __ATOMIC_RELAXED, __HIP_MEMORY_SCOPE_AGENT); }
__device__ __forceinline__ unsigned xb_xcc_id() { return (unsigned)__builtin_amdgcn_s_getreg((3 << 11) | 20) & 0xFu; }
#define XB_SPIN(cond, bar) do { unsigned _sp = 0; while (cond) { __builtin_amdgcn_s_sleep(1); \
    if ((++_sp & 255u) == 0u) { if (xb_ld(&(bar)[XB_TMO])) break; if (_sp > XB_SPIN_CAP) { atomicAdd(&(bar)[XB_TMO], 1u); break; } } } } while (0)

struct XcdBarrier {
    unsigned* bar; unsigned x;
    volatile LAS unsigned* st;
};

__device__ __forceinline__ XcdBarrier xcd_barrier_post(unsigned* bar, volatile LAS unsigned* st) {
    XcdBarrier b; b.bar = bar; b.x = xb_xcc_id(); b.st = st;
    if (threadIdx.x == 0) (void)xb_add(&bar[XB_XCNT(b.x)], 1u);
    return b;
}
__device__ __forceinline__ void xcd_barrier_complete(unsigned* bar, unsigned x, unsigned& nloc, unsigned& nx) {
    const unsigned G = gridDim.x * gridDim.y * gridDim.z;
    unsigned sum, cnt, mine, sp = 0u;
    for (;;) {
        sum = 0u; cnt = 0u; mine = 0u;
#pragma unroll
        for (unsigned j = 0; j < 16; ++j) { const unsigned c = xb_ld(&bar[XB_XCNT(j)]); sum += c; cnt += (c > 0u) ? 1u : 0u; mine = (j == x) ? c : mine; }
        if (sum == G) break;
        __builtin_amdgcn_s_sleep(1);
        if ((++sp & 255u) == 0u) { if (xb_ld(&bar[XB_TMO])) break; if (sp > XB_SPIN_CAP) { atomicAdd(&bar[XB_TMO], 1u); break; } }
    }
    nloc = mine > 0u ? mine : 1u; nx = cnt > 0u ? cnt : 1u;
}

__device__ __forceinline__ void xcd_barrier(const XcdBarrier& b) {
    asm volatile("s_waitcnt vmcnt(0)" ::: "memory");
    __syncthreads();
    if (threadIdx.x == 0) {
        unsigned* bar = b.bar;
        __builtin_amdgcn_s_waitcnt(0);
        unsigned nloc = b.st[0], nx = b.st[1];
        if (nloc == 0u) { xcd_barrier_complete(bar, b.x, nloc, nx); b.st[0] = nloc; b.st[1] = nx; }
        const unsigned old = xb_add(&bar[XB_XSUB(b.x)], 1u);
        const unsigned gen = old / nloc;
        if (old + 1u == (gen + 1u) * nloc) {
            __builtin_amdgcn_fence(__ATOMIC_RELEASE, "agent");
            asm volatile("s_waitcnt vmcnt(0)" ::: "memory");
            const unsigned og = xb_add(&bar[XB_TOP], 1u);
            const unsigned tg = og / nx;
            if (og + 1u == (tg + 1u) * nx) xb_add(&bar[XB_TOPGEN], 1u);
            else XB_SPIN(xb_ld(&bar[XB_TOPGEN]) == tg, bar);
            __builtin_amdgcn_fence(__ATOMIC_ACQUIRE, "agent");
            xb_add(&bar[XB_XGEN(b.x)], 1u);
            asm volatile("s_waitcnt vmcnt(0)" ::: "memory");
        } else {
            XB_SPIN(xb_ld(&bar[XB_XGEN(b.x)]) == gen, bar);
            __builtin_amdgcn_fence(__ATOMIC_ACQUIRE, "agent");
            asm volatile("s_waitcnt vmcnt(0)" ::: "memory");
        }
    }
    __syncthreads();
}

constexpr size_t O_Y = 0, O_KP = 17301504, O_VP = O_KP + 8388608, O_KS = O_VP + 8388608, O_VS = O_KS + 262144, O_CP = O_VS + 262144, O_CS = O_CP + 61440, O_HP = O_CS + 1966080, O_HS = O_HP + 524288, O_END = O_HS + 16777216;
enum { I_XP = 0, I_XS, I_CK, I_CV, I_SCONV, I_SHGRN, I_PT, I_NORM0, I_WIN0, I_QN, I_KN, I_CW, I_CB, I_LNG, I_LNB, I_WOUT0, I_NORM1, I_WIN1, I_LBL, I_ONORM, I_WOUT1, N_IN };
struct Args { const void* in[N_IN]; float* out; unsigned char* ws; };

__device__ __forceinline__ void p0_transpose_item(const float* W, int K, int N, bf16* WT, int k0, int n0, int drow0, const float* gain, LAS float* scr, int lane) {
#pragma unroll
    for (int i = 0; i < 8; ++i) { const int kk = (lane >> 3) + 8 * i, n4 = (lane & 7) * 4; const float gsc = gain ? gain[k0 + kk] : 1.0f;
        const f32x4 w = *(const f32x4*)(W + (size_t)(k0 + kk) * N + n0 + n4);
        scr[kk * 33 + n4] = w[0] * gsc; scr[kk * 33 + n4 + 1] = w[1] * gsc; scr[kk * 33 + n4 + 2] = w[2] * gsc; scr[kk * 33 + n4 + 3] = w[3] * gsc; }
    LDS_WAIT(); asm volatile("" ::: "memory");
    const int c = lane & 7;
#pragma unroll
    for (int j = 0; j < 4; ++j) { const int n = (lane >> 3) + 8 * j; const LAS float* s = scr + (8 * c) * 33 + n;
        v4u o; o.x = pk2(s[0 * 33], s[1 * 33]); o.y = pk2(s[2 * 33], s[3 * 33]); o.z = pk2(s[4 * 33], s[5 * 33]); o.w = pk2(s[6 * 33], s[7 * 33]);
        *(GAS v4u*)(WT + (size_t)(drow0 + n) * K + k0 + 8 * c) = o; }
    LDS_WAIT(); asm volatile("" ::: "memory");
}
__device__ __forceinline__ int l0_src_group(int dg) {
    const int pnD = dg >> 3, gi = dg & 7, bj = gi >> 2, wc = gi & 3;
    if (pnD >= 8 && pnD < 12) return (bj ? 80 : 64) + 4 * (pnD - 8) + wc;
    return 8 * pnD + 2 * wc + bj;
}


__device__ __forceinline__ void conv_phase(LAS unsigned char* lds, int vcu, int G, const bf16* U, const bf16* GCs, const float* state_conv,
                                           const float* cw, const float* cb, const float* lng, const float* lnb, bf16* M0) {
    const int tid = threadIdx.x, c = tid, wave = tid >> 6, lane = tid & 63;
    LAS float* Y = (LAS float*)lds;
    LAS float* ST = (LAS float*)(lds + 32768);
    float w[31];
#pragma unroll
    for (int i = 0; i < 31; ++i) w[i] = cw[i * 512 + c];
    const float bias = cb[c], gg = lng[c], be = lnb[c];
    for (int unit = vcu; unit < 1056; unit += G) {
        float y[16];
        if (unit < 1024) {
            const int r0 = unit * 16, tok0 = r0 & 4095;
            float uw[46];
#pragma unroll
            for (int i = 0; i < 46; ++i) { const int tt = tok0 - 30 + i; uw[i] = tt >= 0 ? bf2f(U[(size_t)(r0 - 30 + i) * 512 + c]) : 0.f; }
#pragma unroll
            for (int t = 0; t < 16; ++t) { float a = bias;
#pragma unroll
                for (int i = 0; i < 31; ++i) a += w[i] * uw[t + i];
                y[t] = a; }
        } else {
            const int s0 = (unit - 1024) * 4;
#pragma unroll
            for (int sq = 0; sq < 4; ++sq) { const int n = s0 + sq; float uw[34];
#pragma unroll
                for (int i = 0; i < 30; ++i) uw[i] = state_conv[((size_t)n * 30 + i) * 512 + c];
#pragma unroll
                for (int i = 0; i < 4; ++i) uw[30 + i] = bf2f(U[(size_t)(MPROMPT + n * 4 + i) * 512 + c]);
#pragma unroll
                for (int t = 0; t < 4; ++t) { float a = bias;
#pragma unroll
                    for (int i = 0; i < 31; ++i) a += w[i] * uw[t + i];
                    y[sq * 4 + t] = a; } }
        }
#pragma unroll
        for (int t = 0; t < 16; ++t) Y[t * 512 + c] = y[t];
        __syncthreads();
#pragma unroll
        for (int k = 0; k < 2; ++k) { const int t = 2 * wave + k; float v[8]; float s = 0.f;
#pragma unroll
            for (int j = 0; j < 8; ++j) { v[j] = Y[t * 512 + lane + 64 * j]; s += v[j]; }
            const float mean = wave_sum(s) * (1.0f / 512.0f); float q = 0.f;
#pragma unroll
            for (int j = 0; j < 8; ++j) { const float d = v[j] - mean; q += d * d; }
            const float var = wave_sum(q) * (1.0f / 512.0f);
            if (lane == 0) { ST[2 * t] = mean; ST[2 * t + 1] = 1.0f / sqrtf(var + 1e-6f); } }
        __syncthreads();
        const int rbase = unit < 1024 ? unit * 16 : MPROMPT + (unit - 1024) * 16;
#pragma unroll
        for (int t = 0; t < 16; ++t) { const float ln = (y[t] - ST[2 * t]) * ST[2 * t + 1] * gg + be; const float oc = pg8::fsilu(ln); const size_t r = (size_t)(rbase + t);
            M0[r * 1024 + 512 + c] = (bf16)f2bf(oc * bf2f(GCs[r * 512 + c])); }
        __syncthreads();
    }
}


typedef unsigned u32x4_t __attribute__((ext_vector_type(4)));
typedef unsigned u32x2_t __attribute__((ext_vector_type(2)));
__device__ __forceinline__ float fexp(float x) { return __builtin_amdgcn_exp2f(x * 1.4426950408889634f); }
__device__ __forceinline__ bf16x8 mk_frag(u32x2_t a, u32x2_t b) { u32x4_t w; w.x = a.x; w.y = a.y; w.z = b.x; w.w = b.y; return __builtin_bit_cast(bf16x8, w); }
__device__ __forceinline__ unsigned cvtpk(float lo, float hi) { return pg8::cvt_pk_bf16(lo, hi); }
typedef float f32x2_t __attribute__((ext_vector_type(2))); typedef __bf16 bf16x2_t __attribute__((ext_vector_type(2)));
__device__ __forceinline__ unsigned cvtpk_nv(float lo, float hi) { f32x2_t v = {lo, hi}; bf16x2_t b = __builtin_convertvector(v, bf16x2_t); return __builtin_bit_cast(unsigned, b); }
constexpr int P1_QB = 0, P1_QT = 17408, P1_QTS = 34816, P1_KD = 47872, P1_KE = 65280, P1_KLT = 78336, P1_VT = 96768, P1_AB = 115200, P1_TOT = 124416, P1_DV = 126464;
constexpr int RP = 272, RS = 144;

__device__ __forceinline__ void scan_a_block(LAS unsigned char* lds, int aoff, int boff, int I, int J, bool diag, int lane) {
    const int l15 = lane & 15, g4 = lane >> 4;
    f32x4 acc = (f32x4){0.f, 0.f, 0.f, 0.f};
#pragma unroll
    for (int ks = 0; ks < 4; ++ks) {
        const bf16x8 a = *(const LAS bf16x8*)(lds + aoff + l15 * RP + (32 * ks + 8 * g4) * 2);
        const bf16x8 b = *(const LAS bf16x8*)(lds + boff + l15 * RP + (32 * ks + 8 * g4) * 2);
        acc = __builtin_amdgcn_mfma_f32_16x16x32_bf16(a, b, acc, 0, 0, 0);
    }
#pragma unroll
    for (int r = 0; r < 4; ++r) { const int t = 4 * g4 + r; const float v = (diag && l15 > t) ? 0.f : acc[r];
        *(LAS unsigned short*)(lds + P1_AB + (16 * I + t) * RS + (16 * J + l15) * 2) = (unsigned short)f2bf(v); }
}

__device__ __forceinline__ void scan_pass1(LAS unsigned char* lds, int vcu, int G, const bf16* QQ, const float* LOGF, const bf16* VV, float* OLOC, bf16* QBS, float* USEG, float* DSEG) {
    const int tid = threadIdx.x, lane = tid & 63, wave = __builtin_amdgcn_readfirstlane(tid >> 6), l15 = lane & 15, g4 = lane >> 4;
    const int k = tid & 127, I = __builtin_amdgcn_readfirstlane(tid >> 7);
    LAS float* TOT = (LAS float*)(lds + P1_TOT); LAS float* DV = (LAS float*)(lds + P1_DV);
    for (int unit = vcu; unit < 256; unit += G) {
        const int b = unit >> 6, h = (unit >> 3) & 7, g = unit & 7;
        for (int i = tid; i < 64 * RS / 4; i += 512) ((LAS unsigned*)(lds + P1_AB))[i] = 0u;
        f32x4 S[8];
#pragma unroll
        for (int kt = 0; kt < 8; ++kt) S[kt] = (f32x4){0.f, 0.f, 0.f, 0.f};
        float Bprev = 0.f;
        __syncthreads();
        for (int ch = 0; ch < 8; ++ch) {
            const size_t row0 = (size_t)b * 4096 + g * 512 + ch * 64;
            float lf[16], c[16]; unsigned short qv[16], vvv[16];
#pragma unroll
            for (int i = 0; i < 16; ++i) { const size_t o = (row0 + 16 * I + i) * 1024 + h * 128 + k; lf[i] = LOGF[o]; qv[i] = QQ[o]; vvv[i] = VV[o]; }
            { u32x4_t w0, w1;
              w0.x = vvv[0] | ((unsigned)vvv[1] << 16); w0.y = vvv[2] | ((unsigned)vvv[3] << 16); w0.z = vvv[4] | ((unsigned)vvv[5] << 16); w0.w = vvv[6] | ((unsigned)vvv[7] << 16);
              w1.x = vvv[8] | ((unsigned)vvv[9] << 16); w1.y = vvv[10] | ((unsigned)vvv[11] << 16); w1.z = vvv[12] | ((unsigned)vvv[13] << 16); w1.w = vvv[14] | ((unsigned)vvv[15] << 16);
              *(LAS u32x4_t*)(lds + P1_VT + k * RS + I * 32) = w0; *(LAS u32x4_t*)(lds + P1_VT + k * RS + I * 32 + 16) = w1; }
            c[0] = lf[0];
#pragma unroll
            for (int i = 1; i < 16; ++i) c[i] = c[i - 1] + lf[i];
            TOT[I * 128 + k] = c[15];
            __syncthreads();
            const float t0 = TOT[k], t1 = TOT[128 + k], t2 = TOT[256 + k], t3 = TOT[384 + k];
            const float rI = I == 0 ? 0.f : (I == 1 ? t0 : (I == 2 ? t0 + t1 : (t0 + t1) + t2));
            const float totI = I == 0 ? t0 : (I == 1 ? t1 : (I == 2 ? t2 : t3));
            const float btot = (t0 + t1) + (t2 + t3);
            const float e_rI = fexp(rI), e_prev = fexp(Bprev), e_klt = fexp(btot - rI - totI);
            const float sc1 = I == 2 ? fexp(t1) : fexp(t2), sc2 = fexp(t2 + t1);
            unsigned kl2[8];
#pragma unroll
            for (int i = 0; i < 16; ++i) {
                const int t = 16 * I + i;
                const float q = bf2f(qv[i]);
                const float qt = q * fexp(c[i]), qb = qt * e_rI;
                const float kk = 1.0f - fexp(lf[i]);
                const float kd = kk * fexp(fminf(-c[i], 80.f)), ke = kk * fexp(totI - c[i]), kl = ke * e_klt;
                *(LAS unsigned short*)(lds + P1_QB + t * RP + k * 2) = (unsigned short)f2bf(qb);
                *(LAS unsigned short*)(lds + P1_QT + t * RP + k * 2) = (unsigned short)f2bf(qt);
                *(LAS unsigned short*)(lds + P1_KD + t * RP + k * 2) = (unsigned short)f2bf(kd);
                if (I < 3) *(LAS unsigned short*)(lds + P1_KE + t * RP + k * 2) = (unsigned short)f2bf(ke);
                if (I == 2) *(LAS unsigned short*)(lds + P1_QTS + i * RP + k * 2) = (unsigned short)f2bf(qt * sc1);
                if (I == 3) { *(LAS unsigned short*)(lds + P1_QTS + (16 + i) * RP + k * 2) = (unsigned short)f2bf(qt * sc1); *(LAS unsigned short*)(lds + P1_QTS + (32 + i) * RP + k * 2) = (unsigned short)f2bf(qt * sc2); }
                QBS[(row0 + t) * 1024 + h * 128 + k] = (bf16)f2bf(qb * e_prev);
                if (i & 1) kl2[i >> 1] |= f2bf(kl) << 16; else kl2[i >> 1] = f2bf(kl);
            }
            { u32x4_t w0, w1; w0.x = kl2[0]; w0.y = kl2[1]; w0.z = kl2[2]; w0.w = kl2[3]; w1.x = kl2[4]; w1.y = kl2[5]; w1.z = kl2[6]; w1.w = kl2[7];
              *(LAS u32x4_t*)(lds + P1_KLT + k * RS + I * 32) = w0; *(LAS u32x4_t*)(lds + P1_KLT + k * RS + I * 32 + 16) = w1; }
            if (I == 0) DV[k] = fexp(btot);
            Bprev += btot;
            __syncthreads();
            if (wave < 4) scan_a_block(lds, P1_QT + 16 * wave * RP, P1_KD + 16 * wave * RP, wave, wave, true, lane);
            else if (wave < 7) scan_a_block(lds, P1_QT + 16 * (wave - 3) * RP, P1_KE + 16 * (wave - 4) * RP, wave - 3, wave - 4, false, lane);
            else scan_a_block(lds, P1_QTS, P1_KE, 2, 0, false, lane);
            if (wave == 0) scan_a_block(lds, P1_QTS + 16 * RP, P1_KE + 16 * RP, 3, 1, false, lane);
            if (wave == 1) scan_a_block(lds, P1_QTS + 32 * RP, P1_KE, 3, 0, false, lane);
            __syncthreads();
            {
                bf16x8 vfr[2];
#pragma unroll
                for (int ss = 0; ss < 2; ++ss) vfr[ss] = *(const LAS bf16x8*)(lds + P1_VT + (16 * wave + l15) * RS + (32 * ss + 8 * g4) * 2);
                bf16x8 sfr[4];
#pragma unroll
                for (int ks = 0; ks < 4; ++ks) { u32x4_t w; w.x = cvtpk(S[2 * ks][0], S[2 * ks][1]); w.y = cvtpk(S[2 * ks][2], S[2 * ks][3]); w.z = cvtpk(S[2 * ks + 1][0], S[2 * ks + 1][1]); w.w = cvtpk(S[2 * ks + 1][2], S[2 * ks + 1][3]); sfr[ks] = __builtin_bit_cast(bf16x8, w); }
#pragma unroll
                for (int ti = 0; ti < 4; ++ti) {
                    f32x4 o = (f32x4){0.f, 0.f, 0.f, 0.f};
#pragma unroll
                    for (int ks = 0; ks < 4; ++ks) {
                        const u32x2_t a0 = *(const LAS u32x2_t*)(lds + P1_QB + (16 * ti + l15) * RP + (32 * ks + 4 * g4) * 2);
                        const u32x2_t a1 = *(const LAS u32x2_t*)(lds + P1_QB + (16 * ti + l15) * RP + (32 * ks + 16 + 4 * g4) * 2);
                        o = __builtin_amdgcn_mfma_f32_16x16x32_bf16(sfr[ks], mk_frag(a0, a1), o, 0, 0, 0);
                    }
#pragma unroll
                    for (int ss = 0; ss < 2; ++ss) {
                        const bf16x8 a = *(const LAS bf16x8*)(lds + P1_AB + (16 * ti + l15) * RS + (32 * ss + 8 * g4) * 2);
                        o = __builtin_amdgcn_mfma_f32_16x16x32_bf16(vfr[ss], a, o, 0, 0, 0);
                    }
                    *(f32x4*)(OLOC + (row0 + 16 * ti + l15) * 1024 + h * 128 + 16 * wave + 4 * g4) = o;
                }
#pragma unroll
                for (int kt = 0; kt < 8; ++kt) {
                    const f32x4 dv = *(const LAS f32x4*)(lds + P1_DV + (16 * kt + 4 * g4) * 4);
                    S[kt] = S[kt] * dv;
#pragma unroll
                    for (int ss = 0; ss < 2; ++ss) {
                        const bf16x8 a = *(const LAS bf16x8*)(lds + P1_KLT + (16 * kt + l15) * RS + (32 * ss + 8 * g4) * 2);
                        S[kt] = __builtin_amdgcn_mfma_f32_16x16x32_bf16(a, vfr[ss], S[kt], 0, 0, 0);
                    }
                }
            }
            __syncthreads();
        }
#pragma unroll
        for (int kt = 0; kt < 8; ++kt)
#pragma unroll
            for (int r = 0; r < 4; ++r) USEG[((size_t)unit * 128 + 16 * kt + 4 * g4 + r) * 128 + 16 * wave + l15] = S[kt][r];
        if (I == 0) DSEG[unit * 128 + k] = fexp(Bprev);
    }
}

__device__ __forceinline__ void scan_sample(LAS unsigned char* lds, int vcu, int G, const bf16* QQ, const float* LOGF, const bf16* VV, const bf16* GS, const float* og,
                                            const float* S0, float* Sout, bf16* M1) {
    const int tid = threadIdx.x, lane = tid & 63, wave = tid >> 6, v = tid & 127, kq = tid >> 7;
    LAS float* FS = (LAS float*)lds; LAS float* QS = FS + 512; LAS float* VS = QS + 512; LAS float* PART = VS + 512; LAS float* RED = PART + 2048;
    for (int su = vcu; su < 1024; su += G) {
        const int n = su >> 3, h = su & 7;
        float S[32];
        const float* s0 = S0 + (((size_t)(n * 8 + h)) * 128 + kq * 32) * 128 + v;
#pragma unroll
        for (int i = 0; i < 32; ++i) S[i] = s0[(size_t)i * 128];
        { const size_t o = (size_t)(MPROMPT + n * 4 + kq) * 1024 + h * 128 + v; FS[kq * 128 + v] = fexp(LOGF[o]); QS[kq * 128 + v] = bf2f(QQ[o]); VS[kq * 128 + v] = bf2f(VV[o]); }
        __syncthreads();
        float po[4];
#pragma unroll
        for (int t = 0; t < 4; ++t) { const float vv = VS[t * 128 + v]; float p = 0.f;
#pragma unroll
            for (int i = 0; i < 32; ++i) { const int kk = kq * 32 + i; const float f = FS[t * 128 + kk]; S[i] = f * S[i] + (1.0f - f) * vv; p += QS[t * 128 + kk] * S[i]; }
            po[t] = p; }
#pragma unroll
        for (int t = 0; t < 4; ++t) PART[(kq * 4 + t) * 128 + v] = po[t];
        float* so = Sout + (((size_t)(n * 8 + h)) * 128 + kq * 32) * 128 + v;
#pragma unroll
        for (int i = 0; i < 32; ++i) so[(size_t)i * 128] = S[i];
        __syncthreads();
        const int t = kq;
        const float o = (PART[(0 * 4 + t) * 128 + v] + PART[(1 * 4 + t) * 128 + v]) + (PART[(2 * 4 + t) * 128 + v] + PART[(3 * 4 + t) * 128 + v]);
        const float ss = wave_sum(o * o);
        if (lane == 0) RED[wave] = ss;
        __syncthreads();
        const float rs = __builtin_amdgcn_rsqf((RED[2 * t] + RED[2 * t + 1]) * (1.0f / 128.0f) + 1e-6f);
        const size_t ro = (size_t)(MPROMPT + n * 4 + t) * 1024 + h * 128 + v;
        M1[ro] = (bf16)f2bf(o * rs * og[v] * bf2f(GS[ro]));
        __syncthreads();
    }
}

constexpr int P3_SIN = 0;
__device__ __forceinline__ void scan_pass3(LAS unsigned char* lds, int vcu, int G, const bf16* QBS, const float* OLOC, const float* USEG, const float* DSEG, const bf16* GS, const float* og,
                                           bf16* M1, float* hgrn_prompt) {
    const int tid = threadIdx.x, lane = tid & 63, wave = __builtin_amdgcn_readfirstlane(tid >> 6), l15 = lane & 15, g4 = lane >> 4, v = tid & 127, kq = tid >> 7;
    for (int u3 = vcu; u3 < 512; u3 += G) {
        const int half = u3 & 1, g = (u3 >> 1) & 7, h = (u3 >> 4) & 7, b = u3 >> 7, bh = b * 8 + h;
        float S[32];
#pragma unroll
        for (int i = 0; i < 32; ++i) S[i] = 0.f;
        for (int gp = 0; gp < g; ++gp) {
            const float* U = USEG + (((size_t)(bh * 8 + gp)) * 128 + kq * 32) * 128 + v; const float* Dg = DSEG + (bh * 8 + gp) * 128 + kq * 32;
#pragma unroll
            for (int i = 0; i < 32; ++i) S[i] = Dg[i] * S[i] + U[(size_t)i * 128];
        }
        if (g == 7 && half == 0) {
            const float* U = USEG + (((size_t)(bh * 8 + 7)) * 128 + kq * 32) * 128 + v; const float* Dg = DSEG + (bh * 8 + 7) * 128 + kq * 32;
            float* hp = hgrn_prompt + (((size_t)bh) * 128 + kq * 32) * 128 + v;
#pragma unroll
            for (int i = 0; i < 32; ++i) hp[(size_t)i * 128] = Dg[i] * S[i] + U[(size_t)i * 128];
        }
#pragma unroll
        for (int j = 0; j < 4; ++j) { u32x4_t w; w.x = cvtpk(S[8 * j], S[8 * j + 1]); w.y = cvtpk(S[8 * j + 2], S[8 * j + 3]); w.z = cvtpk(S[8 * j + 4], S[8 * j + 5]); w.w = cvtpk(S[8 * j + 6], S[8 * j + 7]);
            *(LAS u32x4_t*)(lds + P3_SIN + v * RP + (kq * 32 + 8 * j) * 2) = w; }
        __syncthreads();
        const size_t rbase = (size_t)b * 4096 + g * 512 + half * 256 + 32 * wave;
        f32x4 acc[2][8];
#pragma unroll
        for (int ti = 0; ti < 2; ++ti)
#pragma unroll
            for (int vt = 0; vt < 8; ++vt) acc[ti][vt] = (f32x4){0.f, 0.f, 0.f, 0.f};
        if (g > 0) {
#pragma unroll
            for (int ks = 0; ks < 4; ++ks) {
                bf16x8 afr[2];
#pragma unroll
                for (int ti = 0; ti < 2; ++ti) afr[ti] = *(const bf16x8*)(QBS + (rbase + 16 * ti + l15) * 1024 + h * 128 + 32 * ks + 8 * g4);
#pragma unroll
                for (int vt = 0; vt < 8; ++vt) { const bf16x8 bfr = *(const LAS bf16x8*)(lds + P3_SIN + (16 * vt + l15) * RP + (32 * ks + 8 * g4) * 2);
#pragma unroll
                    for (int ti = 0; ti < 2; ++ti) acc[ti][vt] = __builtin_amdgcn_mfma_f32_16x16x32_bf16(bfr, afr[ti], acc[ti][vt], 0, 0, 0); }
            }
        }
        f32x4 ogv[8];
#pragma unroll
        for (int vt = 0; vt < 8; ++vt) ogv[vt] = *(const f32x4*)(og + 16 * vt + 4 * g4);
#pragma unroll
        for (int ti = 0; ti < 2; ++ti) {
            const size_t ro = (rbase + 16 * ti + l15) * 1024 + h * 128 + 4 * g4;
            float ss = 0.f;
#pragma unroll
            for (int vt = 0; vt < 8; ++vt) { acc[ti][vt] += *(const f32x4*)(OLOC + ro + 16 * vt); ss += pg8::dot4(acc[ti][vt]); }
            ss += __shfl_xor(ss, 16); ss += __shfl_xor(ss, 32);
            const float rs = __builtin_amdgcn_rsqf(ss * (1.0f / 128.0f) + 1e-6f);
#pragma unroll
            for (int vt = 0; vt < 8; ++vt) {
                const u32x2_t gw = *(const u32x2_t*)(GS + ro + 16 * vt);
                const f32x4 gsv = (f32x4){__builtin_bit_cast(float, gw.x << 16), __builtin_bit_cast(float, gw.x & 0xffff0000u), __builtin_bit_cast(float, gw.y << 16), __builtin_bit_cast(float, gw.y & 0xffff0000u)};
                const f32x4 r4 = acc[ti][vt] * rs * ogv[vt] * gsv;
                u32x2_t w; w.x = cvtpk_nv(r4[0], r4[1]); w.y = cvtpk_nv(r4[2], r4[3]);
                *(u32x2_t*)(M1 + ro + 16 * vt) = w;
            }
        }
        __syncthreads();
    }
}


typedef float f32x16 __attribute__((ext_vector_type(16)));
typedef short v4i16_t __attribute__((ext_vector_type(4)));
constexpr int AT_KV = 0;
constexpr int AT_PITCH = 144, AT_TILE = 64 * AT_PITCH, AT_BUF = 2 * AT_TILE;
constexpr int AT_KM = 2 * AT_BUF;
constexpr int AT_WS = AT_KM + 4096;
constexpr float SM_C = 0.125f * 1.4426950408889634f;
__device__ __forceinline__ int crow(int r, int hi) { return (r & 3) + 8 * (r >> 2) + 4 * hi; }


struct StreamA {
    const bf16* Qb; const float* cache_k; const int* pt; float* SC; float* KMS;
    int vcu, G, h, rowi, kq;
    int s, nsteps;
    f32x4 ld[4]; f32x4 ks[2][2]; bf16x8 qfr[2]; int pg0, pg1; float* scb; int cn, cblk;
    __device__ __forceinline__ void init(const bf16* Qb_, const float* ck, const int* pt_, float* SC_, float* KMS_, int vcu_, int G_, int lane, int wave) {
        Qb = Qb_; cache_k = ck; pt = pt_; SC = SC_; KMS = KMS_; vcu = vcu_; G = G_; h = wave; rowi = lane & 15; kq = lane >> 4;
        s = 0; const int nun = vcu < 1024 ? (1024 - vcu + G - 1) / G : 0; nsteps = nun * 16;
        if (nsteps) { setup(); issue(); }
    }
    __device__ __forceinline__ void setup() {
        const int unit = vcu + (s >> 4) * G; cn = unit >> 3; cblk = unit & 7;
#pragma unroll
        for (int q = 0; q < 2; ++q) { u32x4_t w = (u32x4_t){0u, 0u, 0u, 0u}; if (rowi < 4) w = *(const u32x4_t*)(Qb + (size_t)(MPROMPT + cn * 4 + rowi) * 512 + h * 64 + 32 * q + 8 * kq); qfr[q] = __builtin_bit_cast(bf16x8, w); }
        pg0 = pt[cn * 16 + cblk * 2]; pg1 = pt[cn * 16 + cblk * 2 + 1];
#pragma unroll
        for (int q = 0; q < 2; ++q) { ks[q][0] = (f32x4){0.f, 0.f, 0.f, 0.f}; ks[q][1] = (f32x4){0.f, 0.f, 0.f, 0.f}; }
        scb = SC + (((size_t)cn * 8 + h) * 4 + rowi) * 2048 + cblk * 256 + 4 * kq;
    }
    __device__ __forceinline__ void issue() {
        const int rg = s & 15; const int page = rg < 8 ? pg0 : pg1;
        const float* base = cache_k + (((size_t)page * 128 + ((16 * rg + rowi) & 127)) * 8 + h) * 64 + 8 * kq;
        ld[0] = __builtin_nontemporal_load((const f32x4*)(base)); ld[1] = __builtin_nontemporal_load((const f32x4*)(base + 4));
        ld[2] = __builtin_nontemporal_load((const f32x4*)(base + 32)); ld[3] = __builtin_nontemporal_load((const f32x4*)(base + 36));
    }
    __device__ __forceinline__ void step() {
        if (s >= nsteps) return;
        const int rg = s & 15;
        ks[0][0] += ld[0]; ks[0][1] += ld[1]; ks[1][0] += ld[2]; ks[1][1] += ld[3];
        u32x4_t wa, wb;
        wa.x = cvtpk_nv(ld[0][0], ld[0][1]); wa.y = cvtpk_nv(ld[0][2], ld[0][3]); wa.z = cvtpk_nv(ld[1][0], ld[1][1]); wa.w = cvtpk_nv(ld[1][2], ld[1][3]);
        wb.x = cvtpk_nv(ld[2][0], ld[2][1]); wb.y = cvtpk_nv(ld[2][2], ld[2][3]); wb.z = cvtpk_nv(ld[3][0], ld[3][1]); wb.w = cvtpk_nv(ld[3][2], ld[3][3]);
        f32x4 acc = (f32x4){0.f, 0.f, 0.f, 0.f};
        acc = __builtin_amdgcn_mfma_f32_16x16x32_bf16(__builtin_bit_cast(bf16x8, wa), qfr[0], acc, 0, 0, 0);
        acc = __builtin_amdgcn_mfma_f32_16x16x32_bf16(__builtin_bit_cast(bf16x8, wb), qfr[1], acc, 0, 0, 0);
        if (rowi < 4) *(f32x4*)(scb + 16 * rg) = acc;
        if (rg == 15) {
#pragma unroll
            for (int q = 0; q < 2; ++q)
#pragma unroll
                for (int e = 0; e < 2; ++e) {
                    f32x4 v = ks[q][e];
#pragma unroll
                    for (int o = 1; o < 16; o <<= 1) { v[0] += __shfl_xor(v[0], o); v[1] += __shfl_xor(v[1], o); v[2] += __shfl_xor(v[2], o); v[3] += __shfl_xor(v[3], o); }
                    if (rowi == 0) *(f32x4*)(KMS + ((size_t)cn * 8 + cblk) * 512 + h * 64 + 32 * q + 8 * kq + 4 * e) = v * (1.0f / 256.0f);
                }
        }
        ++s;
        if (s < nsteps) { if ((s & 15) == 0) setup(); issue(); }
    }
    __device__ __forceinline__ void drain() { while (s < nsteps) step(); }
};

__device__ __forceinline__ void attn_prompt_unit(LAS unsigned char* lds, int b, int h, int j, const bf16* Qb, const bf16* Kb, const bf16* Vb, const bf16* GAs, const float* KMP,
                                                 const float* qg, const float* kg, bf16* M0, StreamA& st) {
    const int tid = threadIdx.x, lane = tid & 63, wave = __builtin_amdgcn_readfirstlane(tid >> 6), l31 = lane & 31, hh = lane >> 5;
    LAS float* KM = (LAS float*)(lds + AT_KM); LAS float* WSF = (LAS float*)(lds + AT_WS) + wave * 32;
    for (int i = tid; i < j * 64; i += 512) { const int n = i >> 6, d = i & 63; const float* p = KMP + ((size_t)(b * 16 + n) * 4) * 512 + h * 64 + d; KM[i] = ((p[0] + p[512]) + (p[1024] + p[1536])) * (1.0f / 256.0f); }
    float gq = fabsf(qg[lane]), gk = fabsf(kg[lane]);
#pragma unroll
    for (int o = 1; o < 64; o <<= 1) { gq = fmaxf(gq, __shfl_xor(gq, o)); gk = fmaxf(gk, __shfl_xor(gk, o)); }
    const float m0c = 8.0f * gq * gk * 1.4426950408889634f;
    const size_t qrow = (size_t)b * 4096 + 256 * j + 32 * wave + l31;
    bf16x8 qf[4];
#pragma unroll
    for (int ds = 0; ds < 4; ++ds) qf[ds] = *(const bf16x8*)(Qb + qrow * 512 + h * 64 + 16 * ds + 8 * hh);
    const int srow = tid >> 3, sch = tid & 7;
    const size_t kvbase = (size_t)b * 4096 * 512 + h * 64 + sch * 8;
    const int sdst = srow * AT_PITCH + sch * 16;
    const int T = 4 * (j + 1);
    u32x4_t kreg, vreg;
    { const size_t r0 = (size_t)(256 * j + srow) * 512; kreg = *(const u32x4_t*)(Kb + kvbase + r0); vreg = *(const u32x4_t*)(Vb + kvbase + r0); }
    __syncthreads();
    unsigned selmask;
    if (j <= 3) selmask = (1u << j) - 1u;
    else {
        float g0 = -INFINITY, g1 = -INFINITY, g2 = -INFINITY; int s0 = 0, s1 = 0, s2 = 0;
        for (int n = 0; n < j; ++n) {
            float part = 0.f;
#pragma unroll
            for (int ds = 0; ds < 4; ++ds)
#pragma unroll
                for (int e = 0; e < 8; ++e) part += bf2f((unsigned short)qf[ds][e]) * KM[n * 64 + 16 * ds + 8 * hh + e];
            const float g = part + __shfl_xor(part, 32);
            if (g > g0) { g2 = g1; s2 = s1; g1 = g0; s1 = s0; g0 = g; s0 = n; }
            else if (g > g1) { g2 = g1; s2 = s1; g1 = g; s1 = n; }
            else if (g > g2) { g2 = g; s2 = n; }
        }
        selmask = (1u << s0) | (1u << s1) | (1u << s2);
    }
    *(LAS u32x4_t*)(lds + AT_KV + sdst) = kreg; *(LAS u32x4_t*)(lds + AT_KV + AT_TILE + sdst) = vreg;
    __syncthreads();
    f32x16 o0, o1;
#pragma unroll
    for (int r = 0; r < 16; ++r) { o0[r] = 0.f; o1[r] = 0.f; }
    float lsum = 0.f;
    const int qp = 32 * wave + l31;
    const int koff = l31 * AT_PITCH + hh * 16;
    const int voff = (4 * hh + ((lane & 15) >> 2)) * AT_PITCH + (16 * ((lane >> 4) & 1) + 4 * (lane & 3)) * 2;
    for (int t = 0; t < T; ++t) {
        const bool more = (t + 1 < T);
        if (more) { const int t1 = t + 1; const int nb = t1 < 4 ? j : (t1 >> 2) - 1; const size_t r0 = (size_t)(256 * nb + 64 * (t1 & 3) + srow) * 512; kreg = *(const u32x4_t*)(Kb + kvbase + r0); vreg = *(const u32x4_t*)(Vb + kvbase + r0); }
        st.step();
        const int buf = (t & 1) * AT_BUF;
        const bool own = t < 4; const int nbk = own ? j : (t >> 2) - 1;
        const bool act = own || ((selmask >> nbk) & 1u);
        f32x16 p0, p1;
#pragma unroll
        for (int r = 0; r < 16; ++r) { p0[r] = 0.f; p1[r] = 0.f; }
#pragma unroll
        for (int ds = 0; ds < 4; ++ds) {
            const bf16x8 ka0 = *(const LAS bf16x8*)(lds + AT_KV + buf + koff + ds * 32);
            const bf16x8 ka1 = *(const LAS bf16x8*)(lds + AT_KV + buf + koff + 32 * AT_PITCH + ds * 32);
            p0 = __builtin_amdgcn_mfma_f32_32x32x16_bf16(ka0, qf[ds], p0, 0, 0, 0);
            p1 = __builtin_amdgcn_mfma_f32_32x32x16_bf16(ka1, qf[ds], p1, 0, 0, 0);
        }
        const int kp0 = 64 * (t & 3);
        float ls = 0.f;
#pragma unroll
        for (int r = 0; r < 16; ++r) {
            const int kp = kp0 + crow(r, hh);
            const bool v0 = own ? (kp <= qp) : act, v1 = own ? (kp + 32 <= qp) : act;
            const float e0 = v0 ? __builtin_amdgcn_exp2f(p0[r] * SM_C - m0c) : 0.f, e1 = v1 ? __builtin_amdgcn_exp2f(p1[r] * SM_C - m0c) : 0.f;
            p0[r] = e0; p1[r] = e1; ls += e0 + e1;
        }
        lsum += ls;
        bf16x8 pa[4];
        { u32x4_t w;
          w.x = cvtpk(p0[0], p0[1]); w.y = cvtpk(p0[2], p0[3]); w.z = cvtpk(p0[4], p0[5]); w.w = cvtpk(p0[6], p0[7]); pa[0] = __builtin_bit_cast(bf16x8, w);
          w.x = cvtpk(p0[8], p0[9]); w.y = cvtpk(p0[10], p0[11]); w.z = cvtpk(p0[12], p0[13]); w.w = cvtpk(p0[14], p0[15]); pa[1] = __builtin_bit_cast(bf16x8, w);
          w.x = cvtpk(p1[0], p1[1]); w.y = cvtpk(p1[2], p1[3]); w.z = cvtpk(p1[4], p1[5]); w.w = cvtpk(p1[6], p1[7]); pa[2] = __builtin_bit_cast(bf16x8, w);
          w.x = cvtpk(p1[8], p1[9]); w.y = cvtpk(p1[10], p1[11]); w.z = cvtpk(p1[12], p1[13]); w.w = cvtpk(p1[14], p1[15]); pa[3] = __builtin_bit_cast(bf16x8, w); }
#pragma unroll
        for (int ks = 0; ks < 4; ++ks) {
            const LAS unsigned char* vb = lds + AT_KV + buf + AT_TILE + voff + 16 * ks * AT_PITCH;
            const v4i16_t a0 = __builtin_amdgcn_ds_read_tr16_b64_v4i16((LAS v4i16_t*)(vb));
            const v4i16_t a1 = __builtin_amdgcn_ds_read_tr16_b64_v4i16((LAS v4i16_t*)(vb + 8 * AT_PITCH));
            const v4i16_t c0 = __builtin_amdgcn_ds_read_tr16_b64_v4i16((LAS v4i16_t*)(vb + 64));
            const v4i16_t c1 = __builtin_amdgcn_ds_read_tr16_b64_v4i16((LAS v4i16_t*)(vb + 8 * AT_PITCH + 64));
            const bf16x8 vf0 = (bf16x8){a0[0], a0[1], a0[2], a0[3], a1[0], a1[1], a1[2], a1[3]};
            const bf16x8 vf1 = (bf16x8){c0[0], c0[1], c0[2], c0[3], c1[0], c1[1], c1[2], c1[3]};
            o0 = __builtin_amdgcn_mfma_f32_32x32x16_bf16(pa[ks], vf0, o0, 0, 0, 0);
            o1 = __builtin_amdgcn_mfma_f32_32x32x16_bf16(pa[ks], vf1, o1, 0, 0, 0);
        }
        if (more) { const int nbuf = ((t + 1) & 1) * AT_BUF; *(LAS u32x4_t*)(lds + AT_KV + nbuf + sdst) = kreg; *(LAS u32x4_t*)(lds + AT_KV + nbuf + AT_TILE + sdst) = vreg; }
        __syncthreads();
    }
    lsum += __shfl_xor(lsum, 32);
    if (hh == 0) WSF[l31] = 1.0f / lsum;
    asm volatile("s_waitcnt lgkmcnt(0)" ::: "memory");
    const size_t orow0 = (size_t)b * 4096 + 256 * j + 32 * wave;
#pragma unroll
    for (int r = 0; r < 16; ++r) {
        const int q = crow(r, hh); const float li = WSF[q]; const size_t ro = orow0 + q;
        const float ga0 = bf2f(GAs[ro * 512 + h * 64 + l31]), ga1 = bf2f(GAs[ro * 512 + h * 64 + 32 + l31]);
        M0[ro * 1024 + h * 64 + l31] = (bf16)f2bf(o0[r] * li * ga0);
        M0[ro * 1024 + h * 64 + 32 + l31] = (bf16)f2bf(o1[r] * li * ga1);
    }
}
__device__ __forceinline__ void attn_prompt_phase(LAS unsigned char* lds, int vcu, int G, const bf16* Qb, const bf16* Kb, const bf16* Vb, const bf16* GAs, const float* KMP, const float* qg, const float* kg, bf16* M0,
                                                  const float* cache_k, const int* pt, float* SC, float* KMS) {
    const int lane = threadIdx.x & 63, wave = __builtin_amdgcn_readfirstlane(threadIdx.x >> 6);
    StreamA st; st.init(Qb, cache_k, pt, SC, KMS, vcu, G, lane, wave);
    for (int u = vcu; u < 256; u += G) {
        const int b = u >> 6, h = (u >> 3) & 7, jj = u & 7;
        attn_prompt_unit(lds, b, h, 15 - jj, Qb, Kb, Vb, GAs, KMP, qg, kg, M0, st);
        attn_prompt_unit(lds, b, h, jj, Qb, Kb, Vb, GAs, KMP, qg, kg, M0, st);
    }
    st.drain();
}

__device__ __forceinline__ void attn_sample_passA(LAS unsigned char* lds, int vcu, int G, const bf16* Qb, const float* cache_k, const int* pt, float* SC, float* KMS) {
    const int tid = threadIdx.x, lane = tid & 63, h = __builtin_amdgcn_readfirstlane(tid >> 6), rowi = lane & 15, kq = lane >> 4;
    for (int unit = vcu; unit < 1024; unit += G) {
        const int n = unit >> 3, blk = unit & 7;
        bf16x8 qfr[2];
#pragma unroll
        for (int s = 0; s < 2; ++s) { u32x4_t w = (u32x4_t){0u, 0u, 0u, 0u}; if (rowi < 4) w = *(const u32x4_t*)(Qb + (size_t)(MPROMPT + n * 4 + rowi) * 512 + h * 64 + 32 * s + 8 * kq); qfr[s] = __builtin_bit_cast(bf16x8, w); }
        const int pg0 = pt[n * 16 + blk * 2], pg1 = pt[n * 16 + blk * 2 + 1];
        f32x4 ks[2][2];
#pragma unroll
        for (int s = 0; s < 2; ++s) { ks[s][0] = (f32x4){0.f, 0.f, 0.f, 0.f}; ks[s][1] = (f32x4){0.f, 0.f, 0.f, 0.f}; }
        float* scb = SC + (((size_t)n * 8 + h) * 4 + rowi) * 2048 + blk * 256 + 4 * kq;
#pragma unroll 1
        for (int rq = 0; rq < 4; ++rq) {
            const int page = rq < 2 ? pg0 : pg1;
            const float* base = cache_k + (((size_t)page * 128 + ((64 * rq + rowi) & 127)) * 8 + h) * 64 + 8 * kq;
            f32x4 ld[4][4];
#pragma unroll
            for (int g = 0; g < 4; ++g) { const float* bg = base + (size_t)g * 16 * 512;
                ld[g][0] = __builtin_nontemporal_load((const f32x4*)(bg)); ld[g][1] = __builtin_nontemporal_load((const f32x4*)(bg + 4));
                ld[g][2] = __builtin_nontemporal_load((const f32x4*)(bg + 32)); ld[g][3] = __builtin_nontemporal_load((const f32x4*)(bg + 36)); }
#pragma unroll
            for (int g = 0; g < 4; ++g) {
                ks[0][0] += ld[g][0]; ks[0][1] += ld[g][1]; ks[1][0] += ld[g][2]; ks[1][1] += ld[g][3];
                u32x4_t wa, wb;
                wa.x = cvtpk_nv(ld[g][0][0], ld[g][0][1]); wa.y = cvtpk_nv(ld[g][0][2], ld[g][0][3]); wa.z = cvtpk_nv(ld[g][1][0], ld[g][1][1]); wa.w = cvtpk_nv(ld[g][1][2], ld[g][1][3]);
                wb.x = cvtpk_nv(ld[g][2][0], ld[g][2][1]); wb.y = cvtpk_nv(ld[g][2][2], ld[g][2][3]); wb.z = cvtpk_nv(ld[g][3][0], ld[g][3][1]); wb.w = cvtpk_nv(ld[g][3][2], ld[g][3][3]);
                f32x4 acc = (f32x4){0.f, 0.f, 0.f, 0.f};
                acc = __builtin_amdgcn_mfma_f32_16x16x32_bf16(__builtin_bit_cast(bf16x8, wa), qfr[0], acc, 0, 0, 0);
                acc = __builtin_amdgcn_mfma_f32_16x16x32_bf16(__builtin_bit_cast(bf16x8, wb), qfr[1], acc, 0, 0, 0);
                if (rowi < 4) *(f32x4*)(scb + 16 * (4 * rq + g)) = acc;
            }
        }
#pragma unroll
        for (int s = 0; s < 2; ++s)
#pragma unroll
            for (int e = 0; e < 2; ++e) {
                f32x4 v = ks[s][e];
#pragma unroll
                for (int o = 1; o < 16; o <<= 1) { v[0] += __shfl_xor(v[0], o); v[1] += __shfl_xor(v[1], o); v[2] += __shfl_xor(v[2], o); v[3] += __shfl_xor(v[3], o); }
                if (rowi == 0) *(f32x4*)(KMS + ((size_t)n * 8 + blk) * 512 + h * 64 + 32 * s + 8 * kq + 4 * e) = v * (1.0f / 256.0f);
            }
    }
}
__device__ __forceinline__ void attn_sample_passB(LAS unsigned char* lds, int vcu, int G, const bf16* Qb, const bf16* Kb, const bf16* Vb, const bf16* GAs, const float* cache_v, const int* pt,
                                                  const float* SC, const float* KMS, const float* qg, const float* kg, bf16* M0) {
    const int tid = threadIdx.x, lane = tid & 63, wave = __builtin_amdgcn_readfirstlane(tid >> 6);
    LAS float* PL = (LAS float*)lds;
    LAS float* OP = (LAS float*)(lds + 32768);
    LAS unsigned* SEL = (LAS unsigned*)(lds + 65536);
    LAS float* POWN = (LAS float*)(lds + 65536 + 64);
    LAS float* REDL = (LAS float*)(lds + 65536 + 128);
    float gq = fabsf(qg[lane]), gk = fabsf(kg[lane]);
#pragma unroll
    for (int o = 1; o < 64; o <<= 1) { gq = fmaxf(gq, __shfl_xor(gq, o)); gk = fmaxf(gk, __shfl_xor(gk, o)); }
    const float m0c = 8.0f * gq * gk * 1.4426950408889634f;
    for (int unit = vcu; unit < 1024; unit += G) {
        const int n = unit >> 3, h = unit & 7;
        if (wave < 4) {
            const int t = wave; const size_t qrow = (size_t)(MPROMPT + n * 4 + t);
            const float q = bf2f(Qb[qrow * 512 + h * 64 + lane]);
            float g0 = -INFINITY, g1 = -INFINITY, g2 = -INFINITY; int s0 = 0, s1 = 0, s2 = 0;
            for (int blk = 0; blk < 8; ++blk) {
                const float g = wave_sum(q * KMS[((size_t)n * 8 + blk) * 512 + h * 64 + lane]);
                if (g > g0) { g2 = g1; s2 = s1; g1 = g0; s1 = s0; g0 = g; s0 = blk; }
                else if (g > g1) { g2 = g1; s2 = s1; g1 = g; s1 = blk; }
                else if (g > g2) { g2 = g; s2 = blk; }
            }
            if (lane == 0) SEL[t] = (1u << s0) | (1u << s1) | (1u << s2);
#pragma unroll
            for (int tp = 0; tp < 4; ++tp) {
                const float s = wave_sum(q * bf2f(Kb[(size_t)(MPROMPT + n * 4 + tp) * 512 + h * 64 + lane]));
                if (lane == 0) POWN[t * 4 + tp] = tp <= t ? __builtin_amdgcn_exp2f(s * SM_C - m0c) : 0.f;
            }
        }
        __syncthreads();
        const unsigned sel0 = SEL[0], sel1 = SEL[1], sel2 = SEL[2], sel3 = SEL[3], anym = sel0 | sel1 | sel2 | sel3;
        {
            float lp[4] = {0.f, 0.f, 0.f, 0.f};
#pragma unroll
            for (int k = 0; k < 16; ++k) {
                const int i = tid + 512 * k, t = k >> 2, idx = i & 2047, blk = idx >> 8;
                const unsigned sm = t == 0 ? sel0 : (t == 1 ? sel1 : (t == 2 ? sel2 : sel3));
                const float p = ((sm >> blk) & 1u) ? __builtin_amdgcn_exp2f(SC[(((size_t)n * 8 + h) * 4 + t) * 2048 + idx] * SM_C - m0c) : 0.f;
                PL[i] = p; lp[t] += p;
            }
#pragma unroll
            for (int t = 0; t < 4; ++t) { const float s = wave_sum(lp[t]); if (lane == 0) REDL[wave * 4 + t] = s; }
        }
        __syncthreads();
        {
            const int d4 = tid & 15, rl = tid >> 4;
            f32x4 acc[4];
#pragma unroll
            for (int t = 0; t < 4; ++t) acc[t] = (f32x4){0.f, 0.f, 0.f, 0.f};
            const float* cvb = cache_v + (size_t)h * 64 + 4 * d4;
            f32x4 cur[8], nxt[8];
            unsigned rem = anym & 0xffu;
            int blk = rem ? __builtin_ctz(rem) : 8;
            if (blk < 8) { const int pg0 = pt[n * 16 + blk * 2], pg1 = pt[n * 16 + blk * 2 + 1];
#pragma unroll
                for (int rr = 0; rr < 8; ++rr) { const int r = rl + 32 * rr; cur[rr] = __builtin_nontemporal_load((const f32x4*)(cvb + ((size_t)(rr < 4 ? pg0 : pg1) * 128 + (r & 127)) * 512)); } }
            while (blk < 8) {
                rem &= rem - 1u;
                const int nb = rem ? __builtin_ctz(rem) : 8;
                if (nb < 8) { const int pg0 = pt[n * 16 + nb * 2], pg1 = pt[n * 16 + nb * 2 + 1];
#pragma unroll
                    for (int rr = 0; rr < 8; ++rr) { const int r = rl + 32 * rr; nxt[rr] = __builtin_nontemporal_load((const f32x4*)(cvb + ((size_t)(rr < 4 ? pg0 : pg1) * 128 + (r & 127)) * 512)); } }
#pragma unroll
                for (int rr = 0; rr < 8; ++rr) { const int r = rl + 32 * rr;
#pragma unroll
                    for (int t = 0; t < 4; ++t) acc[t] += PL[t * 2048 + blk * 256 + r] * cur[rr]; }
#pragma unroll
                for (int rr = 0; rr < 8; ++rr) cur[rr] = nxt[rr];
                blk = nb;
            }
#pragma unroll
            for (int t = 0; t < 4; ++t) *(LAS f32x4*)(lds + 32768 + ((rl * 4 + t) * 64 + 4 * d4) * 4) = acc[t];
        }
        __syncthreads();
        if (tid < 256) {
            const int t = tid >> 6, d = tid & 63; float o = 0.f;
#pragma unroll 8
            for (int rl = 0; rl < 32; ++rl) o += OP[(rl * 4 + t) * 64 + d];
            float l = 0.f;
#pragma unroll
            for (int w = 0; w < 8; ++w) l += REDL[w * 4 + t];
#pragma unroll
            for (int tp = 0; tp < 4; ++tp) { const float p = POWN[t * 4 + tp]; l += p; o += p * bf2f(Vb[(size_t)(MPROMPT + n * 4 + tp) * 512 + h * 64 + d]); }
            const size_t ro = (size_t)(MPROMPT + n * 4 + t);
            M0[ro * 1024 + h * 64 + d] = (bf16)f2bf(o / l * bf2f(GAs[ro * 512 + h * 64 + d]));
        }
        __syncthreads();
    }
}

__global__ void __launch_bounds__(NWAVES * 64, 2) fwd(Args args) {
    extern __shared__ __attribute__((aligned(16))) unsigned char lds_raw[];
    LAS unsigned char* lds = (LAS unsigned char*)lds_raw;
    volatile LAS unsigned* MISC = (volatile LAS unsigned*)(lds + MISC_OFF);
    const int tid = threadIdx.x, lane = tid & 63, wave = __builtin_amdgcn_readfirstlane(tid >> 6);
    const int G = gridDim.x; const int bx = blockIdx.x; const int vcu = (G % 8 == 0) ? (bx % 8) * (G / 8) + bx / 8 : bx;
    unsigned char* ws = args.ws;
    for (int u = tid; u < (LDS_BYTES - LDSCTL_OFF) / 4; u += NWAVES * 64) ((LAS unsigned*)(lds + LDSCTL_OFF))[u] = 0u;
    __syncthreads();
    XcdBarrier bar = xcd_barrier_post((unsigned*)(ws + WS_CTL) + CW_BAR, MISC + 8);
#ifdef FWD_STAMPS
    unsigned long long* stamps_ = (unsigned long long*)(ws + WS_STAMP);
#define STAMP(k) do { if (bx == 0 && tid == 0) stamps_[k] = __builtin_amdgcn_s_memrealtime(); } while (0)
#else
#define STAMP(k) do {} while (0)
#endif
    STAMP(0);

    const float* x_prompt = (const float*)args.in[I_XP]; const float* x_sample = (const float*)args.in[I_XS];
    float* out = args.out;
    bf16* W0T = (bf16*)(ws + WS_W0T); bf16* WO0T = (bf16*)(ws + WS_WO0T); bf16* W1T = (bf16*)(ws + WS_W1T); bf16* WO1T = (bf16*)(ws + WS_WO1T);
    float* RSTD0 = (float*)(ws + WS_RSTD0); float* LB = (float*)(ws + WS_LB); float* KMP = (float*)(ws + WS_KMP); float* SSQ = (float*)(ws + WS_SSQ);
    bf16* XB = (bf16*)(ws + WS_XB); bf16* Qb = (bf16*)(ws + WS_Q); bf16* Kb = (bf16*)(ws + WS_K); bf16* Vb = (bf16*)(ws + WS_V);
    bf16* GA = (bf16*)(ws + WS_GA); bf16* Ub = (bf16*)(ws + WS_U); bf16* GC = (bf16*)(ws + WS_GC);
    bf16* M0 = (bf16*)(ws + WS_M0); float* X1 = (float*)(ws + WS_X1); bf16* XB1 = (bf16*)(ws + WS_XB1); bf16* QQ = (bf16*)(ws + WS_QQ); float* LOGF = (float*)(ws + WS_LOGF);
    bf16* VV = (bf16*)(ws + WS_VV); bf16* GS = (bf16*)(ws + WS_GS); bf16* M1 = (bf16*)(ws + WS_M1);
    float* SCb = (float*)(ws + WS_SC); float* KMS = (float*)(ws + WS_KMS);
    float* OLOC = (float*)(ws + WS_OLOC); bf16* QBS = (bf16*)(ws + WS_QBS); float* USEG = (float*)(ws + WS_USEG); float* DSEG = (float*)(ws + WS_DSEG);

    {
        LAS float* scr = (LAS float*)(lds + wave * 16384);
        const int gw = vcu * NWAVES + wave, NGW = G * NWAVES;
        constexpr int I0 = 16 * (N0 / 32), IO = 16 * 32, I1 = 16 * (N1 / 32);
        constexpr int NITEMS = I0 + IO + I1 + IO;
        for (int it = gw; it < NITEMS; it += NGW) {
            int r = it;
            if (r < I0) { const int kb = r / (N0 / 32), dg = r % (N0 / 32); p0_transpose_item((const float*)args.in[I_WIN0], D, N0, W0T, 64 * kb, 32 * l0_src_group(dg), 32 * dg, (const float*)args.in[I_NORM0], scr, lane); continue; } r -= I0;
            if (r < IO) { const int kb = r / 32, dg = r % 32; p0_transpose_item((const float*)args.in[I_WOUT0], D, D, WO0T, 64 * kb, 32 * dg, 32 * dg, nullptr, scr, lane); continue; } r -= IO;
            if (r < I1) { const int kb = r / (N1 / 32), dg = r % (N1 / 32); p0_transpose_item((const float*)args.in[I_WIN1], D, N1, W1T, 64 * kb, 32 * dg, 32 * dg, (const float*)args.in[I_NORM1], scr, lane); continue; } r -= I1;
            { const int kb = r / 32, dg = r % 32; p0_transpose_item((const float*)args.in[I_WOUT1], D, D, WO1T, 64 * kb, 32 * dg, 32 * dg, nullptr, scr, lane); }
        }
        for (int m0 = gw; m0 < MTOT; m0 += 2 * NGW) {
            const int m1 = m0 + NGW; const bool has1 = m1 < MTOT; const int m1c = has1 ? m1 : m0;
            const float* xr0 = m0 < MPROMPT ? x_prompt + (size_t)m0 * D : x_sample + (size_t)(m0 - MPROMPT) * D;
            const float* xr1 = m1c < MPROMPT ? x_prompt + (size_t)m1c * D : x_sample + (size_t)(m1c - MPROMPT) * D;
            f32x4 v0[4], v1[4];
#pragma unroll
            for (int j = 0; j < 4; ++j) { v0[j] = ((const GAS f32x4*)xr0)[lane + 64 * j]; v1[j] = ((const GAS f32x4*)xr1)[lane + 64 * j]; }
            float s0 = 0.f, s1 = 0.f;
#pragma unroll
            for (int j = 0; j < 4; ++j) { s0 += pg8::dot4(v0[j]); s1 += pg8::dot4(v1[j]); }
            s0 = wave_sum(s0); s1 = wave_sum(s1);
            if (lane == 0) { RSTD0[m0] = __builtin_amdgcn_rsqf(s0 * (1.0f / D) + 1e-6f); if (has1) RSTD0[m1] = __builtin_amdgcn_rsqf(s1 * (1.0f / D) + 1e-6f); }
            GAS unsigned long long* o0 = (GAS unsigned long long*)(XB + (size_t)m0 * D) + lane;
#pragma unroll
            for (int j = 0; j < 4; ++j) o0[64 * j] = (unsigned long long)pk2(v0[j].x, v0[j].y) | ((unsigned long long)pk2(v0[j].z, v0[j].w) << 32);
            if (has1) { GAS unsigned long long* o1 = (GAS unsigned long long*)(XB + (size_t)m1 * D) + lane;
#pragma unroll
                for (int j = 0; j < 4; ++j) o1[64 * j] = (unsigned long long)pk2(v1[j].x, v1[j].y) | ((unsigned long long)pk2(v1[j].z, v1[j].w) << 32); }
        }
        { const int gt = vcu * (NWAVES * 64) + tid; if (gt < 1024) { const float* l = (const float*)args.in[I_LBL]; LB[gt] = 1.0f / (1.0f + __expf(l[gt] - l[1024 + gt])); } }
        { const f32x4* sc = (const f32x4*)args.in[I_SCONV]; f32x4* cs = (f32x4*)(out + O_CS);
          for (int i = vcu * (NWAVES * 64) + tid; i < NDEC * 26 * 128; i += G * NWAVES * 64) { const int n = i / (26 * 128), rem = i % (26 * 128); cs[(size_t)n * 30 * 128 + rem] = sc[(size_t)n * 30 * 128 + 4 * 128 + rem]; } }
    }
    xcd_barrier(bar); STAMP(1);

    {
        pg8::Gemm g{XB, W0T, MTOT, N0, D}; pg8::StaticOrder S; S.init(MTOT, N0, G, bx);
        pg8::EpiIn0 E{RSTD0, (const float*)args.in[I_QN], (const float*)args.in[I_KN], Qb, Kb, Vb, GA, Ub, GC,
                      out + O_KP, out + O_VP, out + O_KS, out + O_VS, out + O_CP, out + O_CS, KMP};
        pg8::gemm_phase<pg8::EpiIn0, pg8::StaticOrder, true, true>(lds, g, S, E);
    }
    xcd_barrier(bar); STAMP(2);

    attn_prompt_phase(lds, vcu, G, Qb, Kb, Vb, GA, KMP, (const float*)args.in[I_QN], (const float*)args.in[I_KN], M0, (const float*)args.in[I_CK], (const int*)args.in[I_PT], SCb, KMS); STAMP(3);
    xcd_barrier(bar); STAMP(4);

    if (bx & 1) attn_sample_passB(lds, vcu, G, Qb, Kb, Vb, GA, (const float*)args.in[I_CV], (const int*)args.in[I_PT], SCb, KMS, (const float*)args.in[I_QN], (const float*)args.in[I_KN], M0);
    conv_phase(lds, vcu, G, Ub, GC, (const float*)args.in[I_SCONV], (const float*)args.in[I_CW], (const float*)args.in[I_CB], (const float*)args.in[I_LNG], (const float*)args.in[I_LNB], M0); STAMP(5);
    if (!(bx & 1)) attn_sample_passB(lds, vcu, G, Qb, Kb, Vb, GA, (const float*)args.in[I_CV], (const int*)args.in[I_PT], SCb, KMS, (const float*)args.in[I_QN], (const float*)args.in[I_KN], M0);
    xcd_barrier(bar); STAMP(6);

    {
        pg8::Gemm g{M0, WO0T, MTOT, D, D}; pg8::StaticOrder S; S.init(MTOT, D, G, bx);
        pg8::EpiOut0 E{x_prompt, x_sample, X1, XB1, SSQ};
        pg8::gemm_phase<pg8::EpiOut0, pg8::StaticOrder, true, true>(lds, g, S, E);
    }
    xcd_barrier(bar); STAMP(7);

    {
        pg8::Gemm g{XB1, W1T, MTOT, N1, D}; pg8::StaticOrder S; S.init(MTOT, N1, G, bx);
        pg8::EpiIn1 E{SSQ, LB, QQ, VV, GS, LOGF};
        pg8::gemm_phase<pg8::EpiIn1, pg8::StaticOrder, true, true>(lds, g, S, E);
    }
    xcd_barrier(bar); STAMP(8);

    scan_pass1(lds, vcu, G, QQ, LOGF, VV, OLOC, QBS, USEG, DSEG); STAMP(9);
    scan_sample(lds, vcu, G, QQ, LOGF, VV, GS, (const float*)args.in[I_ONORM], (const float*)args.in[I_SHGRN], out + O_HS, M1);
    xcd_barrier(bar); STAMP(10);

    if (G > 16 && bx < 8) {
        pg8::Gemm g{M1, WO1T, MTOT, D, D}; pg8::FewOrder S; S.n = 8; S.nN = 4; S.pm0 = 64; S.c = bx;
        pg8::EpiOut1 E{X1, out + O_Y};
        pg8::gemm_phase<pg8::EpiOut1, pg8::FewOrder, true, true>(lds, g, S, E);
    } else {
        const bool split = G > 16;
        scan_pass3(lds, split ? bx - 8 : vcu, split ? G - 8 : G, QBS, OLOC, USEG, DSEG, GS, (const float*)args.in[I_ONORM], M1, out + O_HP);
    }
    xcd_barrier(bar); STAMP(11);

    {
        const int mrows = G > 16 ? MPROMPT : MTOT;
        pg8::Gemm g{M1, WO1T, mrows, D, D}; pg8::StaticOrder S; S.init(mrows, D, G, bx);
        pg8::EpiOut1 E{X1, out + O_Y};
        pg8::gemm_phase<pg8::EpiOut1, pg8::StaticOrder, true, true>(lds, g, S, E);
    }
    STAMP(12);
}
extern "C" void kernel_launch(void* const* d_in, const int* in_sizes, int n_in, void* d_out, int out_size, void* d_ws, size_t ws_size, hipStream_t stream) {
    static int grid = 0;
    if (grid == 0) {
        if (n_in != N_IN || (size_t)out_size != O_END || ws_size < WS_END) { fprintf(stderr, "kernel_launch: unexpected shapes (n_in %d out %d ws %zu)\n", n_in, out_size, ws_size); grid = -1; return; }
        int dev = 0, cus = 0, per_cu = 0;
        if (hipGetDevice(&dev) != hipSuccess || hipDeviceGetAttribute(&cus, hipDeviceAttributeMultiprocessorCount, dev) != hipSuccess) { grid = -1; return; }
        if (hipFuncSetAttribute((const void*)fwd, hipFuncAttributeMaxDynamicSharedMemorySize, LDS_BYTES) != hipSuccess) { fprintf(stderr, "kernel_launch: hipFuncSetAttribute failed\n"); grid = -1; return; }
        if (hipOccupancyMaxActiveBlocksPerMultiprocessor(&per_cu, (const void*)fwd, NWAVES * 64, LDS_BYTES) != hipSuccess || per_cu < 1) fprintf(stderr, "kernel_launch: occupancy query reports %d\n", per_cu);
        (void)hipGetLastError();
        grid = cus;
    }
    if (grid < 0) return;
    if (hipMemsetAsync((char*)d_ws + WS_CTL, 0, CTL_ZERO_BYTES, stream) != hipSuccess) return;
    Args a{};
    for (int i = 0; i < N_IN; ++i) a.in[i] = d_in[i];
    a.out = (float*)d_out; a.ws = (unsigned char*)d_ws;
    hipLaunchKernelGGL(fwd, dim3(grid), dim3(NWAVES * 64), LDS_BYTES, stream, a);
}
```
